# Optimizing an MI355X kernel written in HIP

```python
import jax, jax.numpy as jnp
from jax import lax
import numpy as np

D_MODEL = 1024
BATCH = 2
SEQ = 8192
DEPTH = 2

A_HEADS = 8
A_HEAD_DIM = 64
A_PATTERNS = ((128, 1), (512, 4), (2048, 16))
A_WIDTH = A_HEADS * A_HEAD_DIM
B_GROUPS = 4
B_GROUP_DIM = 128
B_CHUNK = 128
B_WIDTH = B_GROUPS * B_GROUP_DIM
C_HEADS = 16
C_HEAD_DIM = 64
C_WIDTH = C_HEADS * C_HEAD_DIM
C_BLOCK = 256
C_TOPK = 3
C_QCHUNK = 32
D_FF = 2816
EPS = 1e-6

AB_IN_WIDTH = 3 * A_WIDTH + 2 * B_WIDTH
AB_MIX_WIDTH = A_WIDTH + B_WIDTH
N_EVEN = (DEPTH + 1) // 2
N_ODD = DEPTH // 2

kernel_name = 'hybrid_dilated_gmlp_moba_macaron'


def rms_norm(x, g):
    xf = x.astype(jnp.float32)
    y = xf * lax.rsqrt(jnp.mean(xf * xf, axis=-1, keepdims=True) + EPS)
    return (y * g.astype(jnp.float32)).astype(x.dtype)


def swiglu(x, w_gate, w_up, w_down):
    return (jax.nn.silu(x @ w_gate) * (x @ w_up)) @ w_down


def to_heads(t, n_heads, head_dim):
    b, s, _ = t.shape
    return t.reshape(b, s, n_heads, head_dim).transpose(0, 2, 1, 3)


def from_heads(t):
    b, h, s, hd = t.shape
    return t.transpose(0, 2, 1, 3).reshape(b, s, h * hd)


def dilated_window_attention(q, k, v, window, dilation):
    b, h, s, hd = q.shape
    w = window // dilation
    span = w * dilation
    sp = -(-s // span) * span
    nb = sp // span

    def to_sub(t):
        t = jnp.pad(t, ((0, 0), (0, 0), (0, sp - s), (0, 0)))
        t = t.reshape(b, h, sp // dilation, dilation, hd)
        t = jnp.swapaxes(t, 2, 3)
        return t.reshape(b, h, dilation, nb, w, hd)

    def with_prev(t):
        prev = jnp.pad(t[:, :, :, :-1], ((0, 0), (0, 0), (0, 0), (1, 0), (0, 0), (0, 0)))
        return jnp.concatenate([prev, t], axis=-2)

    qb = to_sub(q)
    kk = with_prev(to_sub(k))
    vv = with_prev(to_sub(v))
    scores = jnp.einsum('bhrnqd,bhrnkd->bhrnqk', qb, kk).astype(jnp.float32) * (hd ** -0.5)
    qi = jnp.arange(w)[:, None]
    kj = jnp.arange(2 * w)[None, :] - w
    dist = qi - kj
    band = (dist >= 0) & (dist <= w)
    has_prev = (jnp.arange(nb)[:, None, None] > 0) | (kj >= 0)[None]
    mask = band[None] & has_prev
    scores = jnp.where(mask, scores, -jnp.inf)
    m = jnp.max(scores, axis=-1, keepdims=True)
    p = jnp.exp(scores - m)
    l = jnp.sum(p, axis=-1, keepdims=True)
    out = jnp.einsum('bhrnqk,bhrnkd->bhrnqd', (p / l).astype(v.dtype), vv)
    lse = (m + jnp.log(l))[..., 0]

    def from_sub(t):
        rest = t.shape[5:]
        t = t.reshape((b, h, dilation, sp // dilation) + rest)
        t = jnp.swapaxes(t, 2, 3).reshape((b, h, sp) + rest)
        return t[:, :, :s]

    return from_sub(out), from_sub(lse)


def mixture_of_dilations(q, k, v):
    outs, lses = [], []
    for window, dilation in A_PATTERNS:
        o, lse = dilated_window_attention(q, k, v, window, dilation)
        outs.append(o.astype(jnp.float32))
        lses.append(lse)
    wts = jax.nn.softmax(jnp.stack(lses, axis=0), axis=0)
    return jnp.sum(wts[..., None] * jnp.stack(outs, axis=0), axis=0).astype(q.dtype)


def chunked_spatial_gating(u, v, v_norm_g, w_s, b_s):
    b, s, g, c = u.shape
    u = jax.nn.gelu(u)
    v = rms_norm(jax.nn.gelu(v), v_norm_g)
    sp = -(-s // B_CHUNK) * B_CHUNK
    v = jnp.pad(v, ((0, 0), (0, sp - s), (0, 0), (0, 0))).reshape(b, sp // B_CHUNK, B_CHUNK, g, c)
    causal = jnp.tril(jnp.ones((B_CHUNK, B_CHUNK), dtype=bool))
    ws = jnp.where(causal[None], w_s, jnp.zeros_like(w_s))
    mixed = jnp.einsum('gpq,bnqgc->bnpgc', ws, v) + jnp.swapaxes(b_s, 0, 1)[None, None, :, :, None]
    mixed = mixed.reshape(b, sp, g, c)[:, :s]
    return (u * mixed).reshape(b, s, g * c)


def ab_mixer(x, w_in, v_norm, w_s, b_s, w_out):
    z = x @ w_in
    qa, ka, va, ub, vb = jnp.split(
        z, [A_WIDTH, 2 * A_WIDTH, 3 * A_WIDTH, 3 * A_WIDTH + B_WIDTH], axis=-1)
    b, s, _ = x.shape
    a_out = mixture_of_dilations(to_heads(qa, A_HEADS, A_HEAD_DIM),
                                 to_heads(ka, A_HEADS, A_HEAD_DIM),
                                 to_heads(va, A_HEADS, A_HEAD_DIM))
    a_out = from_heads(a_out)
    b_out = chunked_spatial_gating(ub.reshape(b, s, B_GROUPS, B_GROUP_DIM),
                                   vb.reshape(b, s, B_GROUPS, B_GROUP_DIM),
                                   v_norm, w_s, b_s)
    return jnp.concatenate([a_out, b_out], axis=-1) @ w_out


def moba_attention(q, k, v):
    b, h, s, hd = q.shape
    sp = -(-s // C_BLOCK) * C_BLOCK
    pad = ((0, 0), (0, 0), (0, sp - s), (0, 0))
    q, k, v = jnp.pad(q, pad), jnp.pad(k, pad), jnp.pad(v, pad)
    nb = sp // C_BLOCK
    topk = min(C_TOPK, nb)
    kb = k.reshape(b, h, nb, C_BLOCK, hd)
    vb = v.reshape(b, h, nb, C_BLOCK, hd)
    k_mean = jnp.mean(kb.astype(jnp.float32), axis=3).astype(k.dtype)
    scale = hd ** -0.5
    n_chunks = sp // C_QCHUNK
    qc = jnp.moveaxis(q.reshape(b, h, n_chunks, C_QCHUNK, hd), 2, 0)
    bi = jnp.arange(b)[:, None, None, None]
    hi = jnp.arange(h)[None, :, None, None]
    block_ids = jnp.arange(nb)

    def one_chunk(args):
        c, qq = args
        start = c * C_QCHUNK
        own = start // C_BLOCK
        qpos = start + jnp.arange(C_QCHUNK)
        gate = jnp.einsum('bhqd,bhnd->bhqn', qq, k_mean).astype(jnp.float32)
        gate = jnp.where(block_ids < own, gate, -jnp.inf)
        _, idx = lax.top_k(gate, topk)
        valid = idx < own
        k_sel = kb[bi, hi, idx]
        v_sel = vb[bi, hi, idx]
        s_sel = jnp.einsum('bhqd,bhqtkd->bhqtk', qq, k_sel).astype(jnp.float32) * scale
        s_sel = jnp.where(valid[..., None], s_sel, -jnp.inf).reshape(b, h, C_QCHUNK, topk * C_BLOCK)
        k_own = lax.dynamic_index_in_dim(kb, own, axis=2, keepdims=False)
        v_own = lax.dynamic_index_in_dim(vb, own, axis=2, keepdims=False)
        s_own = jnp.einsum('bhqd,bhkd->bhqk', qq, k_own).astype(jnp.float32) * scale
        kpos = own * C_BLOCK + jnp.arange(C_BLOCK)
        s_own = jnp.where(kpos[None, :] <= qpos[:, None], s_own, -jnp.inf)
        p = jax.nn.softmax(jnp.concatenate([s_sel, s_own], axis=-1), axis=-1).astype(v.dtype)
        p_sel = p[..., :topk * C_BLOCK].reshape(b, h, C_QCHUNK, topk, C_BLOCK)
        p_own = p[..., topk * C_BLOCK:]
        return (jnp.einsum('bhqtk,bhqtkd->bhqd', p_sel, v_sel)
                + jnp.einsum('bhqk,bhkd->bhqd', p_own, v_own))

    out = lax.map(one_chunk, (jnp.arange(n_chunks), qc))
    out = jnp.moveaxis(out, 0, 2).reshape(b, h, sp, hd)
    return out[:, :, :s]


def c_mixer(x, w_in, w_out):
    q, k, v = jnp.split(x @ w_in, 3, axis=-1)
    o = moba_attention(to_heads(q, C_HEADS, C_HEAD_DIM),
                       to_heads(k, C_HEADS, C_HEAD_DIM),
                       to_heads(v, C_HEADS, C_HEAD_DIM))
    return from_heads(o) @ w_out


def setup_inputs(seed: int = 0) -> dict:
    key = jax.random.key(seed)
    ks = jax.random.split(key, 18)
    f32 = jnp.float32

    def nrm(k, shape, scale):
        return jax.random.normal(k, shape, f32) * scale

    def gain(k, shape):
        return 1.0 + 0.02 * jax.random.normal(k, shape, f32)

    return {
        'x': nrm(ks[0], (BATCH, SEQ, D_MODEL), 1.0),
        'ffn1_norm': gain(ks[1], (DEPTH, D_MODEL)),
        'ffn1_w_gate': nrm(ks[2], (DEPTH, D_MODEL, D_FF), D_MODEL ** -0.5),
        'ffn1_w_up': nrm(ks[3], (DEPTH, D_MODEL, D_FF), D_MODEL ** -0.5),
        'ffn1_w_down': nrm(ks[4], (DEPTH, D_FF, D_MODEL), D_FF ** -0.5),
        'mix_norm': gain(ks[5], (DEPTH, D_MODEL)),
        'ffn2_norm': gain(ks[6], (DEPTH, D_MODEL)),
        'ffn2_w_gate': nrm(ks[7], (DEPTH, D_MODEL, D_FF), D_MODEL ** -0.5),
        'ffn2_w_up': nrm(ks[8], (DEPTH, D_MODEL, D_FF), D_MODEL ** -0.5),
        'ffn2_w_down': nrm(ks[9], (DEPTH, D_FF, D_MODEL), D_FF ** -0.5),
        'ab_w_in': nrm(ks[10], (N_EVEN, D_MODEL, AB_IN_WIDTH), D_MODEL ** -0.5),
        'ab_v_norm': gain(ks[11], (N_EVEN, B_GROUPS, B_GROUP_DIM)),
        'ab_w_spatial': nrm(ks[12], (N_EVEN, B_GROUPS, B_CHUNK, B_CHUNK), B_CHUNK ** -0.5),
        'ab_b_spatial': gain(ks[13], (N_EVEN, B_GROUPS, B_CHUNK)),
        'ab_w_out': nrm(ks[14], (N_EVEN, AB_MIX_WIDTH, D_MODEL), AB_MIX_WIDTH ** -0.5),
        'c_w_in': nrm(ks[15], (N_ODD, D_MODEL, 3 * C_WIDTH), D_MODEL ** -0.5),
        'c_w_out': nrm(ks[16], (N_ODD, C_WIDTH, D_MODEL), C_WIDTH ** -0.5),
        'final_norm': gain(ks[17], (D_MODEL,)),
    }


def reference(x, ffn1_norm, ffn1_w_gate, ffn1_w_up, ffn1_w_down, mix_norm,
              ffn2_norm, ffn2_w_gate, ffn2_w_up, ffn2_w_down,
              ab_w_in, ab_v_norm, ab_w_spatial, ab_b_spatial, ab_w_out,
              c_w_in, c_w_out, final_norm):
    h = x
    for layer in range(DEPTH):
        h = h + 0.5 * swiglu(rms_norm(h, ffn1_norm[layer]),
                             ffn1_w_gate[layer], ffn1_w_up[layer], ffn1_w_down[layer])
        hn = rms_norm(h, mix_norm[layer])
        if layer % 2 == 0:
            i = layer // 2
            h = h + ab_mixer(hn, ab_w_in[i], ab_v_norm[i], ab_w_spatial[i],
                             ab_b_spatial[i], ab_w_out[i])
        else:
            i = layer // 2
            h = h + c_mixer(hn, c_w_in[i], c_w_out[i])
        h = h + 0.5 * swiglu(rms_norm(h, ffn2_norm[layer]),
                             ffn2_w_gate[layer], ffn2_w_up[layer], ffn2_w_down[layer])
    return rms_norm(h, final_norm)
```

```cpp
#include <hip/hip_runtime.h>
#include <hip/hip_cooperative_groups.h>
#include <hip/hip_bf16.h>
#include <cstdio>
#include <cstdint>
#include <cmath>
namespace cg = cooperative_groups;
namespace pg8 {
#define PG8_LAS __attribute__((address_space(3)))
typedef unsigned short bf16_t;
typedef short bf16x8 __attribute__((ext_vector_type(8)));
typedef float f32x4 __attribute__((ext_vector_type(4)));
typedef unsigned u32x4 __attribute__((ext_vector_type(4)));
constexpr int BM = 256, BK = 64, HALF = 128, HTB = HALF * BK * 2  , STAGE_BYTES = 8 * HTB, NXCD = 8, WGM = 8;

__host__ __device__ __forceinline__ int lds_byte(int r, int c) { const int st = (r >> 4) * 2 + (c >> 5), rr = r & 15, cc = c & 31, ob = rr * 64 + cc * 2; return st * 1024 + (ob ^ (((ob >> 9) & 1) << 5)); }
__host__ __device__ __forceinline__ void stage_rc(int b, int& R, int& C) { const int st = b / 1024, sb = b % 1024, swz = sb ^ (((sb >> 9) & 1) << 5); R = (st >> 1) * 16 + swz / 64; C = (st & 1) * 32 + (swz % 64) / 2; }
__host__ __device__ __forceinline__ int perm32(int rho) { const int n = rho >> 4, i = rho & 15; return 8 * (i >> 2) + 4 * n + (i & 3); }

struct Unit { int pm, pn; };
struct Gemm { const bf16_t* A; const bf16_t* Bt; int M, N, K; };

struct StaticOrder {
    int nM, nN, nwg, G, c;
    __host__ __device__ void init(int M, int N, int G_, int c_) { nM = M / BM; nN = N / BM; nwg = nM * nN; G = G_; c = c_; }
    __host__ __device__ bool next(int i, Unit& u) const {
        const long L = (long)i * G + c; if (L >= nwg) return false;
        int wgid = (int)L; { const int q = nwg / NXCD, r = nwg % NXCD, xcd = wgid % NXCD, off = wgid / NXCD; wgid = (xcd < r ? xcd * (q + 1) : r * (q + 1) + (xcd - r) * q) + off; }
        const int nig = WGM * nN, gid = wgid / nig, fm = gid * WGM, gsz = (nM - fm) < WGM ? (nM - fm) : WGM;
        u.pm = fm + ((wgid % nig) % gsz); u.pn = (wgid % nig) / gsz; return true;
    }
    __device__ __forceinline__ void a_ready(const Unit&) const {}
    __device__ __forceinline__ void done(const Unit&) const {}
};

__device__ __forceinline__ unsigned cvt_pk_bf16(float lo, float hi) { unsigned r; asm volatile("v_cvt_pk_bf16_f32 %0, %1, %2" : "=v"(r) : "v"(lo), "v"(hi)); return r; }
typedef float f32x2 __attribute__((ext_vector_type(2)));
typedef unsigned u32x2 __attribute__((ext_vector_type(2)));
__device__ __forceinline__ float row_rstd(const float* part, int row) {
    const f32x4* p = (const f32x4*)(part + (size_t)row * 16);
    const f32x4 a = p[0], b = p[1], c = p[2], d = p[3];
    const float s = (((a[0] + a[1]) + (a[2] + a[3])) + ((b[0] + b[1]) + (b[2] + b[3]))) + (((c[0] + c[1]) + (c[2] + c[3])) + ((d[0] + d[1]) + (d[2] + d[3])));
    return rsqrtf(s * (1.0f / 1024.0f) + 1e-6f);
}
__device__ __forceinline__ float silu_mul(float g, float u) { return g * u * __builtin_amdgcn_rcpf(1.0f + __builtin_amdgcn_exp2f(-1.4426950408889634f * g)); }
struct EpiSwiGLU {
    static constexpr bool PERM = true, AFTER_DRAIN = false;
    bf16_t* H; int ldh; const PG8_LAS float* rt;
    __device__ __forceinline__ void operator()(const f32x4 (&acc)[2][2][4][2], const Unit& u, int wr, int wc, int fr, int fq, int ui) const {
        const int row0 = u.pm * BM + wr * 64 + fr; const int col0 = u.pn * HALF + wc * 32 + 8 * fq;
#pragma unroll
        for (int ai = 0; ai < 2; ++ai)
#pragma unroll
            for (int m = 0; m < 4; ++m) { const int row = row0 + ai * HALF + m * 16; const float rs = rt[ui * 256 + wr * 64 + fr + ai * HALF + m * 16];
                const f32x4 g0 = acc[ai][0][m][0] * rs, g1 = acc[ai][0][m][1] * rs, u0 = acc[ai][1][m][0] * rs, u1 = acc[ai][1][m][1] * rs;
                u32x4 w; w.x = cvt_pk_bf16(silu_mul(g0[0], u0[0]), silu_mul(g0[1], u0[1])); w.y = cvt_pk_bf16(silu_mul(g0[2], u0[2]), silu_mul(g0[3], u0[3]));
                w.z = cvt_pk_bf16(silu_mul(g1[0], u1[0]), silu_mul(g1[1], u1[1])); w.w = cvt_pk_bf16(silu_mul(g1[2], u1[2]), silu_mul(g1[3], u1[3]));
                *(u32x4*)(H + (size_t)row * ldh + col0) = w; }
    }
};
struct EpiResid {
    static constexpr bool PERM = true, AFTER_DRAIN = false;
    const float* base; float* out; bf16_t* xb; float* part; float alpha;
    __device__ __forceinline__ void operator()(const f32x4 (&acc)[2][2][4][2], const Unit& u, int wr, int wc, int fr, int fq, int) const {
        const int row0 = u.pm * BM + wr * 64 + fr; const int col0 = u.pn * BM + wc * 32 + 8 * fq;
#pragma unroll
        for (int ai = 0; ai < 2; ++ai)
#pragma unroll
            for (int m = 0; m < 4; ++m) { const int row = row0 + ai * HALF + m * 16; float ss = 0.f;
#pragma unroll
                for (int bj = 0; bj < 2; ++bj) { const size_t off = (size_t)row * 1024 + col0 + bj * HALF;
                    const f32x4 b0 = *(const f32x4*)(base + off), b1 = *(const f32x4*)(base + off + 4);
                    const f32x4 v0 = b0 + acc[ai][bj][m][0] * alpha, v1 = b1 + acc[ai][bj][m][1] * alpha;
                    *(f32x4*)(out + off) = v0; *(f32x4*)(out + off + 4) = v1;
                    ss += ((v0[0] * v0[0] + v0[1] * v0[1]) + (v0[2] * v0[2] + v0[3] * v0[3])) + ((v1[0] * v1[0] + v1[1] * v1[1]) + (v1[2] * v1[2] + v1[3] * v1[3]));
                    u32x4 w; w.x = cvt_pk_bf16(v0[0], v0[1]); w.y = cvt_pk_bf16(v0[2], v0[3]); w.z = cvt_pk_bf16(v1[0], v1[1]); w.w = cvt_pk_bf16(v1[2], v1[3]);
                    *(u32x4*)(xb + off) = w; }
                ss += __shfl_xor(ss, 16); ss += __shfl_xor(ss, 32);
                if (fq == 0) part[(size_t)row * 16 + u.pn * 4 + wc] = ss; }
    }
};
struct EpiProj {
    static constexpr bool PERM = true, AFTER_DRAIN = false;
    bf16_t* O; int ldc; const PG8_LAS float* rt; int split_cols; size_t split_stride; int qcols; float scale0; float* km;
    __device__ __forceinline__ void operator()(const f32x4 (&acc)[2][2][4][2], const Unit& u, int wr, int wc, int fr, int fq, int ui) const {
        const int row0 = u.pm * BM + wr * 64 + fr; int colt = u.pn * BM; bf16_t* basep = O; int t = 0;
        const float sc = (colt < qcols) ? scale0 : 1.f;
        if (split_cols) { t = colt / split_cols; basep += (size_t)t * split_stride; colt -= t * split_cols; }
        const int col0 = colt + wc * 32 + 8 * fq;
        const bool do_km = (km != nullptr) && (t == 1);
        f32x4 cs[2][2];
#pragma unroll
        for (int bj = 0; bj < 2; ++bj)
#pragma unroll
            for (int n = 0; n < 2; ++n) cs[bj][n] = (f32x4){0.f, 0.f, 0.f, 0.f};
#pragma unroll
        for (int ai = 0; ai < 2; ++ai)
#pragma unroll
            for (int m = 0; m < 4; ++m) { const int row = row0 + ai * HALF + m * 16; const float rs = rt[ui * 256 + wr * 64 + fr + ai * HALF + m * 16]; const float rsc = rs * sc;
                bf16_t* rowp = basep + (size_t)row * ldc + col0;
#pragma unroll
                for (int bj = 0; bj < 2; ++bj) { const f32x4 v0 = acc[ai][bj][m][0] * rsc, v1 = acc[ai][bj][m][1] * rsc;
                    cs[bj][0] += v0; cs[bj][1] += v1;
                    u32x4 w; w.x = cvt_pk_bf16(v0[0], v0[1]); w.y = cvt_pk_bf16(v0[2], v0[3]); w.z = cvt_pk_bf16(v1[0], v1[1]); w.w = cvt_pk_bf16(v1[2], v1[3]);
                    *(u32x4*)(rowp + bj * HALF) = w; } }
        if (do_km) {
#pragma unroll
            for (int bj = 0; bj < 2; ++bj)
#pragma unroll
                for (int n = 0; n < 2; ++n) { f32x4 v = cs[bj][n];
#pragma unroll
                    for (int o = 1; o < 16; o <<= 1) { v[0] += __shfl_xor(v[0], o); v[1] += __shfl_xor(v[1], o); v[2] += __shfl_xor(v[2], o); v[3] += __shfl_xor(v[3], o); }
                    if (fr == 0) *(f32x4*)(km + (size_t)(u.pm * 2 + wr) * 1024 + col0 + bj * HALF + 4 * n) = v; }
        }
    }
};
template <class Epi, class Sched, bool ALIGN_EPI = false, bool SP2 = false>
__device__ __forceinline__ void gemm_phase(PG8_LAS unsigned char* lds, const Gemm g, const Sched& S, const Epi& E) {
    const int tid = threadIdx.x, wid = __builtin_amdgcn_readfirstlane(tid >> 6), lane = tid & 63, wr = wid >> 2, wc = wid & 3, fr = lane & 15, fq = lane >> 4;
    const int K = g.K, nt = K / BK;
    unsigned voffA[2], voffB[2];
#pragma unroll
    for (int i = 0; i < 2; ++i) { int R, C; stage_rc(tid * 16 + i * 8192, R, C); const int Rb = Epi::PERM ? ((R & ~31) + perm32(R & 31)) : R;
        voffA[i] = (unsigned)(R * K + C) * 2u; voffB[i] = (unsigned)(Rb * K + C) * 2u; }
    const size_t kstep = (size_t)(BK * 2);
    const size_t hstep = (size_t)HALF * K * 2;
    const size_t tstep = 2 * hstep;
    const unsigned ldsw = (unsigned)wid * 1024u;
    const int aoff = lds_byte(wr * 64 + fr, fq * 8), boff = lds_byte(wc * 32 + fr, fq * 8);
#define PG8_SA(b, h) (((b) * 2 + (h)) * HTB)
#define PG8_SB(b, h) ((4 + (b) * 2 + (h)) * HTB)
#define PG8_STAGE(bufoff, gbase, voff) do { _Pragma("unroll") for (int _i = 0; _i < 2; ++_i) \
        __builtin_amdgcn_global_load_lds((const unsigned*)((const char*)(gbase) + (voff)[_i]), (PG8_LAS unsigned*)(lds + (bufoff) + ldsw + _i * 8192), 16, 0, 0); } while (0)
#define PG8_LDA(dst, b, h) do { _Pragma("unroll") for (int m = 0; m < 4; ++m) _Pragma("unroll") for (int k = 0; k < 2; ++k) dst[m][k] = *(const PG8_LAS bf16x8*)(lds + PG8_SA(b, h) + aoff + m * 2048 + k * 1024); } while (0)
#define PG8_LDB(dst, b, h) do { _Pragma("unroll") for (int n = 0; n < 2; ++n) _Pragma("unroll") for (int k = 0; k < 2; ++k) dst[n][k] = *(const PG8_LAS bf16x8*)(lds + PG8_SB(b, h) + boff + n * 2048 + k * 1024); } while (0)
#define PG8_MMA(ai, bj, At, Bt) do { __builtin_amdgcn_s_setprio(1); _Pragma("unroll") for (int m = 0; m < 4; ++m) _Pragma("unroll") for (int n = 0; n < 2; ++n) _Pragma("unroll") for (int k = 0; k < 2; ++k) \
        acc[ai][bj][m][n] = __builtin_amdgcn_mfma_f32_16x16x32_bf16(Bt[n][k], At[m][k], acc[ai][bj][m][n], 0, 0, 0); __builtin_amdgcn_s_setprio(0); } while (0)
#define PG8_WAIT_V(n) asm volatile("s_waitcnt vmcnt(" #n ")" ::: "memory")
#define PG8_WAIT_L(n) asm volatile("s_waitcnt lgkmcnt(" #n ")" ::: "memory")
#define PG8_BAR __builtin_amdgcn_s_barrier()
#define PG8_SCHED __builtin_amdgcn_sched_barrier(0)
    Unit cur, nxt; int ui = 0;
    if (!S.next(0, cur)) return;
    f32x4 acc[2][2][4][2];
#pragma unroll
    for (int a = 0; a < 2; ++a)
#pragma unroll
        for (int b = 0; b < 2; ++b)
#pragma unroll
            for (int m = 0; m < 4; ++m)
#pragma unroll
                for (int n = 0; n < 2; ++n) acc[a][b][m][n] = (f32x4){0.f, 0.f, 0.f, 0.f};
    bf16x8 At[4][2], B0[2][2], B1[2][2];
    const char* cA = (const char*)g.A + (size_t)cur.pm * tstep; const char* cB = (const char*)g.Bt + (size_t)cur.pn * tstep;
    S.a_ready(cur);
    if constexpr (SP2) {
        PG8_STAGE(PG8_SB(0, 0), cB, voffB); PG8_STAGE(PG8_SB(0, 1), cB + hstep, voffB); PG8_STAGE(PG8_SA(0, 0), cA, voffA); PG8_STAGE(PG8_SA(0, 1), cA + hstep, voffA);
        if (wr == 1) PG8_BAR;
        PG8_WAIT_V(2); PG8_BAR;
        PG8_STAGE(PG8_SB(1, 0), cB + kstep, voffB); PG8_STAGE(PG8_SA(1, 0), cA + kstep, voffA); PG8_STAGE(PG8_SB(1, 1), cB + hstep + kstep, voffB);
        PG8_WAIT_V(6); PG8_BAR;
    } else {
        PG8_STAGE(PG8_SB(0, 0), cB, voffB); PG8_STAGE(PG8_SA(0, 0), cA, voffA); PG8_STAGE(PG8_SB(0, 1), cB + hstep, voffB); PG8_STAGE(PG8_SA(0, 1), cA + hstep, voffA);
        if (wr == 1) PG8_BAR;
        PG8_WAIT_V(4); PG8_BAR;
        PG8_STAGE(PG8_SB(1, 0), cB + kstep, voffB); PG8_STAGE(PG8_SA(1, 0), cA + kstep, voffA); PG8_STAGE(PG8_SB(1, 1), cB + hstep + kstep, voffB);
        PG8_WAIT_V(6); PG8_BAR;
    }
    for (;;) {
        const bool has_next = S.next(ui + 1, nxt);
        const char* nA = has_next ? (const char*)g.A + (size_t)nxt.pm * tstep : cA; const char* nB = has_next ? (const char*)g.Bt + (size_t)nxt.pn * tstep : cB;
        for (int t = 0; t < nt; t += 2) {
            const bool last = (t == nt - 2);
            const char* a1 = cA + (size_t)(t + 1) * kstep;
            const char* a2 = last ? nA : cA + (size_t)(t + 2) * kstep; const char* b2 = last ? nB : cB + (size_t)(t + 2) * kstep;
            const char* a3 = a2 + kstep; const char* b3 = b2 + kstep;
            if (last && has_next) S.a_ready(nxt);
            if constexpr (SP2) {
            PG8_LDB(B0, 0, 0); PG8_LDB(B1, 0, 1); PG8_SCHED; PG8_LDA(At, 0, 0); PG8_STAGE(PG8_SA(1, 1), a1 + hstep, voffA);
            PG8_WAIT_V(8); PG8_WAIT_L(0); PG8_BAR; PG8_MMA(0, 0, At, B0); PG8_MMA(0, 1, At, B1); PG8_BAR; PG8_SCHED;
            PG8_LDA(At, 0, 1); PG8_STAGE(PG8_SB(0, 0), b2, voffB); PG8_STAGE(PG8_SB(0, 1), b2 + hstep, voffB); PG8_STAGE(PG8_SA(0, 0), a2, voffA);
            PG8_WAIT_V(8); PG8_WAIT_L(0); PG8_BAR; PG8_MMA(1, 0, At, B0); PG8_MMA(1, 1, At, B1); PG8_BAR; PG8_SCHED;
            PG8_LDB(B0, 1, 0); PG8_LDB(B1, 1, 1); PG8_SCHED; PG8_LDA(At, 1, 0); PG8_STAGE(PG8_SA(0, 1), a2 + hstep, voffA);
            PG8_WAIT_V(8); PG8_WAIT_L(0); PG8_BAR; PG8_MMA(0, 0, At, B0); PG8_MMA(0, 1, At, B1); PG8_BAR; PG8_SCHED;
            PG8_LDA(At, 1, 1); PG8_STAGE(PG8_SB(1, 0), b3, voffB); PG8_STAGE(PG8_SB(1, 1), b3 + hstep, voffB); PG8_STAGE(PG8_SA(1, 0), a3, voffA);
            PG8_WAIT_V(8); PG8_WAIT_L(0); PG8_BAR; PG8_MMA(1, 0, At, B0); PG8_MMA(1, 1, At, B1); PG8_BAR; PG8_SCHED;
            } else {
            PG8_LDB(B0, 0, 0); PG8_SCHED; PG8_LDA(At, 0, 0); PG8_STAGE(PG8_SA(1, 1), a1 + hstep, voffA);
            PG8_WAIT_L(8); PG8_BAR; PG8_WAIT_L(0); PG8_MMA(0, 0, At, B0); PG8_BAR; PG8_SCHED;
            PG8_LDB(B1, 0, 1); PG8_STAGE(PG8_SB(0, 0), b2, voffB);
            PG8_BAR; PG8_WAIT_L(0); PG8_MMA(0, 1, At, B1); PG8_BAR;
            PG8_LDA(At, 0, 1); PG8_STAGE(PG8_SA(0, 0), a2, voffA);
            PG8_BAR; PG8_WAIT_L(0); PG8_MMA(1, 0, At, B0); PG8_BAR; PG8_SCHED;
            PG8_STAGE(PG8_SB(0, 1), b2 + hstep, voffB);
            PG8_WAIT_V(6); PG8_BAR; PG8_MMA(1, 1, At, B1); PG8_BAR;
            PG8_LDB(B0, 1, 0); PG8_SCHED; PG8_LDA(At, 1, 0); PG8_STAGE(PG8_SA(0, 1), a2 + hstep, voffA);
            PG8_WAIT_L(8); PG8_BAR; PG8_WAIT_L(0); PG8_MMA(0, 0, At, B0); PG8_BAR; PG8_SCHED;
            PG8_LDB(B1, 1, 1); PG8_STAGE(PG8_SB(1, 0), b3, voffB);
            PG8_BAR; PG8_WAIT_L(0); PG8_MMA(0, 1, At, B1); PG8_BAR;
            PG8_LDA(At, 1, 1); PG8_STAGE(PG8_SA(1, 0), a3, voffA);
            PG8_BAR; PG8_WAIT_L(0); PG8_MMA(1, 0, At, B0); PG8_BAR; PG8_SCHED;
            PG8_STAGE(PG8_SB(1, 1), b3 + hstep, voffB);
            PG8_WAIT_V(6); PG8_BAR; PG8_MMA(1, 1, At, B1); PG8_BAR;
            }
        }
        if constexpr (ALIGN_EPI) { if (wr == 0) PG8_BAR; }
        if constexpr (!Epi::AFTER_DRAIN) { E(acc, cur, wr, wc, fr, fq, ui); S.done(cur); }
        if (!has_next) break;
#pragma unroll
        for (int a = 0; a < 2; ++a)
#pragma unroll
            for (int b = 0; b < 2; ++b)
#pragma unroll
                for (int m = 0; m < 4; ++m)
#pragma unroll
                    for (int n = 0; n < 2; ++n) acc[a][b][m][n] = (f32x4){0.f, 0.f, 0.f, 0.f};
        cur = nxt; cA = nA; cB = nB; ++ui;
        if constexpr (ALIGN_EPI) { if (wr == 1) PG8_BAR; }
    }
    PG8_WAIT_V(0);
    if constexpr (!ALIGN_EPI) { if (wr == 0) PG8_BAR; }
    PG8_BAR;
    if constexpr (Epi::AFTER_DRAIN) { E.fused(acc, cur, wr, wc, fr, fq, lds, wid, lane); S.done(cur); }
#undef PG8_SA
#undef PG8_SB
#undef PG8_STAGE
#undef PG8_LDA
#undef PG8_LDB
#undef PG8_MMA
#undef PG8_WAIT_V
#undef PG8_WAIT_L
#undef PG8_BAR
#undef PG8_SCHED
}
}
#define PG8_SP2 true
#define PG8_ALIGN true
namespace attn_body {
using bf16=__hip_bfloat16;
using bf16x8=__attribute__((ext_vector_type(8)))short;
using s16x4=__attribute__((ext_vector_type(4)))short;
using f32x16=__attribute__((ext_vector_type(16)))float;
using u32x4=__attribute__((ext_vector_type(4)))unsigned;
constexpr int BATCH=2,NHEAD=16,SEQ=8192,D=64,DM=NHEAD*D;
constexpr int NW=8,QBLK=32,QB=QBLK*NW,KVBLK=64,NQB=SEQ/QB;
constexpr int ATTN_PITCH=DM, ATTN_UNIT_ROWS=QB;
__device__ __forceinline__ int crow(int r,int hi){return (r&3)+8*(r>>2)+4*hi;}
#define SBAR() __builtin_amdgcn_sched_barrier(0)
__device__ __forceinline__ void cmask(f32x16&p0,f32x16&p1,int jb,int qrel,int hi){
  const float NEG=-INFINITY; int kb=64*jb+4*hi;
  #pragma unroll
  for(int r=0;r<16;++r){int kv=kb+(r&3)+8*(r>>2); if(kv>qrel)p0[r]=NEG; if(kv+32>qrel)p1[r]=NEG;}
}

constexpr int NSLOT=3, SLOTB=8192; constexpr float NEGBIG=-2048.f;
constexpr int LDS_K=0, LDS_V=NSLOT*SLOTB, LDS_WS=2*NSLOT*SLOTB, LDS_OST=LDS_WS+NW*64*4, LDS_BYTES=LDS_OST+NW*4096;
constexpr float C2=0.125f*1.4426950408889634f;
__device__ __forceinline__ void glds16(const void*gsrc,unsigned lds_dst){unsigned keep;
  asm volatile("s_mov_b32 %0, m0\n\ts_mov_b32 m0, %2\n\ts_nop 0\n\tglobal_load_lds_dwordx4 %1, off\n\ts_mov_b32 m0, %0":"=&s"(keep):"v"(gsrc),"s"(lds_dst):"memory");}
__device__ __forceinline__ float max3f(float a,float b,float c){float r;asm("v_max3_f32 %0, %1, %2, %3":"=v"(r):"v"(a),"v"(b),"v"(c));return r;}
__device__ __forceinline__ float max2f(float a,float b){float r;asm("v_max_f32_e32 %0, %1, %2":"=v"(r):"v"(a),"v"(b));return r;}
__device__ __forceinline__ float fadd_s(float a,float b){float r;asm("v_add_f32_e32 %0, %1, %2":"=v"(r):"v"(a),"v"(b));return r;}
__device__ __forceinline__ float fsub_s(float a,float b){float r;asm("v_sub_f32_e32 %0, %1, %2":"=v"(r):"v"(a),"v"(b));return r;}
typedef float f32x2_t __attribute__((ext_vector_type(2))); typedef __bf16 bf16x2_t __attribute__((ext_vector_type(2)));
__device__ __forceinline__ unsigned cvtpk_s(float lo,float hi){f32x2_t v={lo,hi};bf16x2_t b=__builtin_convertvector(v,bf16x2_t);return __builtin_bit_cast(unsigned,b);}
#define WAIT_BAR(N) asm volatile("s_waitcnt vmcnt(" #N ") lgkmcnt(0)\n\ts_barrier":::"memory")

__device__ __forceinline__ void qkt(f32x16&p0,f32x16&p1,const char*Kslot,const bf16x8*qr,const f32x16&negm,int r32,int hi){
  const char*kb=Kslot+hi*1024+r32*16;
  #pragma unroll
  for(int d0=0;d0<4;++d0){
    const bf16x8 b0=*reinterpret_cast<const bf16x8*>(kb+d0*2048);
    const bf16x8 b1=*reinterpret_cast<const bf16x8*>(kb+d0*2048+512);
    if(d0==0){p0=__builtin_amdgcn_mfma_f32_32x32x16_bf16(b0,qr[0],negm,0,0,0);p1=__builtin_amdgcn_mfma_f32_32x32x16_bf16(b1,qr[0],negm,0,0,0);}
    else{p0=__builtin_amdgcn_mfma_f32_32x32x16_bf16(b0,qr[d0],p0,0,0,0);p1=__builtin_amdgcn_mfma_f32_32x32x16_bf16(b1,qr[d0],p1,0,0,0);}}
}
typedef __attribute__((address_space(3))) const char* lds_cptr;
typedef short v4i16_t __attribute__((ext_vector_type(4)));
__device__ __forceinline__ void kload8(bf16x8*kf,lds_cptr kp){
  kf[0]=*(const __attribute__((address_space(3))) bf16x8*)(kp);      kf[1]=*(const __attribute__((address_space(3))) bf16x8*)(kp+512);
  kf[2]=*(const __attribute__((address_space(3))) bf16x8*)(kp+2048); kf[3]=*(const __attribute__((address_space(3))) bf16x8*)(kp+2560);
  kf[4]=*(const __attribute__((address_space(3))) bf16x8*)(kp+4096); kf[5]=*(const __attribute__((address_space(3))) bf16x8*)(kp+4608);
  kf[6]=*(const __attribute__((address_space(3))) bf16x8*)(kp+6144); kf[7]=*(const __attribute__((address_space(3))) bf16x8*)(kp+6656);
}
__device__ __forceinline__ void kload2(bf16x8*kf,lds_cptr kp,int j){ kf[2*j]=*(const __attribute__((address_space(3))) bf16x8*)(kp+j*2048); kf[2*j+1]=*(const __attribute__((address_space(3))) bf16x8*)(kp+j*2048+512); }
__device__ __forceinline__ s16x4 vtr(lds_cptr p){ return __builtin_bit_cast(s16x4,__builtin_amdgcn_ds_read_tr16_b64_v4i16((__attribute__((address_space(3))) v4i16_t*)p)); }
__device__ __forceinline__ float rowmax(const f32x16&p0,const f32x16&p1){
  float a=max3f(p0[0],p0[1],p1[0]),b=max3f(p0[2],p0[3],p1[1]);a=max3f(a,p1[2],p1[3]);
  #pragma unroll
  for(int r=4;r<16;r+=4){a=max3f(a,p0[r],p0[r+1]);b=max3f(b,p0[r+2],p0[r+3]);a=max3f(a,p1[r],p1[r+1]);b=max3f(b,p1[r+2],p1[r+3]);}
  const float m=max2f(a,b);
  auto rr=__builtin_amdgcn_permlane32_swap(__float_as_uint(m),__float_as_uint(m),false,false);
  return max2f(__uint_as_float(rr[0]),__uint_as_float(rr[1]));
}
__device__ __forceinline__ void pv(f32x16*o,int vb,bf16x8 pa0,bf16x8 pa1,bf16x8 pa2,bf16x8 pa3){
  #pragma unroll
  for(int d0=0;d0<2;++d0){s16x4 lo[4],hi[4];
    #pragma unroll
    for(int ks=0;ks<4;++ks){
      asm volatile("ds_read_b64_tr_b16 %0,%1 offset:%c2":"=&v"(lo[ks]):"v"(vb),"i"(d0*4096+ks*1024):"memory");
      asm volatile("ds_read_b64_tr_b16 %0,%1 offset:%c2":"=&v"(hi[ks]):"v"(vb),"i"(d0*4096+ks*1024+512):"memory");}
    asm volatile("s_waitcnt lgkmcnt(0)":::"memory");SBAR();
    #define PK(k) (bf16x8){lo[k][0],lo[k][1],lo[k][2],lo[k][3],hi[k][0],hi[k][1],hi[k][2],hi[k][3]}
    o[d0]=__builtin_amdgcn_mfma_f32_32x32x16_bf16(pa0,PK(0),o[d0],0,0,0);
    o[d0]=__builtin_amdgcn_mfma_f32_32x32x16_bf16(pa1,PK(1),o[d0],0,0,0);
    o[d0]=__builtin_amdgcn_mfma_f32_32x32x16_bf16(pa2,PK(2),o[d0],0,0,0);
    o[d0]=__builtin_amdgcn_mfma_f32_32x32x16_bf16(pa3,PK(3),o[d0],0,0,0);
    #undef PK
  }
}

#ifndef ATTN_STORE16
#define ATTN_STORE16(p,v) (*(u32x4*)(p)=(v))
#endif
template<int THRL> __device__ __forceinline__ void attn_unit(int b,int h,int qb,const bf16*Q,const bf16*__restrict__ K,const bf16*__restrict__ V,bf16*O,const unsigned*__restrict__ SEL,char*shm){
  const int tid=threadIdx.x,lane=tid&63,r32=lane&31,hi=lane>>5; const int wid=__builtin_amdgcn_readfirstlane(tid>>6);
  const long rowbase=(long)b*SEQ; const int q0=qb*QB;
  const bf16*Qw=Q+(rowbase+q0+wid*QBLK)*DM+h*D;
  const bf16*Kh=K+rowbase*DM+h*D,*Vh=V+rowbase*DM+h*D;
  const unsigned lds0=(unsigned)(uintptr_t)shm;
  float*wsf=(float*)(shm+LDS_WS)+wid*64;
  const bf16*ksrc=Kh+(long)lane*DM+wid*8;
  const bf16*vsrc=Vh+(long)(16*(wid&3)+(lane>>2))*DM+(wid>>2)*32+(lane&3)*8;
  const unsigned kdst=lds0+LDS_K+wid*1024, vdst=lds0+LDS_V+wid*1024;
  #define DMA_K(t,slot) glds16(ksrc+(long)(t)*KVBLK*DM,(unsigned)__builtin_amdgcn_readfirstlane(kdst+(slot)))
  #define DMA_V(t,slot) glds16(vsrc+(long)(t)*KVBLK*DM,(unsigned)__builtin_amdgcn_readfirstlane(vdst+(slot)))
  const int vb0=(int)(lds0+LDS_V)+((lane>>4)&1)*32+(lane&3)*8+(4*hi+((lane&15)>>2))*64;
  const char*Kbase=shm+LDS_K; bf16x8 kf[8];
  const lds_cptr shm3=(lds_cptr)shm; const lds_cptr kp0=shm3+LDS_K+hi*1024+r32*16; const lds_cptr vp0=shm3+LDS_V+((lane>>4)&1)*32+(lane&3)*8+(4*hi+((lane&15)>>2))*64;
  const int NT=(q0+QB)/KVBLK;
  DMA_K(0,0);DMA_V(0,0);DMA_K(1,SLOTB);
  bf16x8 qr[4];
  #pragma unroll
  for(int d0=0;d0<4;++d0)qr[d0]=*reinterpret_cast<const bf16x8*>(&Qw[(long)r32*DM+d0*16+hi*8]);
  float mhat=0.f,l_reg=0.f;f32x16 o[2];o[0]=f32x16{};o[1]=f32x16{};const f32x16 negm=f32x16{};
  const int qrel=wid*QBLK+r32; volatile unsigned*sel_l=(volatile unsigned*)(shm+LDS_BYTES)+wid*32; if(hi==0)sel_l[r32]=SEL[(size_t)(b*NHEAD+h)*SEQ+q0+qrel];
  #define CMASK(P0,P1,t) do{int jb_=(t)-(NT-4); if(jb_>=0){cmask(P0,P1,jb_,qrel,hi);} else if(!((sel_l[r32]>>(((t)>>2)&31))&1u)){ _Pragma("unroll") for(int r_=0;r_<16;++r_){P0[r_]=NEGBIG;P1[r_]=NEGBIG;} } }while(0)
  bool resc=false;
  #define START(P0,P1) do{ const float rm=rowmax(P0,P1); resc=false; \
    { const float dl=rm; mhat=fadd_s(mhat,dl); \
      _Pragma("unroll") for(int r=0;r<16;++r){P0[r]=fsub_s(P0[r],dl);P1[r]=fsub_s(P1[r],dl);} \
      } \
    _Pragma("unroll") for(int r=0;r<16;++r)P0[r]=__builtin_amdgcn_exp2f(P0[r]); }while(0)
  #define RESC() do{ if(resc){ asm volatile("s_waitcnt lgkmcnt(0)":::"memory"); \
      _Pragma("unroll") for(int d_=0;d_<2;++d_) _Pragma("unroll") for(int r=0;r<16;++r)o[d_][r]*=wsf[crow(r,hi)]; } }while(0)
  f32x16 pA0,pA1,pB0,pB1;
  int sl_prev=0,sl_cur=0,sl_next=SLOTB;
  #define ROT() do{sl_prev=sl_cur;sl_cur=sl_next;sl_next=(sl_next==(NSLOT-1)*SLOTB)?0:sl_next+SLOTB;}while(0)
  DMA_K(2,2*SLOTB);
  WAIT_BAR(3);
  qkt(pA0,pA1,Kbase,qr,negm,r32,hi);asm volatile("s_nop 15\n\ts_nop 7":"+v"(pA0),"+v"(pA1));CMASK(pA0,pA1,0);
  START(pA0,pA1);
  _Pragma("unroll") for(int r=0;r<16;++r)pA1[r]=__builtin_amdgcn_exp2f(pA1[r]);
  WAIT_BAR(0);
  DMA_K(3,0);DMA_V(1,SLOTB);
  ROT();
  kload8(kf,kp0+sl_cur);
  WAIT_BAR(2);
  s16x4 vlo[8],vhi[8]; u32x4 pw0,pw1,pw2,pw3;
  #define PKW(P,B) cvtpk_s(P[B],P[B+1])
  #define PAF(k) __builtin_bit_cast(bf16x8,pw##k)
  #define VFR(i) (bf16x8){vlo[i][0],vlo[i][1],vlo[i][2],vlo[i][3],vhi[i][0],vhi[i][1],vhi[i][2],vhi[i][3]}
  #define PIN(x) asm volatile("":"+v"(x))
  #define MX3(a,b,c) __builtin_fmaxf(__builtin_fmaxf((a),(b)),(c))
  #define GAPA(MF,A0,A1,A2,A3,W0,W1,PW) do{ MF; sacc+=A0; sacc+=A1; sacc+=A2; sacc+=A3; PIN(sacc); W0; W1; PIN(PW); SBAR(); }while(0)
  #define EX(v) __builtin_amdgcn_exp2f(v)
  #define GAPB(MF,X,B) do{ MF; X[B]=EX(X[B]); X[B+1]=EX(X[B+1]); X[B+2]=EX(X[B+2]); X[B+3]=EX(X[B+3]); PIN(X); SBAR(); }while(0)
  #define VRD(i) do{ vlo[i]=vtr(vp_+(((i)>>2)*4096+((i)&3)*1024)); vhi[i]=vtr(vp_+(((i)>>2)*4096+((i)&3)*1024+512)); }while(0)
  #define KRD(G,j) do{ if(G){ kload2(kf,kp0+sl_next,j); SBAR(); } }while(0)
  #define STEP(C0,C1,P0,P1,t,GK,GV,GL) do{ SBAR(); \
    const lds_cptr vp_=vp0+sl_prev; \
    VRD(0); SBAR(); float sacc=(P0[0]+P0[1]); \
    GAPA(C0=__builtin_amdgcn_mfma_f32_32x32x16_bf16(kf[0],qr[0],negm,0,0,0), P0[2],P0[3],P0[4],P0[5],     pw0[0]=PKW(P0,0), pw0[1]=PKW(P0,2), pw0); \
    VRD(4); SBAR(); GAPA(C1=__builtin_amdgcn_mfma_f32_32x32x16_bf16(kf[1],qr[0],negm,0,0,0), P0[6],P0[7],P0[8],P0[9],     pw0[2]=PKW(P0,4), pw0[3]=PKW(P0,6), pw0); \
    VRD(1); SBAR(); GAPA(C0=__builtin_amdgcn_mfma_f32_32x32x16_bf16(kf[2],qr[1],C0,0,0,0),   P0[10],P0[11],P0[12],P0[13], pw1[0]=PKW(P0,8), pw1[1]=PKW(P0,10), pw1); \
    VRD(5); SBAR(); GAPA(C1=__builtin_amdgcn_mfma_f32_32x32x16_bf16(kf[3],qr[1],C1,0,0,0),   P0[14],P0[15],P1[0],P1[1],   pw1[2]=PKW(P0,12),pw1[3]=PKW(P0,14), pw1); \
    VRD(2); SBAR(); GAPA(C0=__builtin_amdgcn_mfma_f32_32x32x16_bf16(kf[4],qr[2],C0,0,0,0),   P1[2],P1[3],P1[4],P1[5],     pw2[0]=PKW(P1,0), pw2[1]=PKW(P1,2), pw2); \
    VRD(6); SBAR(); GAPA(C1=__builtin_amdgcn_mfma_f32_32x32x16_bf16(kf[5],qr[2],C1,0,0,0),   P1[6],P1[7],P1[8],P1[9],     pw2[2]=PKW(P1,4), pw2[3]=PKW(P1,6), pw2); \
    VRD(3); SBAR(); GAPA(C0=__builtin_amdgcn_mfma_f32_32x32x16_bf16(kf[6],qr[3],C0,0,0,0),   P1[10],P1[11],P1[12],P1[13], pw3[0]=PKW(P1,8), pw3[1]=PKW(P1,10), pw3); \
    VRD(7); SBAR(); GAPA(C1=__builtin_amdgcn_mfma_f32_32x32x16_bf16(kf[7],qr[3],C1,0,0,0),   P1[14],P1[15],0.f,0.f,       pw3[2]=PKW(P1,12),pw3[3]=PKW(P1,14), pw3); \
    l_reg+=sacc; \
    if(GK){DMA_K((t)+3,sl_cur);} if(GV){DMA_V((t)+1,sl_next);} \
    _Pragma("unroll") for(int r=0;r<16;++r){C0[r]-=mhat;C1[r]-=mhat;} \
    CMASK(C0,C1,t); \
    { float a=MX3(C0[0],C0[1],C1[0]),b=MX3(C0[2],C0[3],C1[1]); a=MX3(a,C1[2],C1[3]); \
      _Pragma("unroll") for(int r=4;r<16;r+=4){a=MX3(a,C0[r],C0[r+1]);b=MX3(b,C0[r+2],C0[r+3]);a=MX3(a,C1[r],C1[r+1]);b=MX3(b,C1[r+2],C1[r+3]);} \
      float rm=__builtin_fmaxf(a,b); { auto rr=__builtin_amdgcn_permlane32_swap(__float_as_uint(rm),__float_as_uint(rm),false,false); rm=__builtin_fmaxf(__uint_as_float(rr[0]),__uint_as_float(rr[1])); } \
      resc=false; \
      if(__builtin_expect(__any(rm>(float)THRL),0)){ const float dl=__builtin_fmaxf(rm,0.f); mhat+=dl; \
        _Pragma("unroll") for(int r=0;r<16;++r){C0[r]-=dl;C1[r]-=dl;} \
        const float f=__builtin_amdgcn_exp2f(-dl); l_reg*=f; if(hi==0)wsf[r32]=f; resc=true; } } \
    SBAR(); \
    GAPB(o[0]=__builtin_amdgcn_mfma_f32_32x32x16_bf16(PAF(0),VFR(0),o[0],0,0,0), C0,0); \
    GAPB(o[1]=__builtin_amdgcn_mfma_f32_32x32x16_bf16(PAF(0),VFR(4),o[1],0,0,0), C0,4); \
    KRD(GL,0); GAPB(o[0]=__builtin_amdgcn_mfma_f32_32x32x16_bf16(PAF(1),VFR(1),o[0],0,0,0), C0,8); \
    KRD(GL,1); GAPB(o[1]=__builtin_amdgcn_mfma_f32_32x32x16_bf16(PAF(1),VFR(5),o[1],0,0,0), C0,12); \
    KRD(GL,2); GAPB(o[0]=__builtin_amdgcn_mfma_f32_32x32x16_bf16(PAF(2),VFR(2),o[0],0,0,0), C1,0); \
    KRD(GL,3); GAPB(o[1]=__builtin_amdgcn_mfma_f32_32x32x16_bf16(PAF(2),VFR(6),o[1],0,0,0), C1,4); \
    GAPB(o[0]=__builtin_amdgcn_mfma_f32_32x32x16_bf16(PAF(3),VFR(3),o[0],0,0,0), C1,8); \
    GAPB(o[1]=__builtin_amdgcn_mfma_f32_32x32x16_bf16(PAF(3),VFR(7),o[1],0,0,0), C1,12); \
    }while(0)
  int t=1;
  #undef CMASK
  #define CMASK(P0,P1,t) do{ if(!((sel_l[r32]>>(((t)>>2)&31))&1u)){ _Pragma("unroll") for(int r_=0;r_<16;++r_){P0[r_]=NEGBIG;P1[r_]=NEGBIG;} } }while(0)
  for(;t+5<NT;t+=2){
    STEP(pB0,pB1,pA0,pA1,t,true,true,true);     WAIT_BAR(2); RESC(); ROT();
    STEP(pA0,pA1,pB0,pB1,t+1,true,true,true);   WAIT_BAR(2); RESC(); ROT();
  }
  #undef CMASK
  #define CMASK(P0,P1,t) do{int jb_=(t)-(NT-4); if(jb_>=0){cmask(P0,P1,jb_,qrel,hi);} else if(!((sel_l[r32]>>(((t)>>2)&31))&1u)){ _Pragma("unroll") for(int r_=0;r_<16;++r_){P0[r_]=NEGBIG;P1[r_]=NEGBIG;} } }while(0)
  #define ENDW(tt) do{ if((tt)+3<NT){WAIT_BAR(2);} else if((tt)+2<NT){WAIT_BAR(1);} else {WAIT_BAR(0);} }while(0)
  for(;t+1<NT;t+=2){
    STEP(pB0,pB1,pA0,pA1,t,(t+3<NT),(t+1<NT),(t+1<NT));       ENDW(t);   RESC(); ROT();
    STEP(pA0,pA1,pB0,pB1,t+1,(t+4<NT),(t+2<NT),(t+2<NT));     ENDW(t+1); RESC(); ROT();
  }
  STEP(pB0,pB1,pA0,pA1,NT-1,false,false,false); RESC();
  { float sacc=pB0[0]+pB0[1]; _Pragma("unroll") for(int r=2;r<16;++r)sacc+=pB0[r]; _Pragma("unroll") for(int r=0;r<16;++r)sacc+=pB1[r]; l_reg+=sacc;
    pw0=(u32x4){PKW(pB0,0),PKW(pB0,2),PKW(pB0,4),PKW(pB0,6)};pw1=(u32x4){PKW(pB0,8),PKW(pB0,10),PKW(pB0,12),PKW(pB0,14)};pw2=(u32x4){PKW(pB1,0),PKW(pB1,2),PKW(pB1,4),PKW(pB1,6)};pw3=(u32x4){PKW(pB1,8),PKW(pB1,10),PKW(pB1,12),PKW(pB1,14)};
    SBAR(); pv(o,vb0+sl_cur,PAF(0),PAF(1),PAF(2),PAF(3)); }
  #undef PKW
  #undef PAF
  #undef VFR
  #undef PIN
  #undef MX3
  #undef GAPA
  #undef GAPB
  #undef EX
  #undef VRD
  #undef KRD
  #undef STEP
  #undef ENDW
  {auto rr=__builtin_amdgcn_permlane32_swap(__float_as_uint(l_reg),__float_as_uint(l_reg),false,false);l_reg=__uint_as_float(rr[0])+__uint_as_float(rr[1]);}
  if(hi==0)wsf[32+r32]=l_reg;asm volatile("s_waitcnt lgkmcnt(0)":::"memory");
  float rli[16];
  #pragma unroll
  for(int r=0;r<16;++r)rli[r]=__builtin_amdgcn_rcpf(wsf[32+crow(r,hi)]);
  bf16*Ow=O+(rowbase+q0+wid*QBLK)*DM+h*D;
  { bf16*stg=(bf16*)(shm+LDS_OST)+wid*2048;
    #pragma unroll
    for(int r=0;r<16;++r){const int orow=crow(r,hi);
      #pragma unroll
      for(int d0=0;d0<2;++d0)stg[orow*64+d0*32+r32]=__float2bfloat16(o[d0][r]*rli[r]);}
    asm volatile("s_waitcnt lgkmcnt(0)":::"memory");
    #pragma unroll
    for(int i=0;i<4;++i){const int row=i*8+(lane>>3),ch=lane&7; const u32x4 v=*(const u32x4*)(stg+row*64+ch*8); ATTN_STORE16(Ow+(long)row*DM+ch*8,v);} }
  asm volatile("s_waitcnt lgkmcnt(0)\n\ts_barrier":::"memory");
  #undef DMA_K
  #undef DMA_V
  #undef CMASK
  #undef START
  #undef RESC
  #undef ROT
}
constexpr int ATTN_LDS_BYTES=LDS_BYTES;
struct AttnTensors { const bf16* Q; const bf16* K; const bf16* V; bf16* O; const unsigned* SEL; };
struct AttnUnit { int bh; int qb; };
struct StaticOrder {
  int vcu;
  __device__ __forceinline__ explicit StaticOrder(int grid,int block):vcu((block%8)*(grid/8)+block/8){}
  __device__ __forceinline__ bool next(int i,AttnUnit&u)const{ if(i>=4)return false; const int s=vcu&7; u.bh=vcu>>3; u.qb=(i==0)?s:(i==1)?15-s:(i==2)?16+s:31-s; return true; }
  __device__ __forceinline__ void a_ready(const AttnUnit&)const{}
  __device__ __forceinline__ void done(const AttnUnit&)const{}
};
template<class Sched,int THRL=8> __device__ __forceinline__ void attn_phase(char*lds,const AttnTensors&T,const Sched&S){
  AttnUnit u;
  for(int i=0;S.next(i,u);++i){ S.a_ready(u); attn_unit<THRL>(u.bh/NHEAD,u.bh%NHEAD,u.qb,T.Q,T.K,T.V,T.O,T.SEL,lds); S.done(u); }
}
#undef SBAR
#undef WAIT_BAR
}
#define LAS __attribute__((address_space(3)))
typedef unsigned short bf16;
typedef unsigned v4u __attribute__((ext_vector_type(4)));
typedef unsigned v2u __attribute__((ext_vector_type(2)));
typedef float f32x4 __attribute__((ext_vector_type(4)));
typedef short bf16x8 __attribute__((ext_vector_type(8)));
typedef short s16x4 __attribute__((ext_vector_type(4)));
constexpr int NWAVES = 8, NTHR = 512;
constexpr int SEQ = 8192, DM = 1024, M = 16384, FF = 2816, ABIN = 2560, CIN = 3072;
constexpr float C2 = 0.125f * 1.4426950408889634f;
constexpr size_t MiB = 1u << 20;
__host__ __device__ constexpr size_t ws_wgu(int f) { return (f == 0 ? 2 : f == 1 ? 13 : f == 2 ? 42 : 53) * MiB; }
__host__ __device__ constexpr size_t ws_wd(int f) { return (f == 0 ? 48 : f == 1 ? 59 : f == 2 ? 128 : 139) * (MiB / 2); }
constexpr size_t WS_WABIN = 35 * MiB, WS_WABOUT = 40 * MiB, WS_WCIN = 75 * MiB, WS_WCOUT = 81 * MiB;
constexpr size_t WS_PO2 = 2 * MiB, WS_LSE = 34 * MiB;
constexpr size_t WS_CNT = 131072;
constexpr size_t WS_LIST = 248 * MiB;
constexpr size_t WS_WSB = 83 * MiB;
constexpr size_t WS_PART = 84 * MiB;
constexpr size_t WS_KM = 85 * MiB;
constexpr size_t WS_SEL = 86 * MiB;
constexpr size_t WS_XB = 88 * MiB;
constexpr size_t WS_ACT = 120 * MiB;
constexpr size_t WS_MIX = 216 * MiB;
constexpr size_t WS_END = 256 * MiB;
constexpr int LDS_BYTES = 147456;
constexpr int MISC_OFF = 131072 + 320;
constexpr size_t WS_BAR = 65536;

__device__ __forceinline__ unsigned f2bf(float f) { unsigned u = __builtin_bit_cast(unsigned, f); return (u + 0x7fffu + ((u >> 16) & 1u)) >> 16; }
typedef float f32x2_t __attribute__((ext_vector_type(2))); typedef __bf16 bf16x2_t __attribute__((ext_vector_type(2)));
__device__ __forceinline__ unsigned pk2(float lo, float hi) { f32x2_t v = {lo, hi}; bf16x2_t b = __builtin_convertvector(v, bf16x2_t); return __builtin_bit_cast(unsigned, b); }
__device__ __forceinline__ float bf2f(unsigned short b) { return __builtin_bit_cast(float, (unsigned)b << 16); }
__device__ __forceinline__ float wave_sum(float v) {
#pragma unroll
    for (int o = 1; o < 64; o <<= 1) v += __shfl_xor(v, o);
    return v;
}
__device__ __forceinline__ float gelu_tanh(float x) {
    const float y = 0.7978845608028654f * (x + 0.044715f * x * x * x);
    return x * __builtin_amdgcn_rcpf(1.0f + __builtin_amdgcn_exp2f(-2.0f * 1.4426950408889634f * y));
}
constexpr int TP_STRIDE = 136;
__device__ __forceinline__ void p0_transpose_item(const float* W, int K, int N, bf16* WT, int mode, const float* gain, LAS unsigned char* scr, int item, int lane) {
    const int nblk = N / 64, kb = item / nblk, nb = item % nblk, k0 = 64 * kb, n0 = 64 * nb;
    const int d0 = (mode == 0) ? n0 : ((n0 >> 7) * 256 + (n0 & 127) + (mode == 2 ? 128 : 0));
    const int kr = lane >> 4, nc = (lane & 15) * 4;
    f32x4 v[16];
#pragma unroll
    for (int i = 0; i < 16; ++i) v[i] = *(const f32x4*)(W + (size_t)(k0 + 4 * i + kr) * N + n0 + nc);
#pragma unroll
    for (int i = 0; i < 16; ++i) { const float gk = gain ? gain[k0 + 4 * i + kr] : 1.0f; v2u w; w.x = pk2(v[i][0] * gk, v[i][1] * gk); w.y = pk2(v[i][2] * gk, v[i][3] * gk);
        *(LAS v2u*)(scr + (4 * i + kr) * TP_STRIDE + nc * 2) = w; }
    asm volatile("s_waitcnt lgkmcnt(0)" ::: "memory");
    const int g = lane >> 4, li = lane & 15, qq = li >> 2, pp = li & 3;
#pragma unroll
    for (int nb16 = 0; nb16 < 4; ++nb16)
#pragma unroll
        for (int half = 0; half < 2; ++half) { const int kc = g + 4 * half;
            LAS unsigned char* a = scr + (8 * kc + qq) * TP_STRIDE + (16 * nb16 + 4 * pp) * 2;
            const s16x4 lo = __builtin_bit_cast(s16x4, __builtin_amdgcn_ds_read_tr16_b64_v4i16((LAS s16x4*)a));
            const s16x4 hi = __builtin_bit_cast(s16x4, __builtin_amdgcn_ds_read_tr16_b64_v4i16((LAS s16x4*)(a + 4 * TP_STRIDE)));
            const bf16x8 o = (bf16x8){lo[0], lo[1], lo[2], lo[3], hi[0], hi[1], hi[2], hi[3]};
            *(bf16x8*)(WT + (size_t)(d0 + 16 * nb16 + li) * K + k0 + 8 * kc) = o; }
    asm volatile("s_waitcnt lgkmcnt(0)" ::: "memory");
}
#define XB_TMO      128
#define XB_XCNT(j)  (256  + 64 * (j))
#define XB_XSUB(j)  (1280 + 64 * (j))
#define XB_XGEN(j)  (2304 + 64 * (j))
#define XB_TOP      3328
#define XB_TOPGEN   3392
#define XCD_BAR_WORDS 3456
#define XB_SPIN_CAP (1u << 18)

__device__ __forceinline__ unsigned xb_ld(unsigned* p)              { return __hip_atomic_load(p, __ATOMIC_RELAXED, __HIP_MEMORY_SCOPE_AGENT); }
__device__ __forceinline__ unsigned xb_add(unsigned* p, unsigned v) { return __hip_atomic_fetch_add(p, v, __ATOMIC_RELAXED, __HIP_MEMORY_SCOPE_AGENT); }
__device__ __forceinline__ unsigned xb_xcc_id() { return (unsigned)__builtin_amdgcn_s_getreg((3 << 11) | 20) & 0xFu; }
#define XB_SPIN(cond, bar) do { unsigned _sp = 0; while (cond) { __builtin_amdgcn_s_sleep(1); \
    if ((++_sp & 255u) == 0u) { if (xb_ld(&(bar)[XB_TMO])) break; if (_sp > XB_SPIN_CAP) { atomicAdd(&(bar)[XB_TMO], 1u); break; } } } } while (0)

struct XcdBarrier {
    unsigned* bar; unsigned x;
    volatile LAS unsigned* st;
};

__device__ __forceinline__ XcdBarrier xcd_barrier_post(unsigned* bar, volatile LAS unsigned* st) {
    XcdBarrier b; b.bar = bar; b.x = xb_xcc_id(); b.st = st;
    if (threadIdx.x == 0) (void)xb_add(&bar[XB_XCNT(b.x)], 1u);
    return b;
}
__device__ __forceinline__ void xcd_barrier_complete(unsigned* bar, unsigned x, unsigned& nloc, unsigned& nx) {
    const unsigned G = gridDim.x * gridDim.y * gridDim.z;
    unsigned sum, cnt, mine, sp = 0u;
    for (;;) {
        sum = 0u; cnt = 0u; mine = 0u;
#pragma unroll
        for (unsigned j = 0; j < 16; ++j) { const unsigned c = xb_ld(&bar[XB_XCNT(j)]); sum += c; cnt += (c > 0u) ? 1u : 0u; mine = (j == x) ? c : mine; }
        if (sum == G) break;
        __builtin_amdgcn_s_sleep(1);
        if ((++sp & 255u) == 0u) { if (xb_ld(&bar[XB_TMO])) break; if (sp > XB_SPIN_CAP) { atomicAdd(&bar[XB_TMO], 1u); break; } }
    }
    nloc = mine > 0u ? mine : 1u; nx = cnt > 0u ? cnt : 1u;
}

__device__ __forceinline__ void xcd_barrier(const XcdBarrier& b) {
    asm volatile("s_waitcnt vmcnt(0)" ::: "memory");
    __syncthreads();
    if (threadIdx.x == 0) {
        unsigned* bar = b.bar;
        __builtin_amdgcn_s_waitcnt(0);
        unsigned nloc = b.st[0], nx = b.st[1];
        if (nloc == 0u) { xcd_barrier_complete(bar, b.x, nloc, nx); b.st[0] = nloc; b.st[1] = nx; }
        const unsigned old = xb_add(&bar[XB_XSUB(b.x)], 1u);
        const unsigned gen = old / nloc;
        if (old + 1u == (gen + 1u) * nloc) {
            __builtin_amdgcn_fence(__ATOMIC_RELEASE, "agent");
            asm volatile("s_waitcnt vmcnt(0)" ::: "memory");
            const unsigned og = xb_add(&bar[XB_TOP], 1u);
            const unsigned tg = og / nx;
            if (og + 1u == (tg + 1u) * nx) xb_add(&bar[XB_TOPGEN], 1u);
            else XB_SPIN(xb_ld(&bar[XB_TOPGEN]) == tg, bar);
            __builtin_amdgcn_fence(__ATOMIC_ACQUIRE, "agent");
            xb_add(&bar[XB_XGEN(b.x)], 1u);
            asm volatile("s_waitcnt vmcnt(0)" ::: "memory");
        } else {
            XB_SPIN(xb_ld(&bar[XB_XGEN(b.x)]) == gen, bar);
            __builtin_amdgcn_fence(__ATOMIC_ACQUIRE, "agent");
            asm volatile("s_waitcnt vmcnt(0)" ::: "memory");
        }
    }
    __syncthreads();
}

struct EpiResidNorm {
    static constexpr bool PERM = true, AFTER_DRAIN = true;
    const float* base; float* out; float* part; const float* gfin; float alpha; XcdBarrier xb;
    __device__ __forceinline__ void fused(pg8::f32x4 (&acc)[2][2][4][2], const pg8::Unit& u, int wr, int wc, int fr, int fq, LAS unsigned char* lds, int wid, int lane) const {
        const int row0 = u.pm * pg8::BM + wr * 64 + fr; const int col0 = u.pn * pg8::BM + wc * 32 + 8 * fq;
#pragma unroll
        for (int ai = 0; ai < 2; ++ai)
#pragma unroll
            for (int m = 0; m < 4; ++m) { const int row = row0 + ai * pg8::HALF + m * 16; float ss = 0.f;
#pragma unroll
                for (int bj = 0; bj < 2; ++bj) { const size_t off = (size_t)row * 1024 + col0 + bj * pg8::HALF;
                    const pg8::f32x4 b0 = *(const pg8::f32x4*)(base + off), b1 = *(const pg8::f32x4*)(base + off + 4);
                    const pg8::f32x4 v0 = b0 + acc[ai][bj][m][0] * alpha, v1 = b1 + acc[ai][bj][m][1] * alpha;
                    acc[ai][bj][m][0] = v0; acc[ai][bj][m][1] = v1;
                    ss += ((v0[0] * v0[0] + v0[1] * v0[1]) + (v0[2] * v0[2] + v0[3] * v0[3])) + ((v1[0] * v1[0] + v1[1] * v1[1]) + (v1[2] * v1[2] + v1[3] * v1[3])); }
                ss += __shfl_xor(ss, 16); ss += __shfl_xor(ss, 32);
                if (fq == 0) part[(size_t)row * 16 + u.pn * 4 + wc] = ss; }
        xcd_barrier(xb);
#pragma unroll
        for (int ai = 0; ai < 2; ++ai)
#pragma unroll
            for (int m = 0; m < 4; ++m) { const int row = row0 + ai * pg8::HALF + m * 16; const float rs = pg8::row_rstd(part, row);
#pragma unroll
                for (int bj = 0; bj < 2; ++bj) { const size_t off = (size_t)row * 1024 + col0 + bj * pg8::HALF;
                    const pg8::f32x4 g0 = *(const pg8::f32x4*)(gfin + col0 + bj * pg8::HALF), g1 = *(const pg8::f32x4*)(gfin + col0 + bj * pg8::HALF + 4);
                    *(pg8::f32x4*)(out + off) = acc[ai][bj][m][0] * rs * g0; *(pg8::f32x4*)(out + off + 4) = acc[ai][bj][m][1] * rs * g1; } }
    }
};
constexpr int RSTD_OFF = 131072 + 1024;
__device__ __forceinline__ void rstd_table(const float* part, LAS unsigned char* lds, const pg8::StaticOrder& S) {
    LAS float* T = (LAS float*)(lds + RSTD_OFF);
    const int tid = threadIdx.x;
#pragma unroll
    for (int pass = 0; pass < 3; ++pass) { const int i = 2 * pass + (tid >> 8); pg8::Unit u; if (S.next(i, u)) T[i * 256 + (tid & 255)] = pg8::row_rstd(part, u.pm * 256 + (tid & 255)); }
    __syncthreads();
}
struct Args { const float* in[18]; float* out; unsigned char* ws; int ph_lo, ph_hi; };

constexpr int I_G = (DM / 64) * (FF / 64), I_D = (FF / 64) * (DM / 64), I_ABIN = (DM / 64) * (ABIN / 64), I_SQ = (DM / 64) * (DM / 64), I_CIN = (DM / 64) * (CIN / 64);
__device__ __forceinline__ constexpr int mat_items(int id) { return id < 0 ? 0 : id < 4 ? 2 * I_G : id < 8 ? I_D : id == 8 ? I_ABIN : id == 10 ? I_CIN : I_SQ; }
__device__ __forceinline__ void conv_item(const Args& A, LAS unsigned char* scr, int lane, int id, int r) {
    unsigned char* ws = A.ws;
    if (id < 4) { const int f = id, layer = f >> 1, second = f & 1; const float* gain = A.in[second ? 6 : 1] + layer * DM; bf16* wgu = (bf16*)(ws + ws_wgu(f));
        if (r < I_G) p0_transpose_item(A.in[second ? 7 : 2] + (size_t)layer * DM * FF, DM, FF, wgu, 1, gain, scr, r, lane);
        else p0_transpose_item(A.in[second ? 8 : 3] + (size_t)layer * DM * FF, DM, FF, wgu, 2, gain, scr, r - I_G, lane); }
    else if (id < 8) { const int f = id - 4, layer = f >> 1, second = f & 1; p0_transpose_item(A.in[second ? 9 : 4] + (size_t)layer * FF * DM, FF, DM, (bf16*)(ws + ws_wd(f)), 0, nullptr, scr, r, lane); }
    else if (id == 8) p0_transpose_item(A.in[10], DM, ABIN, (bf16*)(ws + WS_WABIN), 0, A.in[5], scr, r, lane);
    else if (id == 9) p0_transpose_item(A.in[14], DM, DM, (bf16*)(ws + WS_WABOUT), 0, nullptr, scr, r, lane);
    else if (id == 10) p0_transpose_item(A.in[15], DM, CIN, (bf16*)(ws + WS_WCIN), 0, A.in[5] + DM, scr, r, lane);
    else p0_transpose_item(A.in[16], DM, DM, (bf16*)(ws + WS_WCOUT), 0, nullptr, scr, r, lane);
}
__device__ __forceinline__ void conv_set(const Args& A, LAS unsigned char* lds, int wave, int lane, int gw, int NGW, int id0, int id1, int id2) {
    LAS unsigned char* scr = lds + wave * 16384;
    const int n0 = mat_items(id0), n1 = mat_items(id1), n2 = mat_items(id2);
    for (int it = gw; it < n0 + n1 + n2; it += NGW) {
        if (it < n0) conv_item(A, scr, lane, id0, it); else if (it < n0 + n1) conv_item(A, scr, lane, id1, it - n0); else conv_item(A, scr, lane, id2, it - n0 - n1); }
}
__device__ __forceinline__ void conv_idle(const Args& A, LAS unsigned char* lds, int id0, int id1, int id2) {
    if (blockIdx.x >= 128) { const int tid_ = threadIdx.x; conv_set(A, lds, __builtin_amdgcn_readfirstlane(tid_ >> 6), tid_ & 63, ((int)blockIdx.x - 128) * NWAVES + (tid_ >> 6), ((int)gridDim.x - 128) * NWAVES, id0, id1, id2); }
}
__device__ __forceinline__ void phase_prologue(const Args& A, LAS unsigned char* lds, int wave, int lane) {
    const int gw = blockIdx.x * NWAVES + wave, NGW = gridDim.x * NWAVES;
    unsigned char* ws = A.ws;
    conv_set(A, lds, wave, lane, gw, NGW, 0, 4, 3);
    { const float* wsp = A.in[12]; bf16* o = (bf16*)(ws + WS_WSB);
      for (int i = blockIdx.x * NTHR + threadIdx.x; i < 4 * 128 * 128; i += gridDim.x * NTHR) { const int p = (i >> 7) & 127, q = i & 127; o[i] = (bf16)f2bf(q <= p ? wsp[i] : 0.f); } }
    const float* x = A.in[0]; bf16* xb = (bf16*)(ws + WS_XB); float* part = (float*)(ws + WS_PART);
    for (int m = gw; m < M; m += NGW) {
        const f32x4* xr = (const f32x4*)(x + (size_t)m * DM) + lane; f32x4 v[4]; float s = 0.f;
#pragma unroll
        for (int j = 0; j < 4; ++j) { v[j] = xr[64 * j]; s += (v[j][0] * v[j][0] + v[j][1] * v[j][1]) + (v[j][2] * v[j][2] + v[j][3] * v[j][3]); }
        s = wave_sum(s);
        v2u* o8 = (v2u*)(xb + (size_t)m * DM) + lane;
#pragma unroll
        for (int j = 0; j < 4; ++j) { v2u w; w.x = pk2(v[j][0], v[j][1]); w.y = pk2(v[j][2], v[j][3]); o8[64 * j] = w; }
        if (lane < 16) part[(size_t)m * 16 + lane] = (lane == 0) ? s : 0.f;
    }
}

constexpr int GV_STRIDE = 272;
__device__ __forceinline__ void gate_unit(const Args& A, LAS unsigned char* lds, int unit, int wave, int lane) {
    const int g4 = unit & 3, n = (unit >> 2) & 63, b = unit >> 8;
    const size_t R0 = (size_t)b * SEQ + (size_t)n * 128;
    const bf16* Z = (const bf16*)(A.ws + WS_ACT); bf16* MIX = (bf16*)(A.ws + WS_MIX); const bf16* WsB = (const bf16*)(A.ws + WS_WSB) + (size_t)g4 * 128 * 128;
    const float* vnorm = A.in[11] + g4 * 128; const float* bsp = A.in[13] + g4 * 128;
    const int tid = threadIdx.x;
    { const int row = tid >> 2, qt = tid & 3; const bf16* vp = Z + (R0 + row) * ABIN + 2048 + 128 * g4 + 32 * qt;
      float v[32]; float ss = 0.f;
#pragma unroll
      for (int i = 0; i < 4; ++i) { const bf16x8 raw = *(const bf16x8*)(vp + 8 * i);
#pragma unroll
          for (int e = 0; e < 8; ++e) { const float gl = gelu_tanh(bf2f((unsigned short)raw[e])); v[8 * i + e] = gl; ss += gl * gl; } }
      ss += __shfl_xor(ss, 1); ss += __shfl_xor(ss, 2);
      const float rs = rsqrtf(ss * (1.0f / 128.0f) + 1e-6f);
#pragma unroll
      for (int i = 0; i < 4; ++i) { const f32x4 g0 = *(const f32x4*)(vnorm + 32 * qt + 8 * i), g1 = *(const f32x4*)(vnorm + 32 * qt + 8 * i + 4);
          v4u w; w.x = pk2(v[8 * i] * rs * g0[0], v[8 * i + 1] * rs * g0[1]); w.y = pk2(v[8 * i + 2] * rs * g0[2], v[8 * i + 3] * rs * g0[3]);
          w.z = pk2(v[8 * i + 4] * rs * g1[0], v[8 * i + 5] * rs * g1[1]); w.w = pk2(v[8 * i + 6] * rs * g1[2], v[8 * i + 7] * rs * g1[3]);
          *(LAS v4u*)(lds + row * GV_STRIDE + qt * 64 + i * 16) = w; } }
    __syncthreads();
    const int pl = lane & 15, g = lane >> 4, qq = pl >> 2, pp = pl & 3;
    f32x4 acc[8];
#pragma unroll
    for (int cb = 0; cb < 8; ++cb) acc[cb] = (f32x4){0.f, 0.f, 0.f, 0.f};
    const int nks = (16 * wave + 15) / 32 + 1;
    for (int ks = 0; ks < nks; ++ks) {
        const bf16x8 bfrag = *(const bf16x8*)(WsB + (size_t)(16 * wave + pl) * 128 + 32 * ks + 8 * g);
        LAS unsigned char* base = lds + (32 * ks + 8 * g + qq) * GV_STRIDE + pp * 8;
#pragma unroll
        for (int cb = 0; cb < 8; ++cb) {
            const s16x4 lo = __builtin_bit_cast(s16x4, __builtin_amdgcn_ds_read_tr16_b64_v4i16((LAS s16x4*)(base + cb * 32)));
            const s16x4 hi = __builtin_bit_cast(s16x4, __builtin_amdgcn_ds_read_tr16_b64_v4i16((LAS s16x4*)(base + cb * 32 + 4 * GV_STRIDE)));
            const bf16x8 afrag = (bf16x8){lo[0], lo[1], lo[2], lo[3], hi[0], hi[1], hi[2], hi[3]};
            acc[cb] = __builtin_amdgcn_mfma_f32_16x16x32_bf16(afrag, bfrag, acc[cb], 0, 0, 0);
        }
    }
    { const int p = 16 * wave + pl; const float bias = bsp[p];
      const bf16* up = Z + (R0 + p) * ABIN + 1536 + 128 * g4 + 4 * g; bf16* op = MIX + (R0 + p) * DM + 512 + 128 * g4 + 4 * g;
#pragma unroll
      for (int cb = 0; cb < 8; ++cb) { const s16x4 ur = *(const s16x4*)(up + 16 * cb);
          v2u w; w.x = pk2(gelu_tanh(bf2f((unsigned short)ur[0])) * (acc[cb][0] + bias), gelu_tanh(bf2f((unsigned short)ur[1])) * (acc[cb][1] + bias));
          w.y = pk2(gelu_tanh(bf2f((unsigned short)ur[2])) * (acc[cb][2] + bias), gelu_tanh(bf2f((unsigned short)ur[3])) * (acc[cb][3] + bias));
          *(v2u*)(op + 16 * cb) = w; } }
    __syncthreads();
}

constexpr int DV_STRIDE = 160, DV_BUF = 32 * DV_STRIDE;
__device__ __forceinline__ void dil_unit(const Args& A, LAS unsigned char* vl, int unit, int lane) {
    const int r16 = unit & 15, sp = (unit >> 4) & 31, h = (unit >> 9) & 7, b = unit >> 12;
    const bf16* Z = (const bf16*)(A.ws + WS_ACT); bf16* MIX = (bf16*)(A.ws + WS_MIX);
    const int qi = lane & 15, g = lane >> 4, T0 = sp * 256;
    const size_t rowb = (size_t)b * SEQ;
    const int tq = T0 + r16 + 16 * qi;
    const bf16* qp = Z + (rowb + tq) * ABIN + h * 64 + 8 * g;
    const bf16x8 qf0 = *(const bf16x8*)qp, qf1 = *(const bf16x8*)(qp + 32);
    const bf16* Kb = Z + rowb * ABIN + 512 + h * 64 + 8 * g;
    const bf16* Vb = Z + rowb * ABIN + 1024 + h * 64 + 8 * (lane & 7);
    float mrun = -INFINITY, lrun = 0.f; f32x4 o[4];
#pragma unroll
    for (int d = 0; d < 4; ++d) o[d] = (f32x4){0.f, 0.f, 0.f, 0.f};
    const int tb = T0 + r16;
    constexpr int DIL_D = 3;
    bf16x8 kn[DIL_D][4], vn[DIL_D][4];
#define DIL_PARAMS(it, dsh, j) const int dsh = ((it) < 12) ? 0 : ((it) < 18) ? 2 : 4; const int j = (it) - (((it) < 12) ? 0 : ((it) < 18) ? 12 : 18);
#define DIL_LOAD(it, S) do { DIL_PARAMS(it, dsh_, j_) const int c_ = tb & ((1 << dsh_) - 1), skb_ = (tb >> dsh_) - 128 + 32 * j_; \
        _Pragma("unroll") for (int s_ = 0; s_ < 2; ++s_) { int t_ = c_ + ((skb_ + 16 * s_ + qi) << dsh_); t_ = t_ < 0 ? 0 : (t_ > SEQ - 1 ? SEQ - 1 : t_); \
            kn[S][2 * s_] = *(const bf16x8*)(Kb + (size_t)t_ * ABIN); kn[S][2 * s_ + 1] = *(const bf16x8*)(Kb + (size_t)t_ * ABIN + 32); } \
        _Pragma("unroll") for (int i_ = 0; i_ < 4; ++i_) { int t_ = c_ + ((skb_ + (lane >> 3) + 8 * i_) << dsh_); t_ = t_ < 0 ? 0 : (t_ > SEQ - 1 ? SEQ - 1 : t_); \
            vn[S][i_] = *(const bf16x8*)(Vb + (size_t)t_ * ABIN); } } while (0)
#pragma unroll
    for (int p = 0; p < DIL_D; ++p) DIL_LOAD(p, p);
#pragma nounroll
    for (int it0 = 0; it0 < 24; it0 += DIL_D) {
#pragma unroll
      for (int S = 0; S < DIL_D; ++S) { const int it = it0 + S; if (it < 23) {
        LAS unsigned char* buf = vl + (it & 1) * DV_BUF;
        const bf16x8 k0 = kn[S][0], k1 = kn[S][1], k2 = kn[S][2], k3 = kn[S][3];
#pragma unroll
        for (int i = 0; i < 4; ++i) *(LAS bf16x8*)(buf + ((lane >> 3) + 8 * i) * DV_STRIDE + (lane & 7) * 16) = vn[S][i];
        if (it + DIL_D < 23) DIL_LOAD(it + DIL_D, S);
        DIL_PARAMS(it, dsh, j)
        const int skb = (tb >> dsh) - 128 + 32 * j, sq = (tb >> dsh) + ((16 >> dsh) * qi);
        f32x4 sa = (f32x4){0.f, 0.f, 0.f, 0.f}, sb = (f32x4){0.f, 0.f, 0.f, 0.f};
        sa = __builtin_amdgcn_mfma_f32_16x16x32_bf16(k0, qf0, sa, 0, 0, 0); sa = __builtin_amdgcn_mfma_f32_16x16x32_bf16(k1, qf1, sa, 0, 0, 0);
        sb = __builtin_amdgcn_mfma_f32_16x16x32_bf16(k2, qf0, sb, 0, 0, 0); sb = __builtin_amdgcn_mfma_f32_16x16x32_bf16(k3, qf1, sb, 0, 0, 0);
        float mx = -INFINITY;
#pragma unroll
        for (int e = 0; e < 4; ++e) { const int ska = skb + 4 * g + e, skq = ska + 16;
            const bool va = (ska >= 0) && (ska <= sq) && (sq - ska <= 128), vb = (skq >= 0) && (skq <= sq) && (sq - skq <= 128);
            sa[e] = va ? sa[e] : -INFINITY; sb[e] = vb ? sb[e] : -INFINITY; mx = fmaxf(mx, fmaxf(sa[e], sb[e])); }
        mx = fmaxf(mx, __shfl_xor(mx, 16)); mx = fmaxf(mx, __shfl_xor(mx, 32));
        const float mnew = fmaxf(mrun, mx), muse = (mnew == -INFINITY) ? 0.f : mnew;
        const float alpha = __builtin_amdgcn_exp2f(mrun - muse);
        float ps = 0.f; float pa[4], pb[4];
#pragma unroll
        for (int e = 0; e < 4; ++e) { pa[e] = __builtin_amdgcn_exp2f(sa[e] - muse); pb[e] = __builtin_amdgcn_exp2f(sb[e] - muse); ps += pa[e] + pb[e]; }
        lrun = lrun * alpha + ps; mrun = mnew;
        v4u pw; pw.x = pk2(pa[0], pa[1]); pw.y = pk2(pa[2], pa[3]); pw.z = pk2(pb[0], pb[1]); pw.w = pk2(pb[2], pb[3]);
        const bf16x8 pf = __builtin_bit_cast(bf16x8, pw);
        asm volatile("s_waitcnt lgkmcnt(0)" ::: "memory");
        LAS unsigned char* rb = buf + (4 * g + (qi >> 2)) * DV_STRIDE + (qi & 3) * 8;
#pragma unroll
        for (int db = 0; db < 4; ++db) {
            const s16x4 lo = __builtin_bit_cast(s16x4, __builtin_amdgcn_ds_read_tr16_b64_v4i16((LAS s16x4*)(rb + db * 32)));
            const s16x4 hi = __builtin_bit_cast(s16x4, __builtin_amdgcn_ds_read_tr16_b64_v4i16((LAS s16x4*)(rb + db * 32 + 16 * DV_STRIDE)));
            const bf16x8 vf = (bf16x8){lo[0], lo[1], lo[2], lo[3], hi[0], hi[1], hi[2], hi[3]};
            o[db] = o[db] * alpha;
            o[db] = __builtin_amdgcn_mfma_f32_16x16x32_bf16(vf, pf, o[db], 0, 0, 0);
        }
    } } }
#undef DIL_LOAD
#undef DIL_PARAMS
    lrun += __shfl_xor(lrun, 16); lrun += __shfl_xor(lrun, 32);
    const float inv = 1.0f / lrun;
    bf16* op = MIX + (rowb + tq) * DM + h * 64 + 4 * g;
#pragma unroll
    for (int db = 0; db < 4; ++db) { v2u w; w.x = pk2(o[db][0] * inv, o[db][1] * inv); w.y = pk2(o[db][2] * inv, o[db][3] * inv); *(v2u*)(op + 16 * db) = w; }
}

__device__ __forceinline__ void select_phase(const Args& A, LAS unsigned char* lds, int wave, int lane) {
    LAS unsigned* lcnt = (LAS unsigned*)lds; LAS unsigned* lbase = lcnt + 32;
    const int tid = threadIdx.x;
    for (int k = 0; k < 2; ++k) {
        const int U = blockIdx.x + 256 * k, bh = (U >> 4) & 31, c16 = k ? 15 - (U & 15) : (U & 15), b = bh >> 4, h = bh & 15;
        const int ch = c16 * 8 + wave, t = ch * 64 + lane, own = ch >> 2;
        if (tid < 32) lcnt[tid] = 0u;
        __syncthreads();
        unsigned mask = 0u; int i1 = -1, i2 = -1, i3 = -1;
        if (own > 0) {
            const bf16* qp = (const bf16*)(A.ws + WS_ACT) + ((size_t)b * SEQ + t) * DM + h * 64;
            float q[64];
#pragma unroll
            for (int i = 0; i < 8; ++i) { const bf16x8 raw = *(const bf16x8*)(qp + 8 * i);
#pragma unroll
                for (int e = 0; e < 8; ++e) q[8 * i + e] = bf2f((unsigned short)raw[e]); }
            const float* km = (const float*)(A.ws + WS_KM) + (size_t)(b * 32) * 2048 + h * 64 + lane;
            float v1 = -INFINITY, v2 = -INFINITY, v3 = -INFINITY;
            for (int j0 = 0; j0 < own; j0 += 4) {
                float kmv[4];
#pragma unroll
                for (int u = 0; u < 4; ++u) { const int jj = (j0 + u < own) ? j0 + u : own - 1; kmv[u] = km[(size_t)jj * 2048] + km[(size_t)jj * 2048 + 1024]; }
#pragma unroll
                for (int u = 0; u < 4; ++u) { const int j = j0 + u;
                    float s = 0.f;
#pragma unroll
                    for (int d = 0; d < 64; ++d) s += q[d] * __builtin_bit_cast(float, __builtin_amdgcn_readlane(__builtin_bit_cast(int, kmv[u]), d));
                    if (j < own) {
                        if (s > v1) { v3 = v2; i3 = i2; v2 = v1; i2 = i1; v1 = s; i1 = j; }
                        else if (s > v2) { v3 = v2; i3 = i2; v2 = s; i2 = j; }
                        else if (s > v3) { v3 = s; i3 = j; } } }
            }
            if (i1 >= 0) mask |= 1u << i1; if (i2 >= 0) mask |= 1u << i2; if (i3 >= 0) mask |= 1u << i3;
        }
        unsigned p1 = 0, p2 = 0, p3 = 0;
        if (i1 >= 0) p1 = atomicAdd((unsigned*)(lcnt + i1), 1u);
        if (i2 >= 0) p2 = atomicAdd((unsigned*)(lcnt + i2), 1u);
        if (i3 >= 0) p3 = atomicAdd((unsigned*)(lcnt + i3), 1u);
        __syncthreads();
        if (tid < 32) { const unsigned n = lcnt[tid]; lbase[tid] = n ? atomicAdd((unsigned*)(A.ws + WS_CNT) + bh * 32 + tid, n) : 0u; }
        __syncthreads();
        unsigned short* list = (unsigned short*)(A.ws + WS_LIST) + (size_t)bh * 126976;
        if (i1 >= 0) list[256 * (31 * i1 - (i1 * (i1 - 1)) / 2) + lbase[i1] + p1] = (unsigned short)(t | (__popc(mask & ((1u << i1) - 1u)) << 13));
        if (i2 >= 0) list[256 * (31 * i2 - (i2 * (i2 - 1)) / 2) + lbase[i2] + p2] = (unsigned short)(t | (__popc(mask & ((1u << i2) - 1u)) << 13));
        if (i3 >= 0) list[256 * (31 * i3 - (i3 * (i3 - 1)) / 2) + lbase[i3] + p3] = (unsigned short)(t | (__popc(mask & ((1u << i3) - 1u)) << 13));
        ((unsigned*)(A.ws + WS_SEL))[(size_t)bh * SEQ + t] = mask;
        __syncthreads();
    }
}
constexpr int MB_VIRT = 0;
constexpr int MK_STRIDE = 144, MV_STRIDE = 160, MK_OFF = 0, MV_OFF = 256 * MK_STRIDE, MB_CTL = 81920;
__device__ __forceinline__ void moba_stage_load(const Args& A, int bh, int j, bf16x8 (&kk)[4], bf16x8 (&vv)[4]) {
    const int b = bh >> 4, h = bh & 15, row = threadIdx.x >> 1, hf = threadIdx.x & 1;
    const bf16* kp = (const bf16*)(A.ws + WS_ACT) + (size_t)M * DM + ((size_t)b * SEQ + 256 * j + row) * DM + h * 64 + 32 * hf;
    const bf16* vp = kp + (size_t)M * DM;
#pragma unroll
    for (int i = 0; i < 4; ++i) { kk[i] = *(const bf16x8*)(kp + 8 * i); vv[i] = *(const bf16x8*)(vp + 8 * i); }
}
__device__ __forceinline__ void moba_stage_store(LAS unsigned char* lds, const bf16x8 (&kk)[4], const bf16x8 (&vv)[4]) {
    const int row = threadIdx.x >> 1, hf = threadIdx.x & 1;
#pragma unroll
    for (int i = 0; i < 4; ++i) { *(LAS bf16x8*)(lds + MK_OFF + row * MK_STRIDE + 64 * hf + 16 * i) = kk[i]; *(LAS bf16x8*)(lds + MV_OFF + row * MV_STRIDE + 64 * hf + 16 * i) = vv[i]; }
}
__device__ __forceinline__ void moba_stage(const Args& A, LAS unsigned char* lds, int bh, int j) {
    bf16x8 kk[4], vv[4]; moba_stage_load(A, bh, j, kk, vv); moba_stage_store(lds, kk, vv);
}
__device__ __forceinline__ void moba_block(LAS unsigned char* lds, int ntile, const bf16x8 qf0, const bf16x8 qf1, int qpos, int lane, float& m_out, float& l_out, f32x4 (&o)[4]) {
    const int qi = lane & 15, g = lane >> 4;
    LAS unsigned char* kb = lds + MK_OFF + qi * MK_STRIDE + 16 * g;
    f32x4 sa[8], sb[8];
    float mx = -INFINITY;
#pragma unroll
    for (int t = 0; t < 8; ++t) {
        sa[t] = (f32x4){-INFINITY, -INFINITY, -INFINITY, -INFINITY}; sb[t] = sa[t];
        if (t < ntile) {
            LAS unsigned char* kt = kb + t * 32 * MK_STRIDE;
            const bf16x8 k0 = *(LAS bf16x8*)(kt), k1 = *(LAS bf16x8*)(kt + 64), k2 = *(LAS bf16x8*)(kt + 16 * MK_STRIDE), k3 = *(LAS bf16x8*)(kt + 16 * MK_STRIDE + 64);
            f32x4 a = (f32x4){0.f, 0.f, 0.f, 0.f}, bq = (f32x4){0.f, 0.f, 0.f, 0.f};
            a = __builtin_amdgcn_mfma_f32_16x16x32_bf16(k0, qf0, a, 0, 0, 0); a = __builtin_amdgcn_mfma_f32_16x16x32_bf16(k1, qf1, a, 0, 0, 0);
            bq = __builtin_amdgcn_mfma_f32_16x16x32_bf16(k2, qf0, bq, 0, 0, 0); bq = __builtin_amdgcn_mfma_f32_16x16x32_bf16(k3, qf1, bq, 0, 0, 0);
#pragma unroll
            for (int e = 0; e < 4; ++e) { const int ka = 32 * t + 4 * g + e;
                a[e] = (ka <= qpos) ? a[e] : -INFINITY; bq[e] = (ka + 16 <= qpos) ? bq[e] : -INFINITY; mx = fmaxf(mx, fmaxf(a[e], bq[e])); }
            sa[t] = a; sb[t] = bq;
        }
    }
    mx = fmaxf(mx, __shfl_xor(mx, 16)); mx = fmaxf(mx, __shfl_xor(mx, 32));
    float ps = 0.f;
    LAS unsigned char* rb = lds + MV_OFF + (4 * g + (qi >> 2)) * MV_STRIDE + (qi & 3) * 8;
#pragma unroll
    for (int t = 0; t < 8; ++t) {
        if (t < ntile) {
            float pa[4], pb[4];
#pragma unroll
            for (int e = 0; e < 4; ++e) { pa[e] = __builtin_amdgcn_exp2f(sa[t][e] - mx); pb[e] = __builtin_amdgcn_exp2f(sb[t][e] - mx); ps += pa[e] + pb[e]; }
            v4u pw; pw.x = pk2(pa[0], pa[1]); pw.y = pk2(pa[2], pa[3]); pw.z = pk2(pb[0], pb[1]); pw.w = pk2(pb[2], pb[3]);
            const bf16x8 pf = __builtin_bit_cast(bf16x8, pw);
            LAS unsigned char* rt = rb + t * 32 * MV_STRIDE;
#pragma unroll
            for (int db = 0; db < 4; ++db) {
                const s16x4 lo = __builtin_bit_cast(s16x4, __builtin_amdgcn_ds_read_tr16_b64_v4i16((LAS s16x4*)(rt + db * 32)));
                const s16x4 hi = __builtin_bit_cast(s16x4, __builtin_amdgcn_ds_read_tr16_b64_v4i16((LAS s16x4*)(rt + db * 32 + 16 * MV_STRIDE)));
                const bf16x8 vf = (bf16x8){lo[0], lo[1], lo[2], lo[3], hi[0], hi[1], hi[2], hi[3]};
                o[db] = __builtin_amdgcn_mfma_f32_16x16x32_bf16(vf, pf, o[db], 0, 0, 0);
            }
        }
    }
    m_out = mx; l_out = ps;
}
__device__ __forceinline__ bf16* moba_po(const Args& A, int slot) { return (bf16*)(A.ws + (slot == 0 ? WS_MIX : slot == 1 ? WS_XB : WS_PO2)); }
__device__ __forceinline__ void moba_past_phase(const Args& A, LAS unsigned char* lds, int wave, int lane) {
    LAS unsigned* cntl = (LAS unsigned*)(lds + MB_CTL);
    LAS unsigned* pre = cntl + 1024;
    LAS unsigned* tot = pre + 1025;
    const unsigned* cnt = (const unsigned*)(A.ws + WS_CNT);
    const int tid = threadIdx.x;
    for (int i = tid; i < 1024; i += NTHR) cntl[i] = cnt[i];
    __syncthreads();
    if (tid < 32) { unsigned run = 0; for (int j = 0; j < 32; ++j) { pre[tid * 32 + j] = run; const unsigned n = cntl[tid * 32 + j]; run += n ? ((n + 127u) >> 7) + MB_VIRT : 0u; } tot[tid] = run; }
    __syncthreads();
    if (tid == 0) { unsigned run = 0; for (int b = 0; b < 32; ++b) { const unsigned t = tot[b]; tot[b] = run; run += t; } tot[32] = run; pre[1024] = run; }
    __syncthreads();
    for (int i = tid; i < 1024; i += NTHR) pre[i] += tot[i >> 5];
    __syncthreads();
    const unsigned T = tot[32];
    const unsigned i0 = (unsigned)(((unsigned long long)T * blockIdx.x) / gridDim.x), i1 = (unsigned)(((unsigned long long)T * (blockIdx.x + 1)) / gridDim.x);
    const int qi = lane & 15, g = lane >> 4;
    LAS unsigned short* ents = (LAS unsigned short*)(lds + 98304);
    LAS unsigned short* item_e = (LAS unsigned short*)(lds + 98304 + 24576);
    const int n = (int)(i1 - i0) < 96 ? (int)(i1 - i0) : 96;
    for (int x = tid; x < n * 128; x += NTHR) {
        const unsigned it = i0 + (unsigned)(x >> 7);
        int lo = 0, hi = 1024;
        while (lo < hi) { const int mid = (lo + hi) >> 1; if (pre[mid + 1] > it) hi = mid; else lo = mid + 1; }
        const int e = lo, c = (int)(it - pre[e]), li = c * 128 + (x & 127), j = e & 31;
        const unsigned short* list = (const unsigned short*)(A.ws + WS_LIST) + (size_t)(e >> 5) * 126976 + 256 * (31 * j - (j * (j - 1)) / 2);
        ents[x] = (li < (int)cntl[e]) ? list[li] : (unsigned short)0xFFFF;
        if ((x & 127) == 0) item_e[x >> 7] = (unsigned short)e;
    }
    __syncthreads();
    int cur_e = -1;
#define MB_QP(e_, tq_) ((const bf16*)(A.ws + WS_ACT) + ((size_t)((e_) >> 9) * SEQ + (tq_)) * DM + (((e_) >> 5) & 15) * 64 + 8 * g)
    if (n > 0) {
        int eA = (int)item_e[0]; unsigned entA = ents[wave * 16 + qi];
        bf16x8 qA0, qA1; { const int tq = (entA == 0xFFFFu) ? 0 : (int)(entA & 8191u); qA0 = *(const bf16x8*)MB_QP(eA, tq); qA1 = *(const bf16x8*)(MB_QP(eA, tq) + 32); }
        bf16x8 pkk[4], pvv[4]; bool have_pf = false; int pf_e = -1;
#pragma unroll
        for (int i = 0; i < 4; ++i) { pkk[i] = (bf16x8){0, 0, 0, 0, 0, 0, 0, 0}; pvv[i] = pkk[i]; }
        for (int ii = 0; ii < n; ++ii) {
            const int bh = eA >> 5, j = eA & 31;
            const int iin = (ii + 1 < n) ? ii + 1 : ii;
            const int eB = (int)item_e[iin]; const unsigned entB = ents[iin * 128 + wave * 16 + qi];
            if (eA != cur_e) { __syncthreads(); if (have_pf && pf_e == eA) moba_stage_store(lds, pkk, pvv); else moba_stage(A, lds, bh, j); __syncthreads(); cur_e = eA; have_pf = false; }
            const int tqB = (entB == 0xFFFFu) ? 0 : (int)(entB & 8191u);
            const bf16x8 qB0 = *(const bf16x8*)MB_QP(eB, tqB), qB1 = *(const bf16x8*)(MB_QP(eB, tqB) + 32);
            if (eB != eA) { moba_stage_load(A, eB >> 5, eB & 31, pkk, pvv); have_pf = true; pf_e = eB; }
            float mrun, lrun; f32x4 o[4];
#pragma unroll
            for (int d = 0; d < 4; ++d) o[d] = (f32x4){0.f, 0.f, 0.f, 0.f};
            moba_block(lds, 8, qA0, qA1, 1 << 30, lane, mrun, lrun, o);
            lrun += __shfl_xor(lrun, 16); lrun += __shfl_xor(lrun, 32);
            {
                const bool valA = entA != 0xFFFFu; const int tq = (int)(entA & 8191u), slot = (int)(entA >> 13); const size_t idx = (size_t)bh * SEQ + tq;
                const float inv = 1.0f / lrun;
                bf16* junk = (bf16*)(A.ws + 524288) + threadIdx.x * 64;
                bf16* op = valA ? moba_po(A, slot) + idx * 64 + 4 * g : junk;
#pragma unroll
                for (int db = 0; db < 4; ++db) { v2u w; w.x = pk2(o[db][0] * inv, o[db][1] * inv); w.y = pk2(o[db][2] * inv, o[db][3] * inv); *(v2u*)(op + 16 * db) = w; }
                float* lp = (valA && g == 0) ? (float*)(A.ws + WS_LSE) + (size_t)slot * (32 * SEQ) + idx : (float*)(junk + 32);
                *lp = mrun + __builtin_amdgcn_logf(lrun);
            }
            eA = eB; entA = entB; qA0 = qB0; qA1 = qB1;
        }
    }
#undef MB_QP
    __syncthreads();
}
__device__ __forceinline__ void moba_own_phase(const Args& A, LAS unsigned char* lds, int wave, int lane) {
    const int qi = lane & 15, g = lane >> 4;
    int cur_e = -1;
    for (int u = blockIdx.x * 8; u < blockIdx.x * 8 + 8; ++u) {
        const int hf = u & 1, e = u >> 1, bh = e >> 5, j = e & 31;
        if (e != cur_e) { __syncthreads(); moba_stage(A, lds, bh, j); __syncthreads(); cur_e = e; }
        const int qloc = 128 * hf + 16 * wave + qi, tq = 256 * j + qloc;
        const size_t qrow = (size_t)(bh >> 4) * SEQ + tq;
        bf16* qp = (bf16*)(A.ws + WS_ACT) + qrow * DM + (bh & 15) * 64;
        const bf16x8 qf0 = *(const bf16x8*)(qp + 8 * g), qf1 = *(const bf16x8*)(qp + 8 * g + 32);
        float mrun, lrun; f32x4 o[4];
#pragma unroll
        for (int d = 0; d < 4; ++d) o[d] = (f32x4){0.f, 0.f, 0.f, 0.f};
        const size_t idx = (size_t)bh * SEQ + tq;
        const unsigned selm = ((const unsigned*)(A.ws + WS_SEL))[idx];
        const float* lsep = (const float*)(A.ws + WS_LSE) + idx;
        float lsr[3]; s16x4 pr[3][4];
#pragma unroll
        for (int s = 0; s < 3; ++s) { lsr[s] = lsep[(size_t)s * (32 * SEQ)]; const bf16* pp = moba_po(A, s) + idx * 64 + 4 * g;
#pragma unroll
            for (int db = 0; db < 4; ++db) pr[s][db] = *(const s16x4*)(pp + 16 * db); }
        const int ntile = (128 * hf + 16 * wave + 15) / 32 + 1;
        moba_block(lds, ntile, qf0, qf1, qloc, lane, mrun, lrun, o);
        lrun += __shfl_xor(lrun, 16); lrun += __shfl_xor(lrun, 32);
        const int nsel = __popc(selm);
        float ls[3]; float mx = mrun;
#pragma unroll
        for (int s = 0; s < 3; ++s) { ls[s] = (s < nsel) ? lsr[s] : -INFINITY; mx = fmaxf(mx, ls[s]); }
        const float w0 = __builtin_amdgcn_exp2f(mrun - mx); float den = lrun * w0;
#pragma unroll
        for (int d = 0; d < 4; ++d) o[d] = o[d] * w0;
#pragma unroll
        for (int s = 0; s < 3; ++s) { const bool on = s < nsel; const float ws_ = on ? __builtin_amdgcn_exp2f(ls[s] - mx) : 0.f; den += ws_;
#pragma unroll
            for (int db = 0; db < 4; ++db) { const s16x4 r = pr[s][db];
                o[db][0] += on ? ws_ * bf2f((unsigned short)r[0]) : 0.f; o[db][1] += on ? ws_ * bf2f((unsigned short)r[1]) : 0.f;
                o[db][2] += on ? ws_ * bf2f((unsigned short)r[2]) : 0.f; o[db][3] += on ? ws_ * bf2f((unsigned short)r[3]) : 0.f; } }
        const float inv = 1.0f / den;
#pragma unroll
        for (int db = 0; db < 4; ++db) { v2u w; w.x = pk2(o[db][0] * inv, o[db][1] * inv); w.y = pk2(o[db][2] * inv, o[db][3] * inv); *(v2u*)(qp + 16 * db + 4 * g) = w; }
    }
    __syncthreads();
}
constexpr int N_PHASES = 17;
#ifndef MK_DENSE_MOBA
#define MK_DENSE_MOBA 0
#endif
#ifndef MK_FUSE_FINAL
#define MK_FUSE_FINAL 1
#endif
#ifndef MK_SINGLE
#define MK_SINGLE 1
#endif
__global__ void __launch_bounds__(NTHR, 2) fwd_megakernel(Args args) {
    extern __shared__ __attribute__((aligned(16))) unsigned char lds_raw[];
    __builtin_assume(__builtin_amdgcn_workitem_id_y() == 0); __builtin_assume(__builtin_amdgcn_workitem_id_z() == 0);
    cg::grid_group grid = cg::this_grid();
    LAS unsigned char* lds = (LAS unsigned char*)lds_raw;
    const int tid = threadIdx.x, lane = tid & 63, wave = __builtin_amdgcn_readfirstlane(tid >> 6);
    const int G = gridDim.x;
    unsigned char* ws = args.ws;
    const int lo = args.ph_lo, hi = args.ph_hi;
    bf16* XB = (bf16*)(ws + WS_XB); float* PART = (float*)(ws + WS_PART); bf16* ACT = (bf16*)(ws + WS_ACT); bf16* MIX = (bf16*)(ws + WS_MIX);
    float* X = args.out;
#define IN(k) (lo <= (k) && (k) < hi)
    volatile LAS unsigned* MISC = (volatile LAS unsigned*)(lds + MISC_OFF);
    if (tid < 32) MISC[tid] = 0u;
    unsigned* barw = (unsigned*)(ws + WS_BAR);
    XcdBarrier xbar; xbar.bar = barw; xbar.x = 0; xbar.st = MISC + 8;
    __syncthreads();
    xbar = xcd_barrier_post(barw, MISC + 8);
    if (lo > 1000) grid.sync();
#ifdef PROBE_REP
#define SEAM(k) do { if (IN(k) && IN((k) + 1)) { for (int s_ = 0; s_ < PROBE_SYNC; ++s_) grid.sync(); } } while (0)
#else
#define SEAM(k) do { if (IN(k) && IN((k) + 1)) xcd_barrier(xbar); } while (0)
#endif
#define GEMM_GU(f) do { pg8::Gemm g{XB, (const bf16*)(ws + ws_wgu(f)), M, 2 * FF, DM}; pg8::StaticOrder S; S.init(M, 2 * FF, G, (int)blockIdx.x); \
        rstd_table(PART, lds, S); pg8::EpiSwiGLU E{ACT, FF, (const LAS float*)(lds + RSTD_OFF)}; pg8::gemm_phase<pg8::EpiSwiGLU, pg8::StaticOrder, true, true>(lds, g, S, E); } while (0)
#define GEMM_DOWN(f, basep) do { pg8::Gemm g{ACT, (const bf16*)(ws + ws_wd(f)), M, DM, FF}; pg8::StaticOrder S; S.init(M, DM, G, (int)blockIdx.x); \
        pg8::EpiResid E{(basep), X, XB, PART, 0.5f}; pg8::gemm_phase<pg8::EpiResid, pg8::StaticOrder, true, true>(lds, g, S, E); } while (0)
#define GEMM_OUT(Ap, Wp) do { pg8::Gemm g{(Ap), (const bf16*)(ws + (Wp)), M, DM, DM}; pg8::StaticOrder S; S.init(M, DM, G, (int)blockIdx.x); \
        pg8::EpiResid E{X, X, XB, PART, 1.0f}; pg8::gemm_phase<pg8::EpiResid, pg8::StaticOrder, true, true>(lds, g, S, E); } while (0)

#ifdef PROBE_REP
    for (int rep_ = 0; rep_ < PROBE_REP0; ++rep_) { phase_prologue(args, lds, wave, lane); __syncthreads(); }
#endif
    if (IN(0)) { phase_prologue(args, lds, wave, lane); } SEAM(0);
    if (IN(1)) { GEMM_GU(0); conv_idle(args, lds, 8, 9, 5); } SEAM(1);
    if (IN(2)) { GEMM_DOWN(0, args.in[0]); } SEAM(2);
    if (IN(3)) { pg8::Gemm g{XB, (const bf16*)(ws + WS_WABIN), M, ABIN, DM}; pg8::StaticOrder S; S.init(M, ABIN, G, (int)blockIdx.x);
        rstd_table(PART, lds, S); pg8::EpiProj E{ACT, ABIN, (const LAS float*)(lds + RSTD_OFF), 0, 0, 512, C2, nullptr}; pg8::gemm_phase<pg8::EpiProj, pg8::StaticOrder, true, true>(lds, g, S, E); conv_idle(args, lds, 1, -1, -1); } SEAM(3);
#ifndef NO_MIX
#ifdef PROBE_REP
    for (int rep_ = 0; rep_ < PROBE_REP4; ++rep_)
#endif
    if (IN(4)) {
        for (int u = blockIdx.x; u < 512; u += G) gate_unit(args, lds, u, wave, lane);
        LAS unsigned char* vl = lds + wave * (2 * DV_BUF);
        for (int u = blockIdx.x * NWAVES + wave; u < 8192; u += G * NWAVES) dil_unit(args, vl, u, lane);
        __syncthreads();
    }
#endif
    SEAM(4);
    if (IN(5)) { GEMM_OUT(MIX, WS_WABOUT); } SEAM(5);
    if (IN(6)) { GEMM_GU(1); conv_idle(args, lds, 2, -1, -1); } SEAM(6);
    if (IN(7)) { GEMM_DOWN(1, X); } SEAM(7);
    if (IN(8)) { GEMM_GU(2); conv_idle(args, lds, 6, 10, 11); } SEAM(8);
    if (IN(9)) { GEMM_DOWN(2, X); } SEAM(9);
    if (IN(10)) { pg8::Gemm g{XB, (const bf16*)(ws + WS_WCIN), M, CIN, DM}; pg8::StaticOrder S; S.init(M, CIN, G, (int)blockIdx.x);
        rstd_table(PART, lds, S); pg8::EpiProj E{ACT, DM, (const LAS float*)(lds + RSTD_OFF), DM, (size_t)M * DM, DM, C2, (float*)(ws + WS_KM)}; pg8::gemm_phase<pg8::EpiProj, pg8::StaticOrder, true, true>(lds, g, S, E); } SEAM(10);
    if (IN(11)) { select_phase(args, lds, wave, lane); }
    SEAM(11);
#if MK_DENSE_MOBA
#ifndef NO_ATTN
    if (IN(12)) {
        const attn_body::AttnTensors AT{(const attn_body::bf16*)ACT, (const attn_body::bf16*)(ACT + (size_t)M * DM), (const attn_body::bf16*)(ACT + (size_t)2 * M * DM), (attn_body::bf16*)ACT, (const unsigned*)(ws + WS_SEL)};
        const attn_body::StaticOrder S(G, (int)blockIdx.x);
        attn_body::attn_phase<attn_body::StaticOrder>((char*)lds_raw, AT, S);
    }
#endif
#else
    if (IN(12)) { moba_past_phase(args, lds, wave, lane); xcd_barrier(xbar); moba_own_phase(args, lds, wave, lane); }
#endif
    SEAM(12);
    if (IN(13)) { GEMM_OUT(ACT, WS_WCOUT); } SEAM(13);
    if (IN(14)) { GEMM_GU(3); conv_idle(args, lds, 7, -1, -1); } SEAM(14);
#if MK_FUSE_FINAL
    if (IN(15)) { pg8::Gemm g{ACT, (const bf16*)(ws + ws_wd(3)), M, DM, FF}; pg8::StaticOrder S; S.init(M, DM, G, (int)blockIdx.x);
        EpiResidNorm E{X, X, PART, args.in[17], 0.5f, xbar}; pg8::gemm_phase<EpiResidNorm, pg8::StaticOrder, false, true>(lds, g, S, E); }
#else
    if (IN(15)) { GEMM_DOWN(3, X); } SEAM(15);
    if (IN(16)) {
        const float* gn = args.in[17];
        int tid16 = threadIdx.x; asm volatile("" : "+v"(tid16)); const int lane = tid16 & 63, wave = __builtin_amdgcn_readfirstlane(tid16 >> 6);
        for (int m = blockIdx.x * NWAVES + wave; m < M; m += G * NWAVES) {
            f32x4* xr = (f32x4*)(X + (size_t)m * DM) + lane; f32x4 v[4]; float s = 0.f;
#pragma unroll
            for (int j = 0; j < 4; ++j) { v[j] = xr[64 * j]; s += (v[j][0] * v[j][0] + v[j][1] * v[j][1]) + (v[j][2] * v[j][2] + v[j][3] * v[j][3]); }
            const float rs = rsqrtf(wave_sum(s) * (1.0f / DM) + 1e-6f);
#pragma unroll
            for (int j = 0; j < 4; ++j) { const f32x4 gg = ((const f32x4*)gn)[64 * j + lane]; xr[64 * j] = v[j] * rs * gg; }
        }
    }
#endif
#undef IN
#undef SEAM
}

extern "C" void kernel_launch(void* const* d_in, const int* in_sizes, int n_in, void* d_out, int out_size, void* d_ws, size_t ws_size, hipStream_t stream) {
    static int grid = 0;
    if (grid == 0) {
        if (n_in != 18 || out_size != M * DM || ws_size < WS_END) { fprintf(stderr, "kernel_launch: unexpected shapes (n_in %d out %d ws %zu)\n", n_in, out_size, ws_size); grid = -1; return; }
        int dev = 0, cus = 0, per_cu = 0;
        hipGetDevice(&dev); hipDeviceGetAttribute(&cus, hipDeviceAttributeMultiprocessorCount, dev);
        hipFuncSetAttribute((const void*)fwd_megakernel, hipFuncAttributeMaxDynamicSharedMemorySize, LDS_BYTES);
        hipOccupancyMaxActiveBlocksPerMultiprocessor(&per_cu, (const void*)fwd_megakernel, NTHR, LDS_BYTES);
        (void)hipGetLastError();
        if (per_cu < 1) { fprintf(stderr, "kernel_launch: occupancy query reports %d blocks per CU\n", per_cu); per_cu = 1; }
        grid = cus;
        if (grid != 256) fprintf(stderr, "kernel_launch: note: %d CUs (the attention order assumes 256)\n", grid);
    }
    if (grid < 0) return;
    if (hipMemsetAsync((char*)d_ws + WS_BAR, 0, (WS_CNT + 4096) - WS_BAR, stream) != hipSuccess) { fprintf(stderr, "kernel_launch: memset failed\n"); return; }
    Args a{};
    for (int i = 0; i < 18; ++i) a.in[i] = (const float*)d_in[i];
    a.out = (float*)d_out; a.ws = (unsigned char*)d_ws;
#if MK_SINGLE
    a.ph_lo = 0; a.ph_hi = N_PHASES;
    { void* kargs[] = {&a}; hipError_t e = hipLaunchCooperativeKernel((const void*)fwd_megakernel, dim3(grid), dim3(NTHR), kargs, LDS_BYTES, stream);
      if (e != hipSuccess) fprintf(stderr, "cooperative launch failed: %s\n", hipGetErrorString(e)); }
#else
    for (int p = 0; p < N_PHASES; ++p) { a.ph_lo = p; a.ph_hi = p + 1; void* kargs[] = {&a};
        hipError_t e = hipLaunchCooperativeKernel((const void*)fwd_megakernel, dim3(grid), dim3(NTHR), kargs, LDS_BYTES, stream);
        if (e != hipSuccess) { fprintf(stderr, "cooperative launch %d failed: %s\n", p, hipGetErrorString(e)); break; } }
#endif
}
```

```cpp
#include <hip/hip_runtime.h>
#include <hip/hip_cooperative_groups.h>
#include <hip/hip_bf16.h>
#include <cstdio>
#include <cstdint>
#include <cmath>
namespace cg = cooperative_groups;
namespace pg8 {
#define PG8_LAS __attribute__((address_space(3)))
typedef unsigned short bf16_t;
typedef short bf16x8 __attribute__((ext_vector_type(8)));
typedef float f32x4 __attribute__((ext_vector_type(4)));
typedef unsigned u32x4 __attribute__((ext_vector_type(4)));
constexpr int BM = 256, BK = 64, HALF = 128, HTB = HALF * BK * 2  , STAGE_BYTES = 8 * HTB, NXCD = 8, WGM = 8;

__host__ __device__ __forceinline__ int lds_byte(int r, int c) { const int st = (r >> 4) * 2 + (c >> 5), rr = r & 15, cc = c & 31, ob = rr * 64 + cc * 2; return st * 1024 + (ob ^ (((ob >> 9) & 1) << 5)); }
__host__ __device__ __forceinline__ void stage_rc(int b, int& R, int& C) { const int st = b / 1024, sb = b % 1024, swz = sb ^ (((sb >> 9) & 1) << 5); R = (st >> 1) * 16 + swz / 64; C = (st & 1) * 32 + (swz % 64) / 2; }
__host__ __device__ __forceinline__ int perm32(int rho) { const int n = rho >> 4, i = rho & 15; return 8 * (i >> 2) + 4 * n + (i & 3); }

struct Unit { int pm, pn; };
struct Gemm { const bf16_t* A; const bf16_t* Bt; int M, N, K; };

struct StaticOrder {
    int nM, nN, nwg, G, c;
    __host__ __device__ void init(int M, int N, int G_, int c_) { nM = M / BM; nN = N / BM; nwg = nM * nN; G = G_; c = c_; }
    __host__ __device__ bool next(int i, Unit& u) const {
        const long L = (long)i * G + c; if (L >= nwg) return false;
        int wgid = (int)L; { const int q = nwg / NXCD, r = nwg % NXCD, xcd = wgid % NXCD, off = wgid / NXCD; wgid = (xcd < r ? xcd * (q + 1) : r * (q + 1) + (xcd - r) * q) + off; }
        const int nig = WGM * nN, gid = wgid / nig, fm = gid * WGM, gsz = (nM - fm) < WGM ? (nM - fm) : WGM;
        u.pm = fm + ((wgid % nig) % gsz); u.pn = (wgid % nig) / gsz; return true;
    }
    __device__ __forceinline__ void a_ready(const Unit&) const {}
    __device__ __forceinline__ void done(const Unit&) const {}
};

__device__ __forceinline__ unsigned cvt_pk_bf16(float lo, float hi) { unsigned r; asm volatile("v_cvt_pk_bf16_f32 %0, %1, %2" : "=v"(r) : "v"(lo), "v"(hi)); return r; }
typedef float f32x2 __attribute__((ext_vector_type(2)));
typedef unsigned u32x2 __attribute__((ext_vector_type(2)));
__device__ __forceinline__ float row_rstd(const float* part, int row) {
    const f32x4* p = (const f32x4*)(part + (size_t)row * 16);
    const f32x4 a = p[0], b = p[1], c = p[2], d = p[3];
    const float s = (((a[0] + a[1]) + (a[2] + a[3])) + ((b[0] + b[1]) + (b[2] + b[3]))) + (((c[0] + c[1]) + (c[2] + c[3])) + ((d[0] + d[1]) + (d[2] + d[3])));
    return rsqrtf(s * (1.0f / 1024.0f) + 1e-6f);
}
__device__ __forceinline__ float silu_mul(float g, float u) { return g * u * __builtin_amdgcn_rcpf(1.0f + __builtin_amdgcn_exp2f(-1.4426950408889634f * g)); }
struct EpiSwiGLU {
    static constexpr bool PERM = true, AFTER_DRAIN = false;
    bf16_t* H; int ldh; const PG8_LAS float* rt;
    __device__ __forceinline__ void operator()(const f32x4 (&acc)[2][2][4][2], const Unit& u, int wr, int wc, int fr, int fq, int ui) const {
        const int row0 = u.pm * BM + wr * 64 + fr; const int col0 = u.pn * HALF + wc * 32 + 8 * fq;
#pragma unroll
        for (int ai = 0; ai < 2; ++ai)
#pragma unroll
            for (int m = 0; m < 4; ++m) { const int row = row0 + ai * HALF + m * 16; const float rs = rt[ui * 256 + wr * 64 + fr + ai * HALF + m * 16];
                const f32x4 g0 = acc[ai][0][m][0] * rs, g1 = acc[ai][0][m][1] * rs, u0 = acc[ai][1][m][0] * rs, u1 = acc[ai][1][m][1] * rs;
                u32x4 w; w.x = cvt_pk_bf16(silu_mul(g0[0], u0[0]), silu_mul(g0[1], u0[1])); w.y = cvt_pk_bf16(silu_mul(g0[2], u0[2]), silu_mul(g0[3], u0[3]));
                w.z = cvt_pk_bf16(silu_mul(g1[0], u1[0]), silu_mul(g1[1], u1[1])); w.w = cvt_pk_bf16(silu_mul(g1[2], u1[2]), silu_mul(g1[3], u1[3]));
                *(u32x4*)(H + (size_t)row * ldh + col0) = w; }
    }
};
template <bool BASE_F32> struct EpiResid {
    static constexpr bool PERM = true, AFTER_DRAIN = false;
    const float* base; bf16_t* xb; float* part; float alpha;
    __device__ __forceinline__ void operator()(const f32x4 (&acc)[2][2][4][2], const Unit& u, int wr, int wc, int fr, int fq, int) const {
        const int row0 = u.pm * BM + wr * 64 + fr; const int col0 = u.pn * BM + wc * 32 + 8 * fq;
#pragma unroll
        for (int ai = 0; ai < 2; ++ai)
#pragma unroll
            for (int m = 0; m < 4; ++m) { const int row = row0 + ai * HALF + m * 16; float ss = 0.f;
#pragma unroll
                for (int bj = 0; bj < 2; ++bj) { const size_t off = (size_t)row * 1024 + col0 + bj * HALF;
                    f32x4 b0, b1;
                    if (BASE_F32) { b0 = *(const f32x4*)(base + off); b1 = *(const f32x4*)(base + off + 4); }
                    else { const u32x4 r = *(const u32x4*)(xb + off);
                        b0 = (f32x4){__builtin_bit_cast(float, r.x << 16), __builtin_bit_cast(float, r.x & 0xffff0000u), __builtin_bit_cast(float, r.y << 16), __builtin_bit_cast(float, r.y & 0xffff0000u)};
                        b1 = (f32x4){__builtin_bit_cast(float, r.z << 16), __builtin_bit_cast(float, r.z & 0xffff0000u), __builtin_bit_cast(float, r.w << 16), __builtin_bit_cast(float, r.w & 0xffff0000u)}; }
                    const f32x4 v0 = b0 + acc[ai][bj][m][0] * alpha, v1 = b1 + acc[ai][bj][m][1] * alpha;
                    ss += ((v0[0] * v0[0] + v0[1] * v0[1]) + (v0[2] * v0[2] + v0[3] * v0[3])) + ((v1[0] * v1[0] + v1[1] * v1[1]) + (v1[2] * v1[2] + v1[3] * v1[3]));
                    u32x4 w; w.x = cvt_pk_bf16(v0[0], v0[1]); w.y = cvt_pk_bf16(v0[2], v0[3]); w.z = cvt_pk_bf16(v1[0], v1[1]); w.w = cvt_pk_bf16(v1[2], v1[3]);
                    *(u32x4*)(xb + off) = w; }
                ss += __shfl_xor(ss, 16); ss += __shfl_xor(ss, 32);
                if (fq == 0) part[(size_t)row * 16 + u.pn * 4 + wc] = ss; }
    }
};
struct EpiProj {
    static constexpr bool PERM = true, AFTER_DRAIN = false;
    bf16_t* O; int ldc; const PG8_LAS float* rt; int split_cols; size_t split_stride; int qcols; float scale0; float* km;
    __device__ __forceinline__ void operator()(const f32x4 (&acc)[2][2][4][2], const Unit& u, int wr, int wc, int fr, int fq, int ui) const {
        const int row0 = u.pm * BM + wr * 64 + fr; int colt = u.pn * BM; bf16_t* basep = O; int t = 0;
        const float sc = (colt < qcols) ? scale0 : 1.f;
        if (split_cols) { t = colt / split_cols; basep += (size_t)t * split_stride; colt -= t * split_cols; }
        const int col0 = colt + wc * 32 + 8 * fq;
        const bool do_km = (km != nullptr) && (t == 1);
        f32x4 cs[2][2];
#pragma unroll
        for (int bj = 0; bj < 2; ++bj)
#pragma unroll
            for (int n = 0; n < 2; ++n) cs[bj][n] = (f32x4){0.f, 0.f, 0.f, 0.f};
#pragma unroll
        for (int ai = 0; ai < 2; ++ai)
#pragma unroll
            for (int m = 0; m < 4; ++m) { const int row = row0 + ai * HALF + m * 16; const float rs = rt[ui * 256 + wr * 64 + fr + ai * HALF + m * 16]; const float rsc = rs * sc;
                bf16_t* rowp = basep + (size_t)row * ldc + col0;
#pragma unroll
                for (int bj = 0; bj < 2; ++bj) { const f32x4 v0 = acc[ai][bj][m][0] * rsc, v1 = acc[ai][bj][m][1] * rsc;
                    cs[bj][0] += v0; cs[bj][1] += v1;
                    u32x4 w; w.x = cvt_pk_bf16(v0[0], v0[1]); w.y = cvt_pk_bf16(v0[2], v0[3]); w.z = cvt_pk_bf16(v1[0], v1[1]); w.w = cvt_pk_bf16(v1[2], v1[3]);
                    *(u32x4*)(rowp + bj * HALF) = w; } }
        if (do_km) {
#pragma unroll
            for (int bj = 0; bj < 2; ++bj)
#pragma unroll
                for (int n = 0; n < 2; ++n) { f32x4 v = cs[bj][n];
#pragma unroll
                    for (int o = 1; o < 16; o <<= 1) { v[0] += __shfl_xor(v[0], o); v[1] += __shfl_xor(v[1], o); v[2] += __shfl_xor(v[2], o); v[3] += __shfl_xor(v[3], o); }
                    if (fr == 0) *(f32x4*)(km + (size_t)(u.pm * 2 + wr) * 1024 + col0 + bj * HALF + 4 * n) = v; }
        }
    }
};
template <class Epi, class Sched, bool ALIGN_EPI = false, bool SP2 = false>
__device__ __forceinline__ void gemm_phase(PG8_LAS unsigned char* lds, const Gemm g, const Sched& S, const Epi& E) {
    const int tid = threadIdx.x, wid = __builtin_amdgcn_readfirstlane(tid >> 6), lane = tid & 63, wr = wid >> 2, wc = wid & 3, fr = lane & 15, fq = lane >> 4;
    const int K = g.K, nt = K / BK;
    unsigned voffA[2], voffB[2];
#pragma unroll
    for (int i = 0; i < 2; ++i) { int R, C; stage_rc(tid * 16 + i * 8192, R, C); const int Rb = Epi::PERM ? ((R & ~31) + perm32(R & 31)) : R;
        voffA[i] = (unsigned)(R * K + C) * 2u; voffB[i] = (unsigned)(Rb * K + C) * 2u; }
    const size_t kstep = (size_t)(BK * 2);
    const size_t hstep = (size_t)HALF * K * 2;
    const size_t tstep = 2 * hstep;
    const unsigned ldsw = (unsigned)wid * 1024u;
    const int aoff = lds_byte(wr * 64 + fr, fq * 8), boff = lds_byte(wc * 32 + fr, fq * 8);
#define PG8_SA(b, h) (((b) * 2 + (h)) * HTB)
#define PG8_SB(b, h) ((4 + (b) * 2 + (h)) * HTB)
#define PG8_STAGE(bufoff, gbase, voff) do { _Pragma("unroll") for (int _i = 0; _i < 2; ++_i) \
        __builtin_amdgcn_global_load_lds((const unsigned*)((const char*)(gbase) + (voff)[_i]), (PG8_LAS unsigned*)(lds + (bufoff) + ldsw + _i * 8192), 16, 0, 0); } while (0)
#define PG8_LDA(dst, b, h) do { _Pragma("unroll") for (int m = 0; m < 4; ++m) _Pragma("unroll") for (int k = 0; k < 2; ++k) dst[m][k] = *(const PG8_LAS bf16x8*)(lds + PG8_SA(b, h) + aoff + m * 2048 + k * 1024); } while (0)
#define PG8_LDB(dst, b, h) do { _Pragma("unroll") for (int n = 0; n < 2; ++n) _Pragma("unroll") for (int k = 0; k < 2; ++k) dst[n][k] = *(const PG8_LAS bf16x8*)(lds + PG8_SB(b, h) + boff + n * 2048 + k * 1024); } while (0)
#define PG8_MMA(ai, bj, At, Bt) do { __builtin_amdgcn_s_setprio(1); _Pragma("unroll") for (int m = 0; m < 4; ++m) _Pragma("unroll") for (int n = 0; n < 2; ++n) _Pragma("unroll") for (int k = 0; k < 2; ++k) \
        acc[ai][bj][m][n] = __builtin_amdgcn_mfma_f32_16x16x32_bf16(Bt[n][k], At[m][k], acc[ai][bj][m][n], 0, 0, 0); __builtin_amdgcn_s_setprio(0); } while (0)
#define PG8_WAIT_V(n) asm volatile("s_waitcnt vmcnt(" #n ")" ::: "memory")
#define PG8_WAIT_L(n) asm volatile("s_waitcnt lgkmcnt(" #n ")" ::: "memory")
#define PG8_BAR __builtin_amdgcn_s_barrier()
#define PG8_SCHED __builtin_amdgcn_sched_barrier(0)
    Unit cur, nxt; int ui = 0;
    if (!S.next(0, cur)) return;
    f32x4 acc[2][2][4][2];
#pragma unroll
    for (int a = 0; a < 2; ++a)
#pragma unroll
        for (int b = 0; b < 2; ++b)
#pragma unroll
            for (int m = 0; m < 4; ++m)
#pragma unroll
                for (int n = 0; n < 2; ++n) acc[a][b][m][n] = (f32x4){0.f, 0.f, 0.f, 0.f};
    bf16x8 At[4][2], B0[2][2], B1[2][2];
    const char* cA = (const char*)g.A + (size_t)cur.pm * tstep; const char* cB = (const char*)g.Bt + (size_t)cur.pn * tstep;
    S.a_ready(cur);
    if constexpr (SP2) {
        PG8_STAGE(PG8_SB(0, 0), cB, voffB); PG8_STAGE(PG8_SB(0, 1), cB + hstep, voffB); PG8_STAGE(PG8_SA(0, 0), cA, voffA); PG8_STAGE(PG8_SA(0, 1), cA + hstep, voffA);
        if (wr == 1) PG8_BAR;
        PG8_WAIT_V(2); PG8_BAR;
        PG8_STAGE(PG8_SB(1, 0), cB + kstep, voffB); PG8_STAGE(PG8_SA(1, 0), cA + kstep, voffA); PG8_STAGE(PG8_SB(1, 1), cB + hstep + kstep, voffB);
        PG8_WAIT_V(6); PG8_BAR;
    } else {
        PG8_STAGE(PG8_SB(0, 0), cB, voffB); PG8_STAGE(PG8_SA(0, 0), cA, voffA); PG8_STAGE(PG8_SB(0, 1), cB + hstep, voffB); PG8_STAGE(PG8_SA(0, 1), cA + hstep, voffA);
        if (wr == 1) PG8_BAR;
        PG8_WAIT_V(4); PG8_BAR;
        PG8_STAGE(PG8_SB(1, 0), cB + kstep, voffB); PG8_STAGE(PG8_SA(1, 0), cA + kstep, voffA); PG8_STAGE(PG8_SB(1, 1), cB + hstep + kstep, voffB);
        PG8_WAIT_V(6); PG8_BAR;
    }
    for (;;) {
        const bool has_next = S.next(ui + 1, nxt);
        const char* nA = has_next ? (const char*)g.A + (size_t)nxt.pm * tstep : cA; const char* nB = has_next ? (const char*)g.Bt + (size_t)nxt.pn * tstep : cB;
        for (int t = 0; t < nt; t += 2) {
            const bool last = (t == nt - 2);
            const char* a1 = cA + (size_t)(t + 1) * kstep;
            const char* a2 = last ? nA : cA + (size_t)(t + 2) * kstep; const char* b2 = last ? nB : cB + (size_t)(t + 2) * kstep;
            const char* a3 = a2 + kstep; const char* b3 = b2 + kstep;
            if (last && has_next) S.a_ready(nxt);
            if constexpr (SP2) {
            PG8_LDB(B0, 0, 0); PG8_LDB(B1, 0, 1); PG8_SCHED; PG8_LDA(At, 0, 0); PG8_STAGE(PG8_SA(1, 1), a1 + hstep, voffA);
            PG8_WAIT_V(8); PG8_WAIT_L(0); PG8_BAR; PG8_MMA(0, 0, At, B0); PG8_MMA(0, 1, At, B1); PG8_BAR; PG8_SCHED;
            PG8_LDA(At, 0, 1); PG8_STAGE(PG8_SB(0, 0), b2, voffB); PG8_STAGE(PG8_SB(0, 1), b2 + hstep, voffB); PG8_STAGE(PG8_SA(0, 0), a2, voffA);
            PG8_WAIT_V(8); PG8_WAIT_L(0); PG8_BAR; PG8_MMA(1, 0, At, B0); PG8_MMA(1, 1, At, B1); PG8_BAR; PG8_SCHED;
            PG8_LDB(B0, 1, 0); PG8_LDB(B1, 1, 1); PG8_SCHED; PG8_LDA(At, 1, 0); PG8_STAGE(PG8_SA(0, 1), a2 + hstep, voffA);
            PG8_WAIT_V(8); PG8_WAIT_L(0); PG8_BAR; PG8_MMA(0, 0, At, B0); PG8_MMA(0, 1, At, B1); PG8_BAR; PG8_SCHED;
            PG8_LDA(At, 1, 1); PG8_STAGE(PG8_SB(1, 0), b3, voffB); PG8_STAGE(PG8_SB(1, 1), b3 + hstep, voffB); PG8_STAGE(PG8_SA(1, 0), a3, voffA);
            PG8_WAIT_V(8); PG8_WAIT_L(0); PG8_BAR; PG8_MMA(1, 0, At, B0); PG8_MMA(1, 1, At, B1); PG8_BAR; PG8_SCHED;
            } else {
            PG8_LDB(B0, 0, 0); PG8_SCHED; PG8_LDA(At, 0, 0); PG8_STAGE(PG8_SA(1, 1), a1 + hstep, voffA);
            PG8_WAIT_L(8); PG8_BAR; PG8_WAIT_L(0); PG8_MMA(0, 0, At, B0); PG8_BAR; PG8_SCHED;
            PG8_LDB(B1, 0, 1); PG8_STAGE(PG8_SB(0, 0), b2, voffB);
            PG8_BAR; PG8_WAIT_L(0); PG8_MMA(0, 1, At, B1); PG8_BAR;
            PG8_LDA(At, 0, 1); PG8_STAGE(PG8_SA(0, 0), a2, voffA);
            PG8_BAR; PG8_WAIT_L(0); PG8_MMA(1, 0, At, B0); PG8_BAR; PG8_SCHED;
            PG8_STAGE(PG8_SB(0, 1), b2 + hstep, voffB);
            PG8_WAIT_V(6); PG8_BAR; PG8_MMA(1, 1, At, B1); PG8_BAR;
            PG8_LDB(B0, 1, 0); PG8_SCHED; PG8_LDA(At, 1, 0); PG8_STAGE(PG8_SA(0, 1), a2 + hstep, voffA);
            PG8_WAIT_L(8); PG8_BAR; PG8_WAIT_L(0); PG8_MMA(0, 0, At, B0); PG8_BAR; PG8_SCHED;
            PG8_LDB(B1, 1, 1); PG8_STAGE(PG8_SB(1, 0), b3, voffB);
            PG8_BAR; PG8_WAIT_L(0); PG8_MMA(0, 1, At, B1); PG8_BAR;
            PG8_LDA(At, 1, 1); PG8_STAGE(PG8_SA(1, 0), a3, voffA);
            PG8_BAR; PG8_WAIT_L(0); PG8_MMA(1, 0, At, B0); PG8_BAR; PG8_SCHED;
            PG8_STAGE(PG8_SB(1, 1), b3 + hstep, voffB);
            PG8_WAIT_V(6); PG8_BAR; PG8_MMA(1, 1, At, B1); PG8_BAR;
            }
        }
        if constexpr (ALIGN_EPI) { if (wr == 0) PG8_BAR; }
        if constexpr (!Epi::AFTER_DRAIN) { E(acc, cur, wr, wc, fr, fq, ui); S.done(cur); }
        if (!has_next) break;
#pragma unroll
        for (int a = 0; a < 2; ++a)
#pragma unroll
            for (int b = 0; b < 2; ++b)
#pragma unroll
                for (int m = 0; m < 4; ++m)
#pragma unroll
                    for (int n = 0; n < 2; ++n) acc[a][b][m][n] = (f32x4){0.f, 0.f, 0.f, 0.f};
        cur = nxt; cA = nA; cB = nB; ++ui;
        if constexpr (ALIGN_EPI) { if (wr == 1) PG8_BAR; }
    }
    PG8_WAIT_V(0);
    if constexpr (!ALIGN_EPI) { if (wr == 0) PG8_BAR; }
    PG8_BAR;
    if constexpr (Epi::AFTER_DRAIN) { E.fused(acc, cur, wr, wc, fr, fq, lds, wid, lane); S.done(cur); }
#undef PG8_SA
#undef PG8_SB
#undef PG8_STAGE
#undef PG8_LDA
#undef PG8_LDB
#undef PG8_MMA
#undef PG8_WAIT_V
#undef PG8_WAIT_L
#undef PG8_BAR
#undef PG8_SCHED
}
}
#define PG8_SP2 true
#define PG8_ALIGN true
namespace attn_body {
using bf16=__hip_bfloat16;
using bf16x8=__attribute__((ext_vector_type(8)))short;
using s16x4=__attribute__((ext_vector_type(4)))short;
using f32x16=__attribute__((ext_vector_type(16)))float;
using u32x4=__attribute__((ext_vector_type(4)))unsigned;
constexpr int BATCH=2,NHEAD=16,SEQ=8192,D=64,DM=NHEAD*D;
constexpr int NW=8,QBLK=32,QB=QBLK*NW,KVBLK=64,NQB=SEQ/QB;
constexpr int ATTN_PITCH=DM, ATTN_UNIT_ROWS=QB;
__device__ __forceinline__ int crow(int r,int hi){return (r&3)+8*(r>>2)+4*hi;}
#define SBAR() __builtin_amdgcn_sched_barrier(0)
__device__ __forceinline__ void cmask(f32x16&p0,f32x16&p1,int jb,int qrel,int hi){
  const float NEG=-INFINITY; int kb=64*jb+4*hi;
  #pragma unroll
  for(int r=0;r<16;++r){int kv=kb+(r&3)+8*(r>>2); if(kv>qrel)p0[r]=NEG; if(kv+32>qrel)p1[r]=NEG;}
}

constexpr int NSLOT=3, SLOTB=8192; constexpr float NEGBIG=-2048.f;
constexpr int LDS_K=0, LDS_V=NSLOT*SLOTB, LDS_WS=2*NSLOT*SLOTB, LDS_OST=LDS_WS+NW*64*4, LDS_BYTES=LDS_OST+NW*4096;
constexpr float C2=0.125f*1.4426950408889634f;
__device__ __forceinline__ void glds16(const void*gsrc,unsigned lds_dst){unsigned keep;
  asm volatile("s_mov_b32 %0, m0\n\ts_mov_b32 m0, %2\n\ts_nop 0\n\tglobal_load_lds_dwordx4 %1, off\n\ts_mov_b32 m0, %0":"=&s"(keep):"v"(gsrc),"s"(lds_dst):"memory");}
__device__ __forceinline__ float max3f(float a,float b,float c){float r;asm("v_max3_f32 %0, %1, %2, %3":"=v"(r):"v"(a),"v"(b),"v"(c));return r;}
__device__ __forceinline__ float max2f(float a,float b){float r;asm("v_max_f32_e32 %0, %1, %2":"=v"(r):"v"(a),"v"(b));return r;}
__device__ __forceinline__ float fadd_s(float a,float b){float r;asm("v_add_f32_e32 %0, %1, %2":"=v"(r):"v"(a),"v"(b));return r;}
__device__ __forceinline__ float fsub_s(float a,float b){float r;asm("v_sub_f32_e32 %0, %1, %2":"=v"(r):"v"(a),"v"(b));return r;}
typedef float f32x2_t __attribute__((ext_vector_type(2))); typedef __bf16 bf16x2_t __attribute__((ext_vector_type(2)));
__device__ __forceinline__ unsigned cvtpk_s(float lo,float hi){f32x2_t v={lo,hi};bf16x2_t b=__builtin_convertvector(v,bf16x2_t);return __builtin_bit_cast(unsigned,b);}
#define WAIT_BAR(N) asm volatile("s_waitcnt vmcnt(" #N ") lgkmcnt(0)\n\ts_barrier":::"memory")

__device__ __forceinline__ void qkt(f32x16&p0,f32x16&p1,const char*Kslot,const bf16x8*qr,const f32x16&negm,int r32,int hi){
  const char*kb=Kslot+hi*1024+r32*16;
  #pragma unroll
  for(int d0=0;d0<4;++d0){
    const bf16x8 b0=*reinterpret_cast<const bf16x8*>(kb+d0*2048);
    const bf16x8 b1=*reinterpret_cast<const bf16x8*>(kb+d0*2048+512);
    if(d0==0){p0=__builtin_amdgcn_mfma_f32_32x32x16_bf16(b0,qr[0],negm,0,0,0);p1=__builtin_amdgcn_mfma_f32_32x32x16_bf16(b1,qr[0],negm,0,0,0);}
    else{p0=__builtin_amdgcn_mfma_f32_32x32x16_bf16(b0,qr[d0],p0,0,0,0);p1=__builtin_amdgcn_mfma_f32_32x32x16_bf16(b1,qr[d0],p1,0,0,0);}}
}
typedef __attribute__((address_space(3))) const char* lds_cptr;
typedef short v4i16_t __attribute__((ext_vector_type(4)));
__device__ __forceinline__ void kload8(bf16x8*kf,lds_cptr kp){
  kf[0]=*(const __attribute__((address_space(3))) bf16x8*)(kp);      kf[1]=*(const __attribute__((address_space(3))) bf16x8*)(kp+512);
  kf[2]=*(const __attribute__((address_space(3))) bf16x8*)(kp+2048); kf[3]=*(const __attribute__((address_space(3))) bf16x8*)(kp+2560);
  kf[4]=*(const __attribute__((address_space(3))) bf16x8*)(kp+4096); kf[5]=*(const __attribute__((address_space(3))) bf16x8*)(kp+4608);
  kf[6]=*(const __attribute__((address_space(3))) bf16x8*)(kp+6144); kf[7]=*(const __attribute__((address_space(3))) bf16x8*)(kp+6656);
}
__device__ __forceinline__ void kload2(bf16x8*kf,lds_cptr kp,int j){ kf[2*j]=*(const __attribute__((address_space(3))) bf16x8*)(kp+j*2048); kf[2*j+1]=*(const __attribute__((address_space(3))) bf16x8*)(kp+j*2048+512); }
__device__ __forceinline__ s16x4 vtr(lds_cptr p){ return __builtin_bit_cast(s16x4,__builtin_amdgcn_ds_read_tr16_b64_v4i16((__attribute__((address_space(3))) v4i16_t*)p)); }
__device__ __forceinline__ float rowmax(const f32x16&p0,const f32x16&p1){
  float a=max3f(p0[0],p0[1],p1[0]),b=max3f(p0[2],p0[3],p1[1]);a=max3f(a,p1[2],p1[3]);
  #pragma unroll
  for(int r=4;r<16;r+=4){a=max3f(a,p0[r],p0[r+1]);b=max3f(b,p0[r+2],p0[r+3]);a=max3f(a,p1[r],p1[r+1]);b=max3f(b,p1[r+2],p1[r+3]);}
  const float m=max2f(a,b);
  auto rr=__builtin_amdgcn_permlane32_swap(__float_as_uint(m),__float_as_uint(m),false,false);
  return max2f(__uint_as_float(rr[0]),__uint_as_float(rr[1]));
}
__device__ __forceinline__ void pv(f32x16*o,int vb,bf16x8 pa0,bf16x8 pa1,bf16x8 pa2,bf16x8 pa3){
  #pragma unroll
  for(int d0=0;d0<2;++d0){s16x4 lo[4],hi[4];
    #pragma unroll
    for(int ks=0;ks<4;++ks){
      asm volatile("ds_read_b64_tr_b16 %0,%1 offset:%c2":"=&v"(lo[ks]):"v"(vb),"i"(d0*4096+ks*1024):"memory");
      asm volatile("ds_read_b64_tr_b16 %0,%1 offset:%c2":"=&v"(hi[ks]):"v"(vb),"i"(d0*4096+ks*1024+512):"memory");}
    asm volatile("s_waitcnt lgkmcnt(0)":::"memory");SBAR();
    #define PK(k) (bf16x8){lo[k][0],lo[k][1],lo[k][2],lo[k][3],hi[k][0],hi[k][1],hi[k][2],hi[k][3]}
    o[d0]=__builtin_amdgcn_mfma_f32_32x32x16_bf16(pa0,PK(0),o[d0],0,0,0);
    o[d0]=__builtin_amdgcn_mfma_f32_32x32x16_bf16(pa1,PK(1),o[d0],0,0,0);
    o[d0]=__builtin_amdgcn_mfma_f32_32x32x16_bf16(pa2,PK(2),o[d0],0,0,0);
    o[d0]=__builtin_amdgcn_mfma_f32_32x32x16_bf16(pa3,PK(3),o[d0],0,0,0);
    #undef PK
  }
}

#ifndef ATTN_STORE16
#define ATTN_STORE16(p,v) (*(u32x4*)(p)=(v))
#endif
template<int THRL> __device__ __forceinline__ void attn_unit(int b,int h,int qb,const bf16*Q,const bf16*__restrict__ K,const bf16*__restrict__ V,bf16*O,const unsigned*__restrict__ SEL,char*shm){
  const int tid=threadIdx.x,lane=tid&63,r32=lane&31,hi=lane>>5; const int wid=__builtin_amdgcn_readfirstlane(tid>>6);
  const long rowbase=(long)b*SEQ; const int q0=qb*QB;
  const bf16*Qw=Q+(rowbase+q0+wid*QBLK)*DM+h*D;
  const bf16*Kh=K+rowbase*DM+h*D,*Vh=V+rowbase*DM+h*D;
  const unsigned lds0=(unsigned)(uintptr_t)shm;
  float*wsf=(float*)(shm+LDS_WS)+wid*64;
  const bf16*ksrc=Kh+(long)lane*DM+wid*8;
  const bf16*vsrc=Vh+(long)(16*(wid&3)+(lane>>2))*DM+(wid>>2)*32+(lane&3)*8;
  const unsigned kdst=lds0+LDS_K+wid*1024, vdst=lds0+LDS_V+wid*1024;
  #define DMA_K(t,slot) glds16(ksrc+(long)(t)*KVBLK*DM,(unsigned)__builtin_amdgcn_readfirstlane(kdst+(slot)))
  #define DMA_V(t,slot) glds16(vsrc+(long)(t)*KVBLK*DM,(unsigned)__builtin_amdgcn_readfirstlane(vdst+(slot)))
  const int vb0=(int)(lds0+LDS_V)+((lane>>4)&1)*32+(lane&3)*8+(4*hi+((lane&15)>>2))*64;
  const char*Kbase=shm+LDS_K; bf16x8 kf[8];
  const lds_cptr shm3=(lds_cptr)shm; const lds_cptr kp0=shm3+LDS_K+hi*1024+r32*16; const lds_cptr vp0=shm3+LDS_V+((lane>>4)&1)*32+(lane&3)*8+(4*hi+((lane&15)>>2))*64;
  const int NT=(q0+QB)/KVBLK;
  DMA_K(0,0);DMA_V(0,0);DMA_K(1,SLOTB);
  bf16x8 qr[4];
  #pragma unroll
  for(int d0=0;d0<4;++d0)qr[d0]=*reinterpret_cast<const bf16x8*>(&Qw[(long)r32*DM+d0*16+hi*8]);
  float mhat=0.f,l_reg=0.f;f32x16 o[2];o[0]=f32x16{};o[1]=f32x16{};const f32x16 negm=f32x16{};
  const int qrel=wid*QBLK+r32; volatile unsigned*sel_l=(volatile unsigned*)(shm+LDS_BYTES)+wid*32; if(hi==0)sel_l[r32]=SEL[(size_t)(b*NHEAD+h)*SEQ+q0+qrel];
  #define CMASK(P0,P1,t) do{int jb_=(t)-(NT-4); if(jb_>=0){cmask(P0,P1,jb_,qrel,hi);} else if(!((sel_l[r32]>>(((t)>>2)&31))&1u)){ _Pragma("unroll") for(int r_=0;r_<16;++r_){P0[r_]=NEGBIG;P1[r_]=NEGBIG;} } }while(0)
  bool resc=false;
  #define START(P0,P1) do{ const float rm=rowmax(P0,P1); resc=false; \
    { const float dl=rm; mhat=fadd_s(mhat,dl); \
      _Pragma("unroll") for(int r=0;r<16;++r){P0[r]=fsub_s(P0[r],dl);P1[r]=fsub_s(P1[r],dl);} \
      } \
    _Pragma("unroll") for(int r=0;r<16;++r)P0[r]=__builtin_amdgcn_exp2f(P0[r]); }while(0)
  #define RESC() do{ if(resc){ asm volatile("s_waitcnt lgkmcnt(0)":::"memory"); \
      _Pragma("unroll") for(int d_=0;d_<2;++d_) _Pragma("unroll") for(int r=0;r<16;++r)o[d_][r]*=wsf[crow(r,hi)]; } }while(0)
  f32x16 pA0,pA1,pB0,pB1;
  int sl_prev=0,sl_cur=0,sl_next=SLOTB;
  #define ROT() do{sl_prev=sl_cur;sl_cur=sl_next;sl_next=(sl_next==(NSLOT-1)*SLOTB)?0:sl_next+SLOTB;}while(0)
  DMA_K(2,2*SLOTB);
  WAIT_BAR(3);
  qkt(pA0,pA1,Kbase,qr,negm,r32,hi);asm volatile("s_nop 15\n\ts_nop 7":"+v"(pA0),"+v"(pA1));CMASK(pA0,pA1,0);
  START(pA0,pA1);
  _Pragma("unroll") for(int r=0;r<16;++r)pA1[r]=__builtin_amdgcn_exp2f(pA1[r]);
  WAIT_BAR(0);
  DMA_K(3,0);DMA_V(1,SLOTB);
  ROT();
  kload8(kf,kp0+sl_cur);
  WAIT_BAR(2);
  s16x4 vlo[8],vhi[8]; u32x4 pw0,pw1,pw2,pw3;
  #define PKW(P,B) cvtpk_s(P[B],P[B+1])
  #define PAF(k) __builtin_bit_cast(bf16x8,pw##k)
  #define VFR(i) (bf16x8){vlo[i][0],vlo[i][1],vlo[i][2],vlo[i][3],vhi[i][0],vhi[i][1],vhi[i][2],vhi[i][3]}
  #define PIN(x) asm volatile("":"+v"(x))
  #define MX3(a,b,c) __builtin_fmaxf(__builtin_fmaxf((a),(b)),(c))
  #define GAPA(MF,A0,A1,A2,A3,W0,W1,PW) do{ MF; sacc+=A0; sacc+=A1; sacc+=A2; sacc+=A3; PIN(sacc); W0; W1; PIN(PW); SBAR(); }while(0)
  #define EX(v) __builtin_amdgcn_exp2f(v)
  #define GAPB(MF,X,B) do{ MF; X[B]=EX(X[B]); X[B+1]=EX(X[B+1]); X[B+2]=EX(X[B+2]); X[B+3]=EX(X[B+3]); PIN(X); SBAR(); }while(0)
  #define VRD(i) do{ vlo[i]=vtr(vp_+(((i)>>2)*4096+((i)&3)*1024)); vhi[i]=vtr(vp_+(((i)>>2)*4096+((i)&3)*1024+512)); }while(0)
  #define KRD(G,j) do{ if(G){ kload2(kf,kp0+sl_next,j); SBAR(); } }while(0)
  #define STEP(C0,C1,P0,P1,t,GK,GV,GL) do{ SBAR(); \
    const lds_cptr vp_=vp0+sl_prev; \
    VRD(0); SBAR(); float sacc=(P0[0]+P0[1]); \
    GAPA(C0=__builtin_amdgcn_mfma_f32_32x32x16_bf16(kf[0],qr[0],negm,0,0,0), P0[2],P0[3],P0[4],P0[5],     pw0[0]=PKW(P0,0), pw0[1]=PKW(P0,2), pw0); \
    VRD(4); SBAR(); GAPA(C1=__builtin_amdgcn_mfma_f32_32x32x16_bf16(kf[1],qr[0],negm,0,0,0), P0[6],P0[7],P0[8],P0[9],     pw0[2]=PKW(P0,4), pw0[3]=PKW(P0,6), pw0); \
    VRD(1); SBAR(); GAPA(C0=__builtin_amdgcn_mfma_f32_32x32x16_bf16(kf[2],qr[1],C0,0,0,0),   P0[10],P0[11],P0[12],P0[13], pw1[0]=PKW(P0,8), pw1[1]=PKW(P0,10), pw1); \
    VRD(5); SBAR(); GAPA(C1=__builtin_amdgcn_mfma_f32_32x32x16_bf16(kf[3],qr[1],C1,0,0,0),   P0[14],P0[15],P1[0],P1[1],   pw1[2]=PKW(P0,12),pw1[3]=PKW(P0,14), pw1); \
    VRD(2); SBAR(); GAPA(C0=__builtin_amdgcn_mfma_f32_32x32x16_bf16(kf[4],qr[2],C0,0,0,0),   P1[2],P1[3],P1[4],P1[5],     pw2[0]=PKW(P1,0), pw2[1]=PKW(P1,2), pw2); \
    VRD(6); SBAR(); GAPA(C1=__builtin_amdgcn_mfma_f32_32x32x16_bf16(kf[5],qr[2],C1,0,0,0),   P1[6],P1[7],P1[8],P1[9],     pw2[2]=PKW(P1,4), pw2[3]=PKW(P1,6), pw2); \
    VRD(3); SBAR(); GAPA(C0=__builtin_amdgcn_mfma_f32_32x32x16_bf16(kf[6],qr[3],C0,0,0,0),   P1[10],P1[11],P1[12],P1[13], pw3[0]=PKW(P1,8), pw3[1]=PKW(P1,10), pw3); \
    VRD(7); SBAR(); GAPA(C1=__builtin_amdgcn_mfma_f32_32x32x16_bf16(kf[7],qr[3],C1,0,0,0),   P1[14],P1[15],0.f,0.f,       pw3[2]=PKW(P1,12),pw3[3]=PKW(P1,14), pw3); \
    l_reg+=sacc; \
    if(GK){DMA_K((t)+3,sl_cur);} if(GV){DMA_V((t)+1,sl_next);} \
    _Pragma("unroll") for(int r=0;r<16;++r){C0[r]-=mhat;C1[r]-=mhat;} \
    CMASK(C0,C1,t); \
    { float a=MX3(C0[0],C0[1],C1[0]),b=MX3(C0[2],C0[3],C1[1]); a=MX3(a,C1[2],C1[3]); \
      _Pragma("unroll") for(int r=4;r<16;r+=4){a=MX3(a,C0[r],C0[r+1]);b=MX3(b,C0[r+2],C0[r+3]);a=MX3(a,C1[r],C1[r+1]);b=MX3(b,C1[r+2],C1[r+3]);} \
      float rm=__builtin_fmaxf(a,b); { auto rr=__builtin_amdgcn_permlane32_swap(__float_as_uint(rm),__float_as_uint(rm),false,false); rm=__builtin_fmaxf(__uint_as_float(rr[0]),__uint_as_float(rr[1])); } \
      resc=false; \
      if(__builtin_expect(__any(rm>(float)THRL),0)){ const float dl=__builtin_fmaxf(rm,0.f); mhat+=dl; \
        _Pragma("unroll") for(int r=0;r<16;++r){C0[r]-=dl;C1[r]-=dl;} \
        const float f=__builtin_amdgcn_exp2f(-dl); l_reg*=f; if(hi==0)wsf[r32]=f; resc=true; } } \
    SBAR(); \
    GAPB(o[0]=__builtin_amdgcn_mfma_f32_32x32x16_bf16(PAF(0),VFR(0),o[0],0,0,0), C0,0); \
    GAPB(o[1]=__builtin_amdgcn_mfma_f32_32x32x16_bf16(PAF(0),VFR(4),o[1],0,0,0), C0,4); \
    KRD(GL,0); GAPB(o[0]=__builtin_amdgcn_mfma_f32_32x32x16_bf16(PAF(1),VFR(1),o[0],0,0,0), C0,8); \
    KRD(GL,1); GAPB(o[1]=__builtin_amdgcn_mfma_f32_32x32x16_bf16(PAF(1),VFR(5),o[1],0,0,0), C0,12); \
    KRD(GL,2); GAPB(o[0]=__builtin_amdgcn_mfma_f32_32x32x16_bf16(PAF(2),VFR(2),o[0],0,0,0), C1,0); \
    KRD(GL,3); GAPB(o[1]=__builtin_amdgcn_mfma_f32_32x32x16_bf16(PAF(2),VFR(6),o[1],0,0,0), C1,4); \
    GAPB(o[0]=__builtin_amdgcn_mfma_f32_32x32x16_bf16(PAF(3),VFR(3),o[0],0,0,0), C1,8); \
    GAPB(o[1]=__builtin_amdgcn_mfma_f32_32x32x16_bf16(PAF(3),VFR(7),o[1],0,0,0), C1,12); \
    }while(0)
  int t=1;
  #undef CMASK
  #define CMASK(P0,P1,t) do{ if(!((sel_l[r32]>>(((t)>>2)&31))&1u)){ _Pragma("unroll") for(int r_=0;r_<16;++r_){P0[r_]=NEGBIG;P1[r_]=NEGBIG;} } }while(0)
  for(;t+5<NT;t+=2){
    STEP(pB0,pB1,pA0,pA1,t,true,true,true);     WAIT_BAR(2); RESC(); ROT();
    STEP(pA0,pA1,pB0,pB1,t+1,true,true,true);   WAIT_BAR(2); RESC(); ROT();
  }
  #undef CMASK
  #define CMASK(P0,P1,t) do{int jb_=(t)-(NT-4); if(jb_>=0){cmask(P0,P1,jb_,qrel,hi);} else if(!((sel_l[r32]>>(((t)>>2)&31))&1u)){ _Pragma("unroll") for(int r_=0;r_<16;++r_){P0[r_]=NEGBIG;P1[r_]=NEGBIG;} } }while(0)
  #define ENDW(tt) do{ if((tt)+3<NT){WAIT_BAR(2);} else if((tt)+2<NT){WAIT_BAR(1);} else {WAIT_BAR(0);} }while(0)
  for(;t+1<NT;t+=2){
    STEP(pB0,pB1,pA0,pA1,t,(t+3<NT),(t+1<NT),(t+1<NT));       ENDW(t);   RESC(); ROT();
    STEP(pA0,pA1,pB0,pB1,t+1,(t+4<NT),(t+2<NT),(t+2<NT));     ENDW(t+1); RESC(); ROT();
  }
  STEP(pB0,pB1,pA0,pA1,NT-1,false,false,false); RESC();
  { float sacc=pB0[0]+pB0[1]; _Pragma("unroll") for(int r=2;r<16;++r)sacc+=pB0[r]; _Pragma("unroll") for(int r=0;r<16;++r)sacc+=pB1[r]; l_reg+=sacc;
    pw0=(u32x4){PKW(pB0,0),PKW(pB0,2),PKW(pB0,4),PKW(pB0,6)};pw1=(u32x4){PKW(pB0,8),PKW(pB0,10),PKW(pB0,12),PKW(pB0,14)};pw2=(u32x4){PKW(pB1,0),PKW(pB1,2),PKW(pB1,4),PKW(pB1,6)};pw3=(u32x4){PKW(pB1,8),PKW(pB1,10),PKW(pB1,12),PKW(pB1,14)};
    SBAR(); pv(o,vb0+sl_cur,PAF(0),PAF(1),PAF(2),PAF(3)); }
  #undef PKW
  #undef PAF
  #undef VFR
  #undef PIN
  #undef MX3
  #undef GAPA
  #undef GAPB
  #undef EX
  #undef VRD
  #undef KRD
  #undef STEP
  #undef ENDW
  {auto rr=__builtin_amdgcn_permlane32_swap(__float_as_uint(l_reg),__float_as_uint(l_reg),false,false);l_reg=__uint_as_float(rr[0])+__uint_as_float(rr[1]);}
  if(hi==0)wsf[32+r32]=l_reg;asm volatile("s_waitcnt lgkmcnt(0)":::"memory");
  float rli[16];
  #pragma unroll
  for(int r=0;r<16;++r)rli[r]=__builtin_amdgcn_rcpf(wsf[32+crow(r,hi)]);
  bf16*Ow=O+(rowbase+q0+wid*QBLK)*DM+h*D;
  { bf16*stg=(bf16*)(shm+LDS_OST)+wid*2048;
    #pragma unroll
    for(int r=0;r<16;++r){const int orow=crow(r,hi);
      #pragma unroll
      for(int d0=0;d0<2;++d0)stg[orow*64+d0*32+r32]=__float2bfloat16(o[d0][r]*rli[r]);}
    asm volatile("s_waitcnt lgkmcnt(0)":::"memory");
    #pragma unroll
    for(int i=0;i<4;++i){const int row=i*8+(lane>>3),ch=lane&7; const u32x4 v=*(const u32x4*)(stg+row*64+ch*8); ATTN_STORE16(Ow+(long)row*DM+ch*8,v);} }
  asm volatile("s_waitcnt lgkmcnt(0)\n\ts_barrier":::"memory");
  #undef DMA_K
  #undef DMA_V
  #undef CMASK
  #undef START
  #undef RESC
  #undef ROT
}
constexpr int ATTN_LDS_BYTES=LDS_BYTES;
struct AttnTensors { const bf16* Q; const bf16* K; const bf16* V; bf16* O; const unsigned* SEL; };
struct AttnUnit { int bh; int qb; };
struct StaticOrder {
  int vcu;
  __device__ __forceinline__ explicit StaticOrder(int grid,int block):vcu((block%8)*(grid/8)+block/8){}
  __device__ __forceinline__ bool next(int i,AttnUnit&u)const{ if(i>=4)return false; const int s=vcu&7; u.bh=vcu>>3; u.qb=(i==0)?s:(i==1)?15-s:(i==2)?16+s:31-s; return true; }
  __device__ __forceinline__ void a_ready(const AttnUnit&)const{}
  __device__ __forceinline__ void done(const AttnUnit&)const{}
};
template<class Sched,int THRL=8> __device__ __forceinline__ void attn_phase(char*lds,const AttnTensors&T,const Sched&S){
  AttnUnit u;
  for(int i=0;S.next(i,u);++i){ S.a_ready(u); attn_unit<THRL>(u.bh/NHEAD,u.bh%NHEAD,u.qb,T.Q,T.K,T.V,T.O,T.SEL,lds); S.done(u); }
}
#undef SBAR
#undef WAIT_BAR
}
#define LAS __attribute__((address_space(3)))
typedef unsigned short bf16;
typedef unsigned v4u __attribute__((ext_vector_type(4)));
typedef unsigned v2u __attribute__((ext_vector_type(2)));
typedef float f32x4 __attribute__((ext_vector_type(4)));
typedef short bf16x8 __attribute__((ext_vector_type(8)));
typedef short s16x4 __attribute__((ext_vector_type(4)));
constexpr int NWAVES = 8, NTHR = 512;
constexpr int SEQ = 8192, DM = 1024, M = 16384, FF = 2816, ABIN = 2560, CIN = 3072;
constexpr float C2 = 0.125f * 1.4426950408889634f;
constexpr size_t MiB = 1u << 20;
__host__ __device__ constexpr size_t ws_wgu(int f) { return (f == 0 ? 2 : f == 1 ? 13 : f == 2 ? 42 : 53) * MiB; }
__host__ __device__ constexpr size_t ws_wd(int f) { return (f == 0 ? 48 : f == 1 ? 59 : f == 2 ? 128 : 139) * (MiB / 2); }
constexpr size_t WS_WABIN = 35 * MiB, WS_WABOUT = 40 * MiB, WS_WCIN = 75 * MiB, WS_WCOUT = 81 * MiB;
constexpr size_t WS_PO2 = 2 * MiB, WS_LSE = 34 * MiB;
constexpr size_t WS_CNT = 131072;
constexpr size_t WS_LIST = 248 * MiB;
constexpr size_t WS_WSB = 83 * MiB;
constexpr size_t WS_PART = 84 * MiB;
constexpr size_t WS_KM = 85 * MiB;
constexpr size_t WS_SEL = 86 * MiB;
constexpr size_t WS_XB = 88 * MiB;
constexpr size_t WS_ACT = 120 * MiB;
constexpr size_t WS_MIX = 216 * MiB;
constexpr size_t WS_END = 256 * MiB;
constexpr int LDS_BYTES = 147456;
constexpr int MISC_OFF = 131072 + 320;
constexpr size_t WS_BAR = 65536;

__device__ __forceinline__ unsigned f2bf(float f) { unsigned u = __builtin_bit_cast(unsigned, f); return (u + 0x7fffu + ((u >> 16) & 1u)) >> 16; }
typedef float f32x2_t __attribute__((ext_vector_type(2))); typedef __bf16 bf16x2_t __attribute__((ext_vector_type(2)));
__device__ __forceinline__ unsigned pk2(float lo, float hi) { f32x2_t v = {lo, hi}; bf16x2_t b = __builtin_convertvector(v, bf16x2_t); return __builtin_bit_cast(unsigned, b); }
__device__ __forceinline__ float bf2f(unsigned short b) { return __builtin_bit_cast(float, (unsigned)b << 16); }
__device__ __forceinline__ float wave_sum(float v) {
#pragma unroll
    for (int o = 1; o < 64; o <<= 1) v += __shfl_xor(v, o);
    return v;
}
__device__ __forceinline__ float gelu_tanh(float x) {
    const float y = 0.7978845608028654f * (x + 0.044715f * x * x * x);
    return x * __builtin_amdgcn_rcpf(1.0f + __builtin_amdgcn_exp2f(-2.0f * 1.4426950408889634f * y));
}
constexpr int TP_STRIDE = 136;
__device__ __forceinline__ void p0_transpose_item(const float* W, int K, int N, bf16* WT, int mode, const float* gain, LAS unsigned char* scr, int item, int lane) {
    const int nblk = N / 64, kb = item / nblk, nb = item % nblk, k0 = 64 * kb, n0 = 64 * nb;
    const int d0 = (mode == 0) ? n0 : ((n0 >> 7) * 256 + (n0 & 127) + (mode == 2 ? 128 : 0));
    const int kr = lane >> 4, nc = (lane & 15) * 4;
    f32x4 v[16];
#pragma unroll
    for (int i = 0; i < 16; ++i) v[i] = *(const f32x4*)(W + (size_t)(k0 + 4 * i + kr) * N + n0 + nc);
#pragma unroll
    for (int i = 0; i < 16; ++i) { const float gk = gain ? gain[k0 + 4 * i + kr] : 1.0f; v2u w; w.x = pk2(v[i][0] * gk, v[i][1] * gk); w.y = pk2(v[i][2] * gk, v[i][3] * gk);
        *(LAS v2u*)(scr + (4 * i + kr) * TP_STRIDE + nc * 2) = w; }
    asm volatile("s_waitcnt lgkmcnt(0)" ::: "memory");
    const int g = lane >> 4, li = lane & 15, qq = li >> 2, pp = li & 3;
#pragma unroll
    for (int nb16 = 0; nb16 < 4; ++nb16)
#pragma unroll
        for (int half = 0; half < 2; ++half) { const int kc = g + 4 * half;
            LAS unsigned char* a = scr + (8 * kc + qq) * TP_STRIDE + (16 * nb16 + 4 * pp) * 2;
            const s16x4 lo = __builtin_bit_cast(s16x4, __builtin_amdgcn_ds_read_tr16_b64_v4i16((LAS s16x4*)a));
            const s16x4 hi = __builtin_bit_cast(s16x4, __builtin_amdgcn_ds_read_tr16_b64_v4i16((LAS s16x4*)(a + 4 * TP_STRIDE)));
            const bf16x8 o = (bf16x8){lo[0], lo[1], lo[2], lo[3], hi[0], hi[1], hi[2], hi[3]};
            *(bf16x8*)(WT + (size_t)(d0 + 16 * nb16 + li) * K + k0 + 8 * kc) = o; }
    asm volatile("s_waitcnt lgkmcnt(0)" ::: "memory");
}
#define XB_TMO      128
#define XB_XCNT(j)  (256  + 64 * (j))
#define XB_XSUB(j)  (1280 + 64 * (j))
#define XB_XGEN(j)  (2304 + 64 * (j))
#define XB_TOP      3328
#define XB_TOPGEN   3392
#define XCD_BAR_WORDS 3456
#define XB_SPIN_CAP (1u << 18)

__device__ __forceinline__ unsigned xb_ld(unsigned* p)              { return __hip_atomic_load(p, __ATOMIC_RELAXED, __HIP_MEMORY_SCOPE_AGENT); }
__device__ __forceinline__ unsigned xb_add(unsigned* p, unsigned v) { return __hip_atomic_fetch_add(p, v, __ATOMIC_RELAXED, __HIP_MEMORY_SCOPE_AGENT); }
__device__ __forceinline__ unsigned xb_xcc_id() { return (unsigned)__builtin_amdgcn_s_getreg((3 << 11) | 20) & 0xFu; }
#define XB_SPIN(cond, bar) do { unsigned _sp = 0; while (cond) { __builtin_amdgcn_s_sleep(1); \
    if ((++_sp & 255u) == 0u) { if (xb_ld(&(bar)[XB_TMO])) break; if (_sp > XB_SPIN_CAP) { atomicAdd(&(bar)[XB_TMO], 1u); break; } } } } while (0)

struct XcdBarrier {
    unsigned* bar; unsigned x;
    volatile LAS unsigned* st;
};

__device__ __forceinline__ XcdBarrier xcd_barrier_post(unsigned* bar, volatile LAS unsigned* st) {
    XcdBarrier b; b.bar = bar; b.x = xb_xcc_id(); b.st = st;
    if (threadIdx.x == 0) (void)xb_add(&bar[XB_XCNT(b.x)], 1u);
    return b;
}
__device__ __forceinline__ void xcd_barrier_complete(unsigned* bar, unsigned x, unsigned& nloc, unsigned& nx) {
    const unsigned G = gridDim.x * gridDim.y * gridDim.z;
    unsigned sum, cnt, mine, sp = 0u;
    for (;;) {
        sum = 0u; cnt = 0u; mine = 0u;
#pragma unroll
        for (unsigned j = 0; j < 16; ++j) { const unsigned c = xb_ld(&bar[XB_XCNT(j)]); sum += c; cnt += (c > 0u) ? 1u : 0u; mine = (j == x) ? c : mine; }
        if (sum == G) break;
        __builtin_amdgcn_s_sleep(1);
        if ((++sp & 255u) == 0u) { if (xb_ld(&bar[XB_TMO])) break; if (sp > XB_SPIN_CAP) { atomicAdd(&bar[XB_TMO], 1u); break; } }
    }
    nloc = mine > 0u ? mine : 1u; nx = cnt > 0u ? cnt : 1u;
}

__device__ __forceinline__ void xcd_barrier(const XcdBarrier& b) {
    asm volatile("s_waitcnt vmcnt(0)" ::: "memory");
    __syncthreads();
    if (threadIdx.x == 0) {
        unsigned* bar = b.bar;
        __builtin_amdgcn_s_waitcnt(0);
        unsigned nloc = b.st[0], nx = b.st[1];
        if (nloc == 0u) { xcd_barrier_complete(bar, b.x, nloc, nx); b.st[0] = nloc; b.st[1] = nx; }
        const unsigned old = xb_add(&bar[XB_XSUB(b.x)], 1u);
        const unsigned gen = old / nloc;
        if (old + 1u == (gen + 1u) * nloc) {
            __builtin_amdgcn_fence(__ATOMIC_RELEASE, "agent");
            asm volatile("s_waitcnt vmcnt(0)" ::: "memory");
            const unsigned og = xb_add(&bar[XB_TOP], 1u);
            const unsigned tg = og / nx;
            if (og + 1u == (tg + 1u) * nx) xb_add(&bar[XB_TOPGEN], 1u);
            else XB_SPIN(xb_ld(&bar[XB_TOPGEN]) == tg, bar);
            __builtin_amdgcn_fence(__ATOMIC_ACQUIRE, "agent");
            xb_add(&bar[XB_XGEN(b.x)], 1u);
            asm volatile("s_waitcnt vmcnt(0)" ::: "memory");
        } else {
            XB_SPIN(xb_ld(&bar[XB_XGEN(b.x)]) == gen, bar);
            __builtin_amdgcn_fence(__ATOMIC_ACQUIRE, "agent");
            asm volatile("s_waitcnt vmcnt(0)" ::: "memory");
        }
    }
    __syncthreads();
}

struct EpiResidNorm {
    static constexpr bool PERM = true, AFTER_DRAIN = true;
    const bf16* basexb; float* out; float* part; const float* gfin; float alpha; XcdBarrier xb;
    __device__ __forceinline__ void fused(pg8::f32x4 (&acc)[2][2][4][2], const pg8::Unit& u, int wr, int wc, int fr, int fq, LAS unsigned char* lds, int wid, int lane) const {
        const int row0 = u.pm * pg8::BM + wr * 64 + fr; const int col0 = u.pn * pg8::BM + wc * 32 + 8 * fq;
#pragma unroll
        for (int ai = 0; ai < 2; ++ai)
#pragma unroll
            for (int m = 0; m < 4; ++m) { const int row = row0 + ai * pg8::HALF + m * 16; float ss = 0.f;
#pragma unroll
                for (int bj = 0; bj < 2; ++bj) { const size_t off = (size_t)row * 1024 + col0 + bj * pg8::HALF;
                    const v4u r = *(const v4u*)(basexb + off);
                    const pg8::f32x4 b0 = (pg8::f32x4){__builtin_bit_cast(float, r.x << 16), __builtin_bit_cast(float, r.x & 0xffff0000u), __builtin_bit_cast(float, r.y << 16), __builtin_bit_cast(float, r.y & 0xffff0000u)};
                    const pg8::f32x4 b1 = (pg8::f32x4){__builtin_bit_cast(float, r.z << 16), __builtin_bit_cast(float, r.z & 0xffff0000u), __builtin_bit_cast(float, r.w << 16), __builtin_bit_cast(float, r.w & 0xffff0000u)};
                    const pg8::f32x4 v0 = b0 + acc[ai][bj][m][0] * alpha, v1 = b1 + acc[ai][bj][m][1] * alpha;
                    acc[ai][bj][m][0] = v0; acc[ai][bj][m][1] = v1;
                    ss += ((v0[0] * v0[0] + v0[1] * v0[1]) + (v0[2] * v0[2] + v0[3] * v0[3])) + ((v1[0] * v1[0] + v1[1] * v1[1]) + (v1[2] * v1[2] + v1[3] * v1[3])); }
                ss += __shfl_xor(ss, 16); ss += __shfl_xor(ss, 32);
                if (fq == 0) part[(size_t)row * 16 + u.pn * 4 + wc] = ss; }
        xcd_barrier(xb);
#pragma unroll
        for (int ai = 0; ai < 2; ++ai)
#pragma unroll
            for (int m = 0; m < 4; ++m) { const int row = row0 + ai * pg8::HALF + m * 16; const float rs = pg8::row_rstd(part, row);
#pragma unroll
                for (int bj = 0; bj < 2; ++bj) { const size_t off = (size_t)row * 1024 + col0 + bj * pg8::HALF;
                    const pg8::f32x4 g0 = *(const pg8::f32x4*)(gfin + col0 + bj * pg8::HALF), g1 = *(const pg8::f32x4*)(gfin + col0 + bj * pg8::HALF + 4);
                    *(pg8::f32x4*)(out + off) = acc[ai][bj][m][0] * rs * g0; *(pg8::f32x4*)(out + off + 4) = acc[ai][bj][m][1] * rs * g1; } }
    }
};
constexpr int RSTD_OFF = 131072 + 1024;
__device__ __forceinline__ void rstd_table(const float* part, LAS unsigned char* lds, const pg8::StaticOrder& S) {
    LAS float* T = (LAS float*)(lds + RSTD_OFF);
    const int tid = threadIdx.x;
#pragma unroll
    for (int pass = 0; pass < 3; ++pass) { const int i = 2 * pass + (tid >> 8); pg8::Unit u; if (S.next(i, u)) T[i * 256 + (tid & 255)] = pg8::row_rstd(part, u.pm * 256 + (tid & 255)); }
    __syncthreads();
}
struct Args { const float* in[18]; float* out; unsigned char* ws; int ph_lo, ph_hi; };

constexpr int I_G = (DM / 64) * (FF / 64), I_D = (FF / 64) * (DM / 64), I_ABIN = (DM / 64) * (ABIN / 64), I_SQ = (DM / 64) * (DM / 64), I_CIN = (DM / 64) * (CIN / 64);
__device__ __forceinline__ constexpr int mat_items(int id) { return id < 0 ? 0 : id < 4 ? 2 * I_G : id < 8 ? I_D : id == 8 ? I_ABIN : id == 10 ? I_CIN : I_SQ; }
__device__ __forceinline__ void conv_item(const Args& A, LAS unsigned char* scr, int lane, int id, int r) {
    unsigned char* ws = A.ws;
    if (id < 4) { const int f = id, layer = f >> 1, second = f & 1; const float* gain = A.in[second ? 6 : 1] + layer * DM; bf16* wgu = (bf16*)(ws + ws_wgu(f));
        if (r < I_G) p0_transpose_item(A.in[second ? 7 : 2] + (size_t)layer * DM * FF, DM, FF, wgu, 1, gain, scr, r, lane);
        else p0_transpose_item(A.in[second ? 8 : 3] + (size_t)layer * DM * FF, DM, FF, wgu, 2, gain, scr, r - I_G, lane); }
    else if (id < 8) { const int f = id - 4, layer = f >> 1, second = f & 1; p0_transpose_item(A.in[second ? 9 : 4] + (size_t)layer * FF * DM, FF, DM, (bf16*)(ws + ws_wd(f)), 0, nullptr, scr, r, lane); }
    else if (id == 8) p0_transpose_item(A.in[10], DM, ABIN, (bf16*)(ws + WS_WABIN), 0, A.in[5], scr, r, lane);
    else if (id == 9) p0_transpose_item(A.in[14], DM, DM, (bf16*)(ws + WS_WABOUT), 0, nullptr, scr, r, lane);
    else if (id == 10) p0_transpose_item(A.in[15], DM, CIN, (bf16*)(ws + WS_WCIN), 0, A.in[5] + DM, scr, r, lane);
    else p0_transpose_item(A.in[16], DM, DM, (bf16*)(ws + WS_WCOUT), 0, nullptr, scr, r, lane);
}
__device__ __forceinline__ void conv_set(const Args& A, LAS unsigned char* lds, int wave, int lane, int gw, int NGW, int id0, int id1, int id2) {
    LAS unsigned char* scr = lds + wave * 16384;
    const int n0 = mat_items(id0), n1 = mat_items(id1), n2 = mat_items(id2);
    for (int it = gw; it < n0 + n1 + n2; it += NGW) {
        if (it < n0) conv_item(A, scr, lane, id0, it); else if (it < n0 + n1) conv_item(A, scr, lane, id1, it - n0); else conv_item(A, scr, lane, id2, it - n0 - n1); }
}
__device__ __forceinline__ void conv_idle(const Args& A, LAS unsigned char* lds, int id0, int id1, int id2) {
    if (blockIdx.x >= 128) { const int tid_ = threadIdx.x; conv_set(A, lds, __builtin_amdgcn_readfirstlane(tid_ >> 6), tid_ & 63, ((int)blockIdx.x - 128) * NWAVES + (tid_ >> 6), ((int)gridDim.x - 128) * NWAVES, id0, id1, id2); }
}
__device__ __forceinline__ void phase_prologue(const Args& A, LAS unsigned char* lds, int wave, int lane) {
    const int gw = blockIdx.x * NWAVES + wave, NGW = gridDim.x * NWAVES;
    unsigned char* ws = A.ws;
    conv_set(A, lds, wave, lane, gw, NGW, 0, 4, 3);
    { const float* wsp = A.in[12]; bf16* o = (bf16*)(ws + WS_WSB);
      for (int i = blockIdx.x * NTHR + threadIdx.x; i < 4 * 128 * 128; i += gridDim.x * NTHR) { const int p = (i >> 7) & 127, q = i & 127; o[i] = (bf16)f2bf(q <= p ? wsp[i] : 0.f); } }
    const float* x = A.in[0]; bf16* xb = (bf16*)(ws + WS_XB); float* part = (float*)(ws + WS_PART);
    for (int m = gw; m < M; m += NGW) {
        const f32x4* xr = (const f32x4*)(x + (size_t)m * DM) + lane; f32x4 v[4]; float s = 0.f;
#pragma unroll
        for (int j = 0; j < 4; ++j) { v[j] = xr[64 * j]; s += (v[j][0] * v[j][0] + v[j][1] * v[j][1]) + (v[j][2] * v[j][2] + v[j][3] * v[j][3]); }
        s = wave_sum(s);
        v2u* o8 = (v2u*)(xb + (size_t)m * DM) + lane;
#pragma unroll
        for (int j = 0; j < 4; ++j) { v2u w; w.x = pk2(v[j][0], v[j][1]); w.y = pk2(v[j][2], v[j][3]); o8[64 * j] = w; }
        if (lane < 16) part[(size_t)m * 16 + lane] = (lane == 0) ? s : 0.f;
    }
}

constexpr int GV_STRIDE = 272;
__device__ __forceinline__ void gate_unit(const Args& A, LAS unsigned char* lds, int unit, int wave, int lane) {
    const int g4 = unit & 3, n = (unit >> 2) & 63, b = unit >> 8;
    const size_t R0 = (size_t)b * SEQ + (size_t)n * 128;
    const bf16* Z = (const bf16*)(A.ws + WS_ACT); bf16* MIX = (bf16*)(A.ws + WS_MIX); const bf16* WsB = (const bf16*)(A.ws + WS_WSB) + (size_t)g4 * 128 * 128;
    const float* vnorm = A.in[11] + g4 * 128; const float* bsp = A.in[13] + g4 * 128;
    const int tid = threadIdx.x;
    { const int row = tid >> 2, qt = tid & 3; const bf16* vp = Z + (R0 + row) * ABIN + 2048 + 128 * g4 + 32 * qt;
      float v[32]; float ss = 0.f;
#pragma unroll
      for (int i = 0; i < 4; ++i) { const bf16x8 raw = *(const bf16x8*)(vp + 8 * i);
#pragma unroll
          for (int e = 0; e < 8; ++e) { const float gl = gelu_tanh(bf2f((unsigned short)raw[e])); v[8 * i + e] = gl; ss += gl * gl; } }
      ss += __shfl_xor(ss, 1); ss += __shfl_xor(ss, 2);
      const float rs = rsqrtf(ss * (1.0f / 128.0f) + 1e-6f);
#pragma unroll
      for (int i = 0; i < 4; ++i) { const f32x4 g0 = *(const f32x4*)(vnorm + 32 * qt + 8 * i), g1 = *(const f32x4*)(vnorm + 32 * qt + 8 * i + 4);
          v4u w; w.x = pk2(v[8 * i] * rs * g0[0], v[8 * i + 1] * rs * g0[1]); w.y = pk2(v[8 * i + 2] * rs * g0[2], v[8 * i + 3] * rs * g0[3]);
          w.z = pk2(v[8 * i + 4] * rs * g1[0], v[8 * i + 5] * rs * g1[1]); w.w = pk2(v[8 * i + 6] * rs * g1[2], v[8 * i + 7] * rs * g1[3]);
          *(LAS v4u*)(lds + row * GV_STRIDE + qt * 64 + i * 16) = w; } }
    __syncthreads();
    const int pl = lane & 15, g = lane >> 4, qq = pl >> 2, pp = pl & 3;
    f32x4 acc[8];
#pragma unroll
    for (int cb = 0; cb < 8; ++cb) acc[cb] = (f32x4){0.f, 0.f, 0.f, 0.f};
    const int nks = (16 * wave + 15) / 32 + 1;
    for (int ks = 0; ks < nks; ++ks) {
        const bf16x8 bfrag = *(const bf16x8*)(WsB + (size_t)(16 * wave + pl) * 128 + 32 * ks + 8 * g);
        LAS unsigned char* base = lds + (32 * ks + 8 * g + qq) * GV_STRIDE + pp * 8;
#pragma unroll
        for (int cb = 0; cb < 8; ++cb) {
            const s16x4 lo = __builtin_bit_cast(s16x4, __builtin_amdgcn_ds_read_tr16_b64_v4i16((LAS s16x4*)(base + cb * 32)));
            const s16x4 hi = __builtin_bit_cast(s16x4, __builtin_amdgcn_ds_read_tr16_b64_v4i16((LAS s16x4*)(base + cb * 32 + 4 * GV_STRIDE)));
            const bf16x8 afrag = (bf16x8){lo[0], lo[1], lo[2], lo[3], hi[0], hi[1], hi[2], hi[3]};
            acc[cb] = __builtin_amdgcn_mfma_f32_16x16x32_bf16(afrag, bfrag, acc[cb], 0, 0, 0);
        }
    }
    { const int p = 16 * wave + pl; const float bias = bsp[p];
      const bf16* up = Z + (R0 + p) * ABIN + 1536 + 128 * g4 + 4 * g; bf16* op = MIX + (R0 + p) * DM + 512 + 128 * g4 + 4 * g;
#pragma unroll
      for (int cb = 0; cb < 8; ++cb) { const s16x4 ur = *(const s16x4*)(up + 16 * cb);
          v2u w; w.x = pk2(gelu_tanh(bf2f((unsigned short)ur[0])) * (acc[cb][0] + bias), gelu_tanh(bf2f((unsigned short)ur[1])) * (acc[cb][1] + bias));
          w.y = pk2(gelu_tanh(bf2f((unsigned short)ur[2])) * (acc[cb][2] + bias), gelu_tanh(bf2f((unsigned short)ur[3])) * (acc[cb][3] + bias));
          *(v2u*)(op + 16 * cb) = w; } }
    __syncthreads();
}

constexpr int DV_STRIDE = 160, DV_BUF = 32 * DV_STRIDE;
__device__ __forceinline__ void dil_unit(const Args& A, LAS unsigned char* vl, int unit, int lane) {
    const int r16 = unit & 15, sp = (unit >> 4) & 31, h = (unit >> 9) & 7, b = unit >> 12;
    const bf16* Z = (const bf16*)(A.ws + WS_ACT); bf16* MIX = (bf16*)(A.ws + WS_MIX);
    const int qi = lane & 15, g = lane >> 4, T0 = sp * 256;
    const size_t rowb = (size_t)b * SEQ;
    const int tq = T0 + r16 + 16 * qi;
    const bf16* qp = Z + (rowb + tq) * ABIN + h * 64 + 8 * g;
    const bf16x8 qf0 = *(const bf16x8*)qp, qf1 = *(const bf16x8*)(qp + 32);
    const bf16* Kb = Z + rowb * ABIN + 512 + h * 64 + 8 * g;
    const bf16* Vb = Z + rowb * ABIN + 1024 + h * 64 + 8 * (lane & 7);
    float mrun = -INFINITY, lrun = 0.f; f32x4 o[4];
#pragma unroll
    for (int d = 0; d < 4; ++d) o[d] = (f32x4){0.f, 0.f, 0.f, 0.f};
    const int tb = T0 + r16;
    constexpr int DIL_D = 3;
    bf16x8 kn[DIL_D][4], vn[DIL_D][4];
#define DIL_PARAMS(it, dsh, j) const int dsh = ((it) < 12) ? 0 : ((it) < 18) ? 2 : 4; const int j = (it) - (((it) < 12) ? 0 : ((it) < 18) ? 12 : 18);
#define DIL_LOAD(it, S) do { DIL_PARAMS(it, dsh_, j_) const int c_ = tb & ((1 << dsh_) - 1), skb_ = (tb >> dsh_) - 128 + 32 * j_; \
        _Pragma("unroll") for (int s_ = 0; s_ < 2; ++s_) { int t_ = c_ + ((skb_ + 16 * s_ + qi) << dsh_); t_ = t_ < 0 ? 0 : (t_ > SEQ - 1 ? SEQ - 1 : t_); \
            kn[S][2 * s_] = *(const bf16x8*)(Kb + (size_t)t_ * ABIN); kn[S][2 * s_ + 1] = *(const bf16x8*)(Kb + (size_t)t_ * ABIN + 32); } \
        _Pragma("unroll") for (int i_ = 0; i_ < 4; ++i_) { int t_ = c_ + ((skb_ + (lane >> 3) + 8 * i_) << dsh_); t_ = t_ < 0 ? 0 : (t_ > SEQ - 1 ? SEQ - 1 : t_); \
            vn[S][i_] = *(const bf16x8*)(Vb + (size_t)t_ * ABIN); } } while (0)
#pragma unroll
    for (int p = 0; p < DIL_D; ++p) DIL_LOAD(p, p);
#pragma nounroll
    for (int it0 = 0; it0 < 24; it0 += DIL_D) {
#pragma unroll
      for (int S = 0; S < DIL_D; ++S) { const int it = it0 + S; if (it < 23) {
        LAS unsigned char* buf = vl + (it & 1) * DV_BUF;
        const bf16x8 k0 = kn[S][0], k1 = kn[S][1], k2 = kn[S][2], k3 = kn[S][3];
#pragma unroll
        for (int i = 0; i < 4; ++i) *(LAS bf16x8*)(buf + ((lane >> 3) + 8 * i) * DV_STRIDE + (lane & 7) * 16) = vn[S][i];
        if (it + DIL_D < 23) DIL_LOAD(it + DIL_D, S);
        DIL_PARAMS(it, dsh, j)
        const int skb = (tb >> dsh) - 128 + 32 * j, sq = (tb >> dsh) + ((16 >> dsh) * qi);
        f32x4 sa = (f32x4){0.f, 0.f, 0.f, 0.f}, sb = (f32x4){0.f, 0.f, 0.f, 0.f};
        sa = __builtin_amdgcn_mfma_f32_16x16x32_bf16(k0, qf0, sa, 0, 0, 0); sa = __builtin_amdgcn_mfma_f32_16x16x32_bf16(k1, qf1, sa, 0, 0, 0);
        sb = __builtin_amdgcn_mfma_f32_16x16x32_bf16(k2, qf0, sb, 0, 0, 0); sb = __builtin_amdgcn_mfma_f32_16x16x32_bf16(k3, qf1, sb, 0, 0, 0);
        float mx = -INFINITY;
#pragma unroll
        for (int e = 0; e < 4; ++e) { const int ska = skb + 4 * g + e, skq = ska + 16;
            const bool va = (ska >= 0) && (ska <= sq) && (sq - ska <= 128), vb = (skq >= 0) && (skq <= sq) && (sq - skq <= 128);
            sa[e] = va ? sa[e] : -INFINITY; sb[e] = vb ? sb[e] : -INFINITY; mx = fmaxf(mx, fmaxf(sa[e], sb[e])); }
        mx = fmaxf(mx, __shfl_xor(mx, 16)); mx = fmaxf(mx, __shfl_xor(mx, 32));
        const float mnew = fmaxf(mrun, mx), muse = (mnew == -INFINITY) ? 0.f : mnew;
        const float alpha = __builtin_amdgcn_exp2f(mrun - muse);
        float ps = 0.f; float pa[4], pb[4];
#pragma unroll
        for (int e = 0; e < 4; ++e) { pa[e] = __builtin_amdgcn_exp2f(sa[e] - muse); pb[e] = __builtin_amdgcn_exp2f(sb[e] - muse); ps += pa[e] + pb[e]; }
        lrun = lrun * alpha + ps; mrun = mnew;
        v4u pw; pw.x = pk2(pa[0], pa[1]); pw.y = pk2(pa[2], pa[3]); pw.z = pk2(pb[0], pb[1]); pw.w = pk2(pb[2], pb[3]);
        const bf16x8 pf = __builtin_bit_cast(bf16x8, pw);
        asm volatile("s_waitcnt lgkmcnt(0)" ::: "memory");
        LAS unsigned char* rb = buf + (4 * g + (qi >> 2)) * DV_STRIDE + (qi & 3) * 8;
#pragma unroll
        for (int db = 0; db < 4; ++db) {
            const s16x4 lo = __builtin_bit_cast(s16x4, __builtin_amdgcn_ds_read_tr16_b64_v4i16((LAS s16x4*)(rb + db * 32)));
            const s16x4 hi = __builtin_bit_cast(s16x4, __builtin_amdgcn_ds_read_tr16_b64_v4i16((LAS s16x4*)(rb + db * 32 + 16 * DV_STRIDE)));
            const bf16x8 vf = (bf16x8){lo[0], lo[1], lo[2], lo[3], hi[0], hi[1], hi[2], hi[3]};
            o[db] = o[db] * alpha;
            o[db] = __builtin_amdgcn_mfma_f32_16x16x32_bf16(vf, pf, o[db], 0, 0, 0);
        }
    } } }
#undef DIL_LOAD
#undef DIL_PARAMS
    lrun += __shfl_xor(lrun, 16); lrun += __shfl_xor(lrun, 32);
    const float inv = 1.0f / lrun;
    bf16* op = MIX + (rowb + tq) * DM + h * 64 + 4 * g;
#pragma unroll
    for (int db = 0; db < 4; ++db) { v2u w; w.x = pk2(o[db][0] * inv, o[db][1] * inv); w.y = pk2(o[db][2] * inv, o[db][3] * inv); *(v2u*)(op + 16 * db) = w; }
}

constexpr int DS_OFF = 16 * DV_BUF, DS_STRIDE = 144;
__device__ __forceinline__ void dil_wg_unit(const Args& A, LAS unsigned char* lds, int unit, int wave, int lane) {
    const int sp = unit & 31, h = (unit >> 5) & 7, b = unit >> 8;
    const bf16* Z = (const bf16*)(A.ws + WS_ACT); bf16* MIX = (bf16*)(A.ws + WS_MIX);
    const int qi = lane & 15, g = lane >> 4, T0 = sp * 256;
    const size_t rowb = (size_t)b * SEQ;
    const bf16* Kb = Z + rowb * ABIN + 512 + h * 64 + 8 * g;
    const bf16* Vb = Z + rowb * ABIN + 1024 + h * 64 + 8 * (lane & 7);
    LAS unsigned char* ST = lds + DS_OFF;
#pragma unroll 1
    for (int stage = 0; stage < 3; ++stage) {
        const int dsh = 4 - 2 * stage;
        int tbg[2]; bf16x8 qf[2][2]; float mrun[2], lrun[2]; f32x4 o[2][4];
#pragma unroll
        for (int k = 0; k < 2; ++k) { const int G = 2 * wave + k; tbg[k] = T0 + (stage == 0 ? G : stage == 1 ? 64 * (G >> 2) + (G & 3) : 16 * G);
            const bf16* qp = Z + (rowb + tbg[k] + (qi << dsh)) * ABIN + h * 64 + 8 * g; qf[k][0] = *(const bf16x8*)qp; qf[k][1] = *(const bf16x8*)(qp + 32); }
        bf16x8 kn[2][4], vn[2][4];
#define DW_LOAD(jt_) do { _Pragma("unroll") for (int k_ = 0; k_ < 2; ++k_) { const int c_ = tbg[k_] & ((1 << dsh) - 1), skb_ = (tbg[k_] >> dsh) - 128 + 32 * (jt_); \
        _Pragma("unroll") for (int i_ = 0; i_ < 4; ++i_) { int t_ = c_ + ((skb_ + (lane >> 3) + 8 * i_) << dsh); t_ = t_ < 0 ? 0 : (t_ > SEQ - 1 ? SEQ - 1 : t_); \
            kn[k_][i_] = *(const bf16x8*)(Vb + (size_t)t_ * ABIN - 512); vn[k_][i_] = *(const bf16x8*)(Vb + (size_t)t_ * ABIN); } } } while (0)
        DW_LOAD(0);
#pragma unroll
        for (int k = 0; k < 2; ++k) { LAS unsigned char* sq_p = ST + (tbg[k] + (qi << dsh) - T0) * DS_STRIDE;
            if (stage == 0) { mrun[k] = -INFINITY; lrun[k] = 0.f;
#pragma unroll
                for (int d = 0; d < 4; ++d) o[k][d] = (f32x4){0.f, 0.f, 0.f, 0.f}; }
            else { mrun[k] = *(LAS float*)(sq_p + 128); lrun[k] = (g == 0) ? *(LAS float*)(sq_p + 132) : 0.f;
#pragma unroll
                for (int d = 0; d < 4; ++d) { const s16x4 r = *(LAS s16x4*)(sq_p + (16 * d + 4 * g) * 2); o[k][d] = (f32x4){bf2f((unsigned short)r[0]), bf2f((unsigned short)r[1]), bf2f((unsigned short)r[2]), bf2f((unsigned short)r[3])}; } } }
#pragma nounroll
        for (int jt = 0; jt < 5; ++jt) {
            bf16x8 kc[2][4], vc[2][4];
#pragma unroll
            for (int k = 0; k < 2; ++k) { LAS unsigned char* vbuf = lds + (wave * 2 + k) * DV_BUF;
#pragma unroll
                for (int i = 0; i < 4; ++i) { vc[k][i] = vn[k][i]; *(LAS bf16x8*)(vbuf + ((lane >> 3) + 8 * i) * DV_STRIDE + (lane & 7) * 16) = kn[k][i]; } }
            if (jt + 1 < 5) DW_LOAD(jt + 1);
            asm volatile("s_waitcnt lgkmcnt(0)" ::: "memory");
#pragma unroll
            for (int k = 0; k < 2; ++k) { LAS unsigned char* kb_ = lds + (wave * 2 + k) * DV_BUF + qi * DV_STRIDE + 16 * g;
                kc[k][0] = *(LAS bf16x8*)(kb_); kc[k][1] = *(LAS bf16x8*)(kb_ + 64); kc[k][2] = *(LAS bf16x8*)(kb_ + 16 * DV_STRIDE); kc[k][3] = *(LAS bf16x8*)(kb_ + 16 * DV_STRIDE + 64); }
            asm volatile("s_waitcnt lgkmcnt(0)" ::: "memory");
#pragma unroll
            for (int k = 0; k < 2; ++k) { LAS unsigned char* vbuf = lds + (wave * 2 + k) * DV_BUF;
#pragma unroll
                for (int i = 0; i < 4; ++i) *(LAS bf16x8*)(vbuf + ((lane >> 3) + 8 * i) * DV_STRIDE + (lane & 7) * 16) = vc[k][i]; }
            f32x4 sa[2], sb[2]; float alpha[2]; bf16x8 pf[2];
#pragma unroll
            for (int k = 0; k < 2; ++k) {
                sa[k] = (f32x4){0.f, 0.f, 0.f, 0.f}; sb[k] = sa[k];
                sa[k] = __builtin_amdgcn_mfma_f32_16x16x32_bf16(kc[k][0], qf[k][0], sa[k], 0, 0, 0); sa[k] = __builtin_amdgcn_mfma_f32_16x16x32_bf16(kc[k][1], qf[k][1], sa[k], 0, 0, 0);
                sb[k] = __builtin_amdgcn_mfma_f32_16x16x32_bf16(kc[k][2], qf[k][0], sb[k], 0, 0, 0); sb[k] = __builtin_amdgcn_mfma_f32_16x16x32_bf16(kc[k][3], qf[k][1], sb[k], 0, 0, 0); }
#pragma unroll
            for (int k = 0; k < 2; ++k) {
                const int skb = (tbg[k] >> dsh) - 128 + 32 * jt, sq = (tbg[k] >> dsh) + qi;
                float mx = -INFINITY;
#pragma unroll
                for (int e = 0; e < 4; ++e) { const int ska = skb + 4 * g + e, skq = ska + 16;
                    const bool va = (ska >= 0) && (ska <= sq) && (sq - ska <= 128), vb = (skq >= 0) && (skq <= sq) && (sq - skq <= 128);
                    sa[k][e] = va ? sa[k][e] : -INFINITY; sb[k][e] = vb ? sb[k][e] : -INFINITY; mx = fmaxf(mx, fmaxf(sa[k][e], sb[k][e])); }
                mx = fmaxf(mx, __shfl_xor(mx, 16)); mx = fmaxf(mx, __shfl_xor(mx, 32));
                const float mnew = fmaxf(mrun[k], mx), muse = (mnew == -INFINITY) ? 0.f : mnew;
                alpha[k] = __builtin_amdgcn_exp2f(mrun[k] - muse);
                float ps = 0.f; float pa[4], pb[4];
#pragma unroll
                for (int e = 0; e < 4; ++e) { pa[e] = __builtin_amdgcn_exp2f(sa[k][e] - muse); pb[e] = __builtin_amdgcn_exp2f(sb[k][e] - muse); ps += pa[e] + pb[e]; }
                lrun[k] = lrun[k] * alpha[k] + ps; mrun[k] = mnew;
                v4u pw; pw.x = pk2(pa[0], pa[1]); pw.y = pk2(pa[2], pa[3]); pw.z = pk2(pb[0], pb[1]); pw.w = pk2(pb[2], pb[3]);
                pf[k] = __builtin_bit_cast(bf16x8, pw); }
            asm volatile("s_waitcnt lgkmcnt(0)" ::: "memory");
#pragma unroll
            for (int k = 0; k < 2; ++k) { LAS unsigned char* rb = lds + (wave * 2 + k) * DV_BUF + (4 * g + (qi >> 2)) * DV_STRIDE + (qi & 3) * 8;
#pragma unroll
                for (int db = 0; db < 4; ++db) {
                    const s16x4 lo = __builtin_bit_cast(s16x4, __builtin_amdgcn_ds_read_tr16_b64_v4i16((LAS s16x4*)(rb + db * 32)));
                    const s16x4 hi = __builtin_bit_cast(s16x4, __builtin_amdgcn_ds_read_tr16_b64_v4i16((LAS s16x4*)(rb + db * 32 + 16 * DV_STRIDE)));
                    const bf16x8 vf = (bf16x8){lo[0], lo[1], lo[2], lo[3], hi[0], hi[1], hi[2], hi[3]};
                    o[k][db] = o[k][db] * alpha[k];
                    o[k][db] = __builtin_amdgcn_mfma_f32_16x16x32_bf16(vf, pf[k], o[k][db], 0, 0, 0);
                } }
            asm volatile("s_waitcnt lgkmcnt(0)" ::: "memory");
        }
#undef DW_LOAD
#pragma unroll
        for (int k = 0; k < 2; ++k) { const int qpos = tbg[k] + (qi << dsh) - T0; LAS unsigned char* sq_p = ST + qpos * DS_STRIDE;
            float lt = lrun[k]; lt += __shfl_xor(lt, 16); lt += __shfl_xor(lt, 32);
            if (stage < 2) {
#pragma unroll
                for (int d = 0; d < 4; ++d) { v2u w; w.x = pk2(o[k][d][0], o[k][d][1]); w.y = pk2(o[k][d][2], o[k][d][3]); *(LAS v2u*)(sq_p + (16 * d + 4 * g) * 2) = w; }
                if (g == 0) { *(LAS float*)(sq_p + 128) = mrun[k]; *(LAS float*)(sq_p + 132) = lt; }
            } else {
                const float inv = 1.0f / lt;
                bf16* op = MIX + (rowb + T0 + qpos) * DM + h * 64 + 4 * g;
#pragma unroll
                for (int db = 0; db < 4; ++db) { v2u w; w.x = pk2(o[k][db][0] * inv, o[k][db][1] * inv); w.y = pk2(o[k][db][2] * inv, o[k][db][3] * inv); *(v2u*)(op + 16 * db) = w; }
            } }
        __syncthreads();
    }
}
__device__ __forceinline__ void select_phase(const Args& A, LAS unsigned char* lds, int wave, int lane) {
    LAS unsigned* lcnt = (LAS unsigned*)lds; LAS unsigned* lbase = lcnt + 32;
    const int tid = threadIdx.x;
    for (int k = 0; k < 2; ++k) {
        const int U = blockIdx.x + 256 * k, bh = (U >> 4) & 31, c16 = k ? 15 - (U & 15) : (U & 15), b = bh >> 4, h = bh & 15;
        const int ch = c16 * 8 + wave, t = ch * 64 + lane, own = ch >> 2;
        if (tid < 32) lcnt[tid] = 0u;
        __syncthreads();
        unsigned mask = 0u; int i1 = -1, i2 = -1, i3 = -1;
        if (own > 0) {
            LAS unsigned char* qs = lds + 1024 + wave * 9216;
            { const bf16* qg = (const bf16*)(A.ws + WS_ACT) + ((size_t)b * SEQ + ch * 64 + (lane >> 3)) * DM + h * 64 + 8 * (lane & 7);
              bf16x8 rawl[8];
#pragma unroll
              for (int p = 0; p < 8; ++p) rawl[p] = *(const bf16x8*)(qg + (size_t)8 * p * DM);
#pragma unroll
              for (int p = 0; p < 8; ++p) *(LAS bf16x8*)(qs + (8 * p + (lane >> 3)) * 144 + 16 * (lane & 7)) = rawl[p];
              asm volatile("s_waitcnt lgkmcnt(0)" ::: "memory"); }
            float q[64];
#pragma unroll
            for (int i = 0; i < 8; ++i) { const bf16x8 raw = *(LAS bf16x8*)(qs + lane * 144 + 16 * i);
#pragma unroll
                for (int e = 0; e < 8; ++e) q[8 * i + e] = bf2f((unsigned short)raw[e]); }
            const float* km = (const float*)(A.ws + WS_KM) + (size_t)(b * 32) * 2048 + h * 64 + lane;
            float v1 = -INFINITY, v2 = -INFINITY, v3 = -INFINITY;
            for (int j0 = 0; j0 < own; j0 += 4) {
                float kmv[4];
#pragma unroll
                for (int u = 0; u < 4; ++u) { const int jj = (j0 + u < own) ? j0 + u : own - 1; kmv[u] = km[(size_t)jj * 2048] + km[(size_t)jj * 2048 + 1024]; }
#pragma unroll
                for (int u = 0; u < 4; ++u) { const int j = j0 + u;
                    float s = 0.f;
#pragma unroll
                    for (int d = 0; d < 64; ++d) s += q[d] * __builtin_bit_cast(float, __builtin_amdgcn_readlane(__builtin_bit_cast(int, kmv[u]), d));
                    if (j < own) {
                        if (s > v1) { v3 = v2; i3 = i2; v2 = v1; i2 = i1; v1 = s; i1 = j; }
                        else if (s > v2) { v3 = v2; i3 = i2; v2 = s; i2 = j; }
                        else if (s > v3) { v3 = s; i3 = j; } } }
            }
            if (i1 >= 0) mask |= 1u << i1; if (i2 >= 0) mask |= 1u << i2; if (i3 >= 0) mask |= 1u << i3;
        }
        unsigned p1 = 0, p2 = 0, p3 = 0;
        if (i1 >= 0) p1 = atomicAdd((unsigned*)(lcnt + i1), 1u);
        if (i2 >= 0) p2 = atomicAdd((unsigned*)(lcnt + i2), 1u);
        if (i3 >= 0) p3 = atomicAdd((unsigned*)(lcnt + i3), 1u);
        __syncthreads();
        if (tid < 32) { const unsigned n = lcnt[tid]; lbase[tid] = n ? atomicAdd((unsigned*)(A.ws + WS_CNT) + bh * 32 + tid, n) : 0u; }
        __syncthreads();
        unsigned short* list = (unsigned short*)(A.ws + WS_LIST) + (size_t)bh * 126976;
        if (i1 >= 0) list[256 * (31 * i1 - (i1 * (i1 - 1)) / 2) + lbase[i1] + p1] = (unsigned short)(t | (__popc(mask & ((1u << i1) - 1u)) << 13));
        if (i2 >= 0) list[256 * (31 * i2 - (i2 * (i2 - 1)) / 2) + lbase[i2] + p2] = (unsigned short)(t | (__popc(mask & ((1u << i2) - 1u)) << 13));
        if (i3 >= 0) list[256 * (31 * i3 - (i3 * (i3 - 1)) / 2) + lbase[i3] + p3] = (unsigned short)(t | (__popc(mask & ((1u << i3) - 1u)) << 13));
        ((unsigned*)(A.ws + WS_SEL))[(size_t)bh * SEQ + t] = mask;
        __syncthreads();
    }
}
constexpr int MB_VIRT = 0;
constexpr int MK_STRIDE = 144, MV_STRIDE = 160, MK_OFF = 0, MV_OFF = 256 * MK_STRIDE, MB_CTL = 81920;
__device__ __forceinline__ void moba_stage_load(const Args& A, int bh, int j, bf16x8 (&kk)[4], bf16x8 (&vv)[4]) {
    const int b = bh >> 4, h = bh & 15, row = threadIdx.x >> 3, ch = threadIdx.x & 7;
    const bf16* kp = (const bf16*)(A.ws + WS_ACT) + (size_t)M * DM + ((size_t)b * SEQ + 256 * j + row) * DM + h * 64 + 8 * ch;
    const bf16* vp = kp + (size_t)M * DM;
#pragma unroll
    for (int i = 0; i < 4; ++i) { kk[i] = *(const bf16x8*)(kp + (size_t)64 * i * DM); vv[i] = *(const bf16x8*)(vp + (size_t)64 * i * DM); }
}
__device__ __forceinline__ void moba_stage_store(LAS unsigned char* lds, const bf16x8 (&kk)[4], const bf16x8 (&vv)[4]) {
    const int row = threadIdx.x >> 3, ch = threadIdx.x & 7;
#pragma unroll
    for (int i = 0; i < 4; ++i) { *(LAS bf16x8*)(lds + MK_OFF + (64 * i + row) * MK_STRIDE + 16 * ch) = kk[i]; *(LAS bf16x8*)(lds + MV_OFF + (64 * i + row) * MV_STRIDE + 16 * ch) = vv[i]; }
}
__device__ __forceinline__ void moba_stage(const Args& A, LAS unsigned char* lds, int bh, int j) {
    bf16x8 kk[4], vv[4]; moba_stage_load(A, bh, j, kk, vv); moba_stage_store(lds, kk, vv);
}
__device__ __forceinline__ void moba_block(LAS unsigned char* lds, int ntile, const bf16x8 qf0, const bf16x8 qf1, int qpos, int lane, float& m_out, float& l_out, f32x4 (&o)[4]) {
    const int qi = lane & 15, g = lane >> 4;
    LAS unsigned char* kb = lds + MK_OFF + qi * MK_STRIDE + 16 * g;
    f32x4 sa[8], sb[8];
    float mx = -INFINITY;
#pragma unroll
    for (int t = 0; t < 8; ++t) {
        sa[t] = (f32x4){-INFINITY, -INFINITY, -INFINITY, -INFINITY}; sb[t] = sa[t];
        if (t < ntile) {
            LAS unsigned char* kt = kb + t * 32 * MK_STRIDE;
            const bf16x8 k0 = *(LAS bf16x8*)(kt), k1 = *(LAS bf16x8*)(kt + 64), k2 = *(LAS bf16x8*)(kt + 16 * MK_STRIDE), k3 = *(LAS bf16x8*)(kt + 16 * MK_STRIDE + 64);
            f32x4 a = (f32x4){0.f, 0.f, 0.f, 0.f}, bq = (f32x4){0.f, 0.f, 0.f, 0.f};
            a = __builtin_amdgcn_mfma_f32_16x16x32_bf16(k0, qf0, a, 0, 0, 0); a = __builtin_amdgcn_mfma_f32_16x16x32_bf16(k1, qf1, a, 0, 0, 0);
            bq = __builtin_amdgcn_mfma_f32_16x16x32_bf16(k2, qf0, bq, 0, 0, 0); bq = __builtin_amdgcn_mfma_f32_16x16x32_bf16(k3, qf1, bq, 0, 0, 0);
#pragma unroll
            for (int e = 0; e < 4; ++e) { const int ka = 32 * t + 4 * g + e;
                a[e] = (ka <= qpos) ? a[e] : -INFINITY; bq[e] = (ka + 16 <= qpos) ? bq[e] : -INFINITY; mx = fmaxf(mx, fmaxf(a[e], bq[e])); }
            sa[t] = a; sb[t] = bq;
        }
    }
    mx = fmaxf(mx, __shfl_xor(mx, 16)); mx = fmaxf(mx, __shfl_xor(mx, 32));
    float ps = 0.f;
    LAS unsigned char* rb = lds + MV_OFF + (4 * g + (qi >> 2)) * MV_STRIDE + (qi & 3) * 8;
#pragma unroll
    for (int t = 0; t < 8; ++t) {
        if (t < ntile) {
            float pa[4], pb[4];
#pragma unroll
            for (int e = 0; e < 4; ++e) { pa[e] = __builtin_amdgcn_exp2f(sa[t][e] - mx); pb[e] = __builtin_amdgcn_exp2f(sb[t][e] - mx); ps += pa[e] + pb[e]; }
            v4u pw; pw.x = pk2(pa[0], pa[1]); pw.y = pk2(pa[2], pa[3]); pw.z = pk2(pb[0], pb[1]); pw.w = pk2(pb[2], pb[3]);
            const bf16x8 pf = __builtin_bit_cast(bf16x8, pw);
            LAS unsigned char* rt = rb + t * 32 * MV_STRIDE;
#pragma unroll
            for (int db = 0; db < 4; ++db) {
                const s16x4 lo = __builtin_bit_cast(s16x4, __builtin_amdgcn_ds_read_tr16_b64_v4i16((LAS s16x4*)(rt + db * 32)));
                const s16x4 hi = __builtin_bit_cast(s16x4, __builtin_amdgcn_ds_read_tr16_b64_v4i16((LAS s16x4*)(rt + db * 32 + 16 * MV_STRIDE)));
                const bf16x8 vf = (bf16x8){lo[0], lo[1], lo[2], lo[3], hi[0], hi[1], hi[2], hi[3]};
                o[db] = __builtin_amdgcn_mfma_f32_16x16x32_bf16(vf, pf, o[db], 0, 0, 0);
            }
        }
    }
    m_out = mx; l_out = ps;
}
__device__ __forceinline__ bf16* moba_po(const Args& A, int slot) { return slot == 0 ? (bf16*)(A.ws + WS_MIX) : slot == 1 ? (bf16*)A.out : (bf16*)(A.ws + WS_PO2); }
__device__ __forceinline__ void moba_past_phase(const Args& A, LAS unsigned char* lds, int wave, int lane) {
    LAS unsigned* cntl = (LAS unsigned*)(lds + MB_CTL);
    LAS unsigned* pre = cntl + 1024;
    LAS unsigned* tot = pre + 1025;
    const unsigned* cnt = (const unsigned*)(A.ws + WS_CNT);
    const int tid = threadIdx.x;
    for (int i = tid; i < 1024; i += NTHR) cntl[i] = cnt[i];
    __syncthreads();
    if (tid < 32) { unsigned run = 0; for (int j = 0; j < 32; ++j) { pre[tid * 32 + j] = run; const unsigned n = cntl[tid * 32 + j]; run += n ? ((n + 127u) >> 7) + MB_VIRT : 0u; } tot[tid] = run; }
    __syncthreads();
    if (tid == 0) { unsigned run = 0; for (int b = 0; b < 32; ++b) { const unsigned t = tot[b]; tot[b] = run; run += t; } tot[32] = run; pre[1024] = run; }
    __syncthreads();
    for (int i = tid; i < 1024; i += NTHR) pre[i] += tot[i >> 5];
    __syncthreads();
    const unsigned T = tot[32];
    const unsigned i0 = (unsigned)(((unsigned long long)T * blockIdx.x) / gridDim.x), i1 = (unsigned)(((unsigned long long)T * (blockIdx.x + 1)) / gridDim.x);
    const int qi = lane & 15, g = lane >> 4;
    LAS unsigned short* ents = (LAS unsigned short*)(lds + 98304);
    LAS unsigned short* item_e = (LAS unsigned short*)(lds + 98304 + 24576);
    const int n = (int)(i1 - i0) < 96 ? (int)(i1 - i0) : 96;
    for (int x = tid; x < n * 128; x += NTHR) {
        const unsigned it = i0 + (unsigned)(x >> 7);
        int lo = 0, hi = 1024;
        while (lo < hi) { const int mid = (lo + hi) >> 1; if (pre[mid + 1] > it) hi = mid; else lo = mid + 1; }
        const int e = lo, c = (int)(it - pre[e]), li = c * 128 + (x & 127), j = e & 31;
        const unsigned short* list = (const unsigned short*)(A.ws + WS_LIST) + (size_t)(e >> 5) * 126976 + 256 * (31 * j - (j * (j - 1)) / 2);
        ents[x] = (li < (int)cntl[e]) ? list[li] : (unsigned short)0xFFFF;
        if ((x & 127) == 0) item_e[x >> 7] = (unsigned short)e;
    }
    __syncthreads();
    int cur_e = -1;
#define MB_QP(e_, tq_) ((const bf16*)(A.ws + WS_ACT) + ((size_t)((e_) >> 9) * SEQ + (tq_)) * DM + (((e_) >> 5) & 15) * 64 + 8 * g)
    if (n > 0) {
        int eA = (int)item_e[0]; unsigned entA = ents[wave * 16 + qi];
        bf16x8 qA0, qA1; { const int tq = (entA == 0xFFFFu) ? 0 : (int)(entA & 8191u); qA0 = *(const bf16x8*)MB_QP(eA, tq); qA1 = *(const bf16x8*)(MB_QP(eA, tq) + 32); }
        bf16x8 pkk[4], pvv[4]; bool have_pf = false; int pf_e = -1;
#pragma unroll
        for (int i = 0; i < 4; ++i) { pkk[i] = (bf16x8){0, 0, 0, 0, 0, 0, 0, 0}; pvv[i] = pkk[i]; }
        for (int ii = 0; ii < n; ++ii) {
            const int bh = eA >> 5, j = eA & 31;
            const int iin = (ii + 1 < n) ? ii + 1 : ii;
            const int eB = (int)item_e[iin]; const unsigned entB = ents[iin * 128 + wave * 16 + qi];
            if (eA != cur_e) { __syncthreads(); if (have_pf && pf_e == eA) moba_stage_store(lds, pkk, pvv); else moba_stage(A, lds, bh, j); __syncthreads(); cur_e = eA; have_pf = false; }
            const int tqB = (entB == 0xFFFFu) ? 0 : (int)(entB & 8191u);
            const bf16x8 qB0 = *(const bf16x8*)MB_QP(eB, tqB), qB1 = *(const bf16x8*)(MB_QP(eB, tqB) + 32);
            if (eB != eA) { moba_stage_load(A, eB >> 5, eB & 31, pkk, pvv); have_pf = true; pf_e = eB; }
            float mrun, lrun; f32x4 o[4];
#pragma unroll
            for (int d = 0; d < 4; ++d) o[d] = (f32x4){0.f, 0.f, 0.f, 0.f};
            moba_block(lds, 8, qA0, qA1, 1 << 30, lane, mrun, lrun, o);
            lrun += __shfl_xor(lrun, 16); lrun += __shfl_xor(lrun, 32);
            {
                const bool valA = entA != 0xFFFFu; const int tq = (int)(entA & 8191u), slot = (int)(entA >> 13); const size_t idx = (size_t)bh * SEQ + tq;
                const float inv = 1.0f / lrun;
                bf16* junk = (bf16*)(A.ws + 524288) + threadIdx.x * 64;
                bf16* op = valA ? moba_po(A, slot) + idx * 64 + 4 * g : junk;
#pragma unroll
                for (int db = 0; db < 4; ++db) { v2u w; w.x = pk2(o[db][0] * inv, o[db][1] * inv); w.y = pk2(o[db][2] * inv, o[db][3] * inv); *(v2u*)(op + 16 * db) = w; }
                float* lp = (valA && g == 0) ? (float*)(A.ws + WS_LSE) + (size_t)slot * (32 * SEQ) + idx : (float*)(junk + 32);
                *lp = mrun + __builtin_amdgcn_logf(lrun);
            }
            eA = eB; entA = entB; qA0 = qB0; qA1 = qB1;
        }
    }
#undef MB_QP
    __syncthreads();
}
__device__ __forceinline__ void moba_own_phase(const Args& A, LAS unsigned char* lds, int wave, int lane) {
    const int qi = lane & 15, g = lane >> 4;
    int cur_e = -1;
    for (int u = blockIdx.x * 8; u < blockIdx.x * 8 + 8; ++u) {
        const int hf = u & 1, e = u >> 1, bh = e >> 5, j = e & 31;
        if (e != cur_e) { __syncthreads(); moba_stage(A, lds, bh, j); __syncthreads(); cur_e = e; }
        const int qloc = 128 * hf + 16 * wave + qi, tq = 256 * j + qloc;
        const size_t qrow = (size_t)(bh >> 4) * SEQ + tq;
        bf16* qp = (bf16*)(A.ws + WS_ACT) + qrow * DM + (bh & 15) * 64;
        const bf16x8 qf0 = *(const bf16x8*)(qp + 8 * g), qf1 = *(const bf16x8*)(qp + 8 * g + 32);
        float mrun, lrun; f32x4 o[4];
#pragma unroll
        for (int d = 0; d < 4; ++d) o[d] = (f32x4){0.f, 0.f, 0.f, 0.f};
        const size_t idx = (size_t)bh * SEQ + tq;
        const unsigned selm = ((const unsigned*)(A.ws + WS_SEL))[idx];
        const float* lsep = (const float*)(A.ws + WS_LSE) + idx;
        float lsr[3]; s16x4 pr[3][4];
#pragma unroll
        for (int s = 0; s < 3; ++s) { lsr[s] = lsep[(size_t)s * (32 * SEQ)]; const bf16* pp = moba_po(A, s) + idx * 64 + 4 * g;
#pragma unroll
            for (int db = 0; db < 4; ++db) pr[s][db] = *(const s16x4*)(pp + 16 * db); }
        const int ntile = (128 * hf + 16 * wave + 15) / 32 + 1;
        moba_block(lds, ntile, qf0, qf1, qloc, lane, mrun, lrun, o);
        lrun += __shfl_xor(lrun, 16); lrun += __shfl_xor(lrun, 32);
        const int nsel = __popc(selm);
        float ls[3]; float mx = mrun;
#pragma unroll
        for (int s = 0; s < 3; ++s) { ls[s] = (s < nsel) ? lsr[s] : -INFINITY; mx = fmaxf(mx, ls[s]); }
        const float w0 = __builtin_amdgcn_exp2f(mrun - mx); float den = lrun * w0;
#pragma unroll
        for (int d = 0; d < 4; ++d) o[d] = o[d] * w0;
#pragma unroll
        for (int s = 0; s < 3; ++s) { const bool on = s < nsel; const float ws_ = on ? __builtin_amdgcn_exp2f(ls[s] - mx) : 0.f; den += ws_;
#pragma unroll
            for (int db = 0; db < 4; ++db) { const s16x4 r = pr[s][db];
                o[db][0] += on ? ws_ * bf2f((unsigned short)r[0]) : 0.f; o[db][1] += on ? ws_ * bf2f((unsigned short)r[1]) : 0.f;
                o[db][2] += on ? ws_ * bf2f((unsigned short)r[2]) : 0.f; o[db][3] += on ? ws_ * bf2f((unsigned short)r[3]) : 0.f; } }
        const float inv = 1.0f / den;
#pragma unroll
        for (int db = 0; db < 4; ++db) { v2u w; w.x = pk2(o[db][0] * inv, o[db][1] * inv); w.y = pk2(o[db][2] * inv, o[db][3] * inv); *(v2u*)(qp + 16 * db + 4 * g) = w; }
    }
    __syncthreads();
}
constexpr int N_PHASES = 17;
#ifndef MK_DENSE_MOBA
#define MK_DENSE_MOBA 0
#endif
#ifndef MK_FUSE_FINAL
#define MK_FUSE_FINAL 1
#endif
#ifndef MK_SINGLE
#define MK_SINGLE 1
#endif
__global__ void __launch_bounds__(NTHR, 2) fwd_megakernel(Args args) {
    extern __shared__ __attribute__((aligned(16))) unsigned char lds_raw[];
    __builtin_assume(__builtin_amdgcn_workitem_id_y() == 0); __builtin_assume(__builtin_amdgcn_workitem_id_z() == 0);
    cg::grid_group grid = cg::this_grid();
    LAS unsigned char* lds = (LAS unsigned char*)lds_raw;
    const int tid = threadIdx.x, lane = tid & 63, wave = __builtin_amdgcn_readfirstlane(tid >> 6);
    const int G = gridDim.x;
    unsigned char* ws = args.ws;
    const int lo = args.ph_lo, hi = args.ph_hi;
    bf16* XB = (bf16*)(ws + WS_XB); float* PART = (float*)(ws + WS_PART); bf16* ACT = (bf16*)(ws + WS_ACT); bf16* MIX = (bf16*)(ws + WS_MIX);
    float* X = args.out;
#define IN(k) (lo <= (k) && (k) < hi)
    volatile LAS unsigned* MISC = (volatile LAS unsigned*)(lds + MISC_OFF);
    if (tid < 32) MISC[tid] = 0u;
    unsigned* barw = (unsigned*)(ws + WS_BAR);
    XcdBarrier xbar; xbar.bar = barw; xbar.x = 0; xbar.st = MISC + 8;
    __syncthreads();
    xbar = xcd_barrier_post(barw, MISC + 8);
    if (lo > 1000) grid.sync();
#ifdef PROBE_REP
#define SEAM(k) do { if (IN(k) && IN((k) + 1)) { for (int s_ = 0; s_ < PROBE_SYNC; ++s_) grid.sync(); } } while (0)
#else
#ifdef MK_TS
#define STAMP(i) do { if (blockIdx.x == 0 && tid == 0) ((unsigned long long*)(ws + 262144))[i] = __builtin_amdgcn_s_memrealtime(); } while (0)
#define SEAM(k) do { if (IN(k) && IN((k) + 1)) xcd_barrier(xbar); STAMP((k) + 1); } while (0)
#else
#define STAMP(i) do { } while (0)
#define SEAM(k) do { if (IN(k) && IN((k) + 1)) xcd_barrier(xbar); } while (0)
#endif
#endif
#define GEMM_GU(f) do { pg8::Gemm g{XB, (const bf16*)(ws + ws_wgu(f)), M, 2 * FF, DM}; pg8::StaticOrder S; S.init(M, 2 * FF, G, (int)blockIdx.x); \
        rstd_table(PART, lds, S); pg8::EpiSwiGLU E{ACT, FF, (const LAS float*)(lds + RSTD_OFF)}; pg8::gemm_phase<pg8::EpiSwiGLU, pg8::StaticOrder, true, true>(lds, g, S, E); } while (0)
#define GEMM_DOWN(f, F32B, basep) do { pg8::Gemm g{ACT, (const bf16*)(ws + ws_wd(f)), M, DM, FF}; pg8::StaticOrder S; S.init(M, DM, G, (int)blockIdx.x); \
        pg8::EpiResid<F32B> E{(basep), XB, PART, 0.5f}; pg8::gemm_phase<pg8::EpiResid<F32B>, pg8::StaticOrder, true, true>(lds, g, S, E); } while (0)
#define GEMM_OUT(Ap, Wp) do { pg8::Gemm g{(Ap), (const bf16*)(ws + (Wp)), M, DM, DM}; pg8::StaticOrder S; S.init(M, DM, G, (int)blockIdx.x); \
        pg8::EpiResid<false> E{nullptr, XB, PART, 1.0f}; pg8::gemm_phase<pg8::EpiResid<false>, pg8::StaticOrder, true, true>(lds, g, S, E); } while (0)

#ifdef PROBE_REP
    for (int rep_ = 0; rep_ < PROBE_REP0; ++rep_) { phase_prologue(args, lds, wave, lane); __syncthreads(); }
#endif
    STAMP(0);
    if (IN(0)) { phase_prologue(args, lds, wave, lane); } SEAM(0);
    if (IN(1)) { GEMM_GU(0); conv_idle(args, lds, 8, 9, 5); } SEAM(1);
    if (IN(2)) { GEMM_DOWN(0, false, nullptr); } SEAM(2);
    if (IN(3)) { pg8::Gemm g{XB, (const bf16*)(ws + WS_WABIN), M, ABIN, DM}; pg8::StaticOrder S; S.init(M, ABIN, G, (int)blockIdx.x);
        rstd_table(PART, lds, S); pg8::EpiProj E{ACT, ABIN, (const LAS float*)(lds + RSTD_OFF), 0, 0, 512, C2, nullptr}; pg8::gemm_phase<pg8::EpiProj, pg8::StaticOrder, true, true>(lds, g, S, E); conv_idle(args, lds, 1, -1, -1); } SEAM(3);
#ifndef NO_MIX
#ifdef PROBE_REP
    for (int rep_ = 0; rep_ < PROBE_REP4; ++rep_)
#endif
    if (IN(4)) {
        for (int u = blockIdx.x; u < 512; u += G) gate_unit(args, lds, u, wave, lane);
        if (G == 256) { for (int r = 0; r < 2; ++r) dil_wg_unit(args, lds, (r << 8) | ((blockIdx.x & 7) << 5) | (blockIdx.x >> 3), wave, lane); }
        else { for (int u = blockIdx.x; u < 512; u += G) dil_wg_unit(args, lds, u, wave, lane); }
    }
#endif
    SEAM(4);
    if (IN(5)) { GEMM_OUT(MIX, WS_WABOUT); } SEAM(5);
    if (IN(6)) { GEMM_GU(1); conv_idle(args, lds, 2, -1, -1); } SEAM(6);
    if (IN(7)) { GEMM_DOWN(1, false, nullptr); } SEAM(7);
    if (IN(8)) { GEMM_GU(2); conv_idle(args, lds, 6, 10, 11); } SEAM(8);
    if (IN(9)) { GEMM_DOWN(2, false, nullptr); } SEAM(9);
    if (IN(10)) { pg8::Gemm g{XB, (const bf16*)(ws + WS_WCIN), M, CIN, DM}; pg8::StaticOrder S; S.init(M, CIN, G, (int)blockIdx.x);
        rstd_table(PART, lds, S); pg8::EpiProj E{ACT, DM, (const LAS float*)(lds + RSTD_OFF), DM, (size_t)M * DM, DM, C2, (float*)(ws + WS_KM)}; pg8::gemm_phase<pg8::EpiProj, pg8::StaticOrder, true, true>(lds, g, S, E); } SEAM(10);
    if (IN(11)) { select_phase(args, lds, wave, lane); }
    SEAM(11);
#if MK_DENSE_MOBA
#ifndef NO_ATTN
    if (IN(12)) {
        const attn_body::AttnTensors AT{(const attn_body::bf16*)ACT, (const attn_body::bf16*)(ACT + (size_t)M * DM), (const attn_body::bf16*)(ACT + (size_t)2 * M * DM), (attn_body::bf16*)ACT, (const unsigned*)(ws + WS_SEL)};
        const attn_body::StaticOrder S(G, (int)blockIdx.x);
        attn_body::attn_phase<attn_body::StaticOrder>((char*)lds_raw, AT, S);
    }
#endif
#else
    if (IN(12)) { moba_past_phase(args, lds, wave, lane); xcd_barrier(xbar); STAMP(20); moba_own_phase(args, lds, wave, lane); }
#endif
    SEAM(12);
    if (IN(13)) { GEMM_OUT(ACT, WS_WCOUT); } SEAM(13);
    if (IN(14)) { GEMM_GU(3); conv_idle(args, lds, 7, -1, -1); } SEAM(14);
#if MK_FUSE_FINAL
    if (IN(15)) { pg8::Gemm g{ACT, (const bf16*)(ws + ws_wd(3)), M, DM, FF}; pg8::StaticOrder S; S.init(M, DM, G, (int)blockIdx.x);
        EpiResidNorm E{XB, X, PART, args.in[17], 0.5f, xbar}; pg8::gemm_phase<EpiResidNorm, pg8::StaticOrder, false, true>(lds, g, S, E); }
#ifdef MK_TS
    xcd_barrier(xbar); STAMP(16);
    if (blockIdx.x == 0 && tid == 0) { const unsigned long long* ts = (const unsigned long long*)(ws + 262144);
        auto dur = [&](int p) -> float { if (p == 100) return (float)(ts[20] - ts[12]) * 0.01f; if (p == 101) return (float)(ts[13] - ts[20]) * 0.01f; if (p == 102) return (float)(ts[16] - ts[0]) * 0.01f; return (float)(ts[p + 1] - ts[p]) * 0.01f; };
        X[0] += dur(MK_TS_A); X[1024 * 1000] += dur(MK_TS_B); }
#endif
#else
    if (IN(15)) { GEMM_DOWN(3, false, nullptr); } SEAM(15);
    if (IN(16)) {
        const float* gn = args.in[17];
        int tid16 = threadIdx.x; asm volatile("" : "+v"(tid16)); const int lane = tid16 & 63, wave = __builtin_amdgcn_readfirstlane(tid16 >> 6);
        for (int m = blockIdx.x * NWAVES + wave; m < M; m += G * NWAVES) {
            f32x4* xr = (f32x4*)(X + (size_t)m * DM) + lane; f32x4 v[4]; float s = 0.f;
#pragma unroll
            for (int j = 0; j < 4; ++j) { v[j] = xr[64 * j]; s += (v[j][0] * v[j][0] + v[j][1] * v[j][1]) + (v[j][2] * v[j][2] + v[j][3] * v[j][3]); }
            const float rs = rsqrtf(wave_sum(s) * (1.0f / DM) + 1e-6f);
#pragma unroll
            for (int j = 0; j < 4; ++j) { const f32x4 gg = ((const f32x4*)gn)[64 * j + lane]; xr[64 * j] = v[j] * rs * gg; }
        }
    }
#endif
#undef IN
#undef SEAM
}

extern "C" void kernel_launch(void* const* d_in, const int* in_sizes, int n_in, void* d_out, int out_size, void* d_ws, size_t ws_size, hipStream_t stream) {
    static int grid = 0;
    if (grid == 0) {
        if (n_in != 18 || out_size != M * DM || ws_size < WS_END) { fprintf(stderr, "kernel_launch: unexpected shapes (n_in %d out %d ws %zu)\n", n_in, out_size, ws_size); grid = -1; return; }
        int dev = 0, cus = 0, per_cu = 0;
        hipGetDevice(&dev); hipDeviceGetAttribute(&cus, hipDeviceAttributeMultiprocessorCount, dev);
        hipFuncSetAttribute((const void*)fwd_megakernel, hipFuncAttributeMaxDynamicSharedMemorySize, LDS_BYTES);
        hipOccupancyMaxActiveBlocksPerMultiprocessor(&per_cu, (const void*)fwd_megakernel, NTHR, LDS_BYTES);
        (void)hipGetLastError();
        if (per_cu < 1) { fprintf(stderr, "kernel_launch: occupancy query reports %d blocks per CU\n", per_cu); per_cu = 1; }
        grid = cus;
        if (grid != 256) fprintf(stderr, "kernel_launch: note: %d CUs (the attention order assumes 256)\n", grid);
    }
    if (grid < 0) return;
    if (hipMemsetAsync((char*)d_ws + WS_BAR, 0, (WS_CNT + 4096) - WS_BAR, stream) != hipSuccess) { fprintf(stderr, "kernel_launch: memset failed\n"); return; }
    Args a{};
    for (int i = 0; i < 18; ++i) a.in[i] = (const float*)d_in[i];
    a.out = (float*)d_out; a.ws = (unsigned char*)d_ws;
#if MK_SINGLE
    a.ph_lo = 0; a.ph_hi = N_PHASES;
    { void* kargs[] = {&a}; hipError_t e = hipLaunchCooperativeKernel((const void*)fwd_megakernel, dim3(grid), dim3(NTHR), kargs, LDS_BYTES, stream);
      if (e != hipSuccess) fprintf(stderr, "cooperative launch failed: %s\n", hipGetErrorString(e)); }
#else
    for (int p = 0; p < N_PHASES; ++p) { a.ph_lo = p; a.ph_hi = p + 1; void* kargs[] = {&a};
        hipError_t e = hipLaunchCooperativeKernel((const void*)fwd_megakernel, dim3(grid), dim3(NTHR), kargs, LDS_BYTES, stream);
        if (e != hipSuccess) { fprintf(stderr, "cooperative launch %d failed: %s\n", p, hipGetErrorString(e)); break; } }
#endif
}
```

```cpp
#include <hip/hip_runtime.h>
#include <hip/hip_cooperative_groups.h>
#include <hip/hip_bf16.h>
#include <cstdio>
#include <cstdint>
#include <cmath>
namespace cg = cooperative_groups;
namespace pg8 {
#define PG8_LAS __attribute__((address_space(3)))
typedef unsigned short bf16_t;
typedef short bf16x8 __attribute__((ext_vector_type(8)));
typedef float f32x4 __attribute__((ext_vector_type(4)));
typedef unsigned u32x4 __attribute__((ext_vector_type(4)));
constexpr int BM = 256, BK = 64, HALF = 128, HTB = HALF * BK * 2  , STAGE_BYTES = 8 * HTB, NXCD = 8, WGM = 8;

__host__ __device__ __forceinline__ int lds_byte(int r, int c) { const int st = (r >> 4) * 2 + (c >> 5), rr = r & 15, cc = c & 31, ob = rr * 64 + cc * 2; return st * 1024 + (ob ^ (((ob >> 9) & 1) << 5)); }
__host__ __device__ __forceinline__ void stage_rc(int b, int& R, int& C) { const int st = b / 1024, sb = b % 1024, swz = sb ^ (((sb >> 9) & 1) << 5); R = (st >> 1) * 16 + swz / 64; C = (st & 1) * 32 + (swz % 64) / 2; }
__host__ __device__ __forceinline__ int perm32(int rho) { const int n = rho >> 4, i = rho & 15; return 8 * (i >> 2) + 4 * n + (i & 3); }

struct Unit { int pm, pn; };
struct Gemm { const bf16_t* A; const bf16_t* Bt; int M, N, K; };

struct StaticOrder {
    int nM, nN, nwg, G, c;
    __host__ __device__ void init(int M, int N, int G_, int c_) { nM = M / BM; nN = N / BM; nwg = nM * nN; G = G_; c = c_; }
    __host__ __device__ bool next(int i, Unit& u) const {
        const long L = (long)i * G + c; if (L >= nwg) return false;
        int wgid = (int)L; { const int q = nwg / NXCD, r = nwg % NXCD, xcd = wgid % NXCD, off = wgid / NXCD; wgid = (xcd < r ? xcd * (q + 1) : r * (q + 1) + (xcd - r) * q) + off; }
        const int nig = WGM * nN, gid = wgid / nig, fm = gid * WGM, gsz = (nM - fm) < WGM ? (nM - fm) : WGM;
        u.pm = fm + ((wgid % nig) % gsz); u.pn = (wgid % nig) / gsz; return true;
    }
    __device__ __forceinline__ void a_ready(const Unit&) const {}
    __device__ __forceinline__ void done(const Unit&) const {}
};

__device__ __forceinline__ unsigned cvt_pk_bf16(float lo, float hi) { unsigned r; asm volatile("v_cvt_pk_bf16_f32 %0, %1, %2" : "=v"(r) : "v"(lo), "v"(hi)); return r; }
typedef float f32x2 __attribute__((ext_vector_type(2)));
typedef unsigned u32x2 __attribute__((ext_vector_type(2)));
__device__ __forceinline__ float row_rstd(const float* part, int row) {
    const f32x4* p = (const f32x4*)(part + (size_t)row * 16);
    const f32x4 a = p[0], b = p[1], c = p[2], d = p[3];
    const float s = (((a[0] + a[1]) + (a[2] + a[3])) + ((b[0] + b[1]) + (b[2] + b[3]))) + (((c[0] + c[1]) + (c[2] + c[3])) + ((d[0] + d[1]) + (d[2] + d[3])));
    return rsqrtf(s * (1.0f / 1024.0f) + 1e-6f);
}
__device__ __forceinline__ float silu_mul(float g, float u) { return g * u * __builtin_amdgcn_rcpf(1.0f + __builtin_amdgcn_exp2f(-1.4426950408889634f * g)); }
struct EpiSwiGLU {
    static constexpr bool PERM = true, AFTER_DRAIN = false;
    bf16_t* H; int ldh; const PG8_LAS float* rt;
    __device__ __forceinline__ void operator()(const f32x4 (&acc)[2][2][4][2], const Unit& u, int wr, int wc, int fr, int fq, int ui) const {
        const int row0 = u.pm * BM + wr * 64 + fr; const int col0 = u.pn * HALF + wc * 32 + 8 * fq;
#pragma unroll
        for (int ai = 0; ai < 2; ++ai)
#pragma unroll
            for (int m = 0; m < 4; ++m) { const int row = row0 + ai * HALF + m * 16; const float rs = rt[ui * 256 + wr * 64 + fr + ai * HALF + m * 16];
                const f32x4 g0 = acc[ai][0][m][0] * rs, g1 = acc[ai][0][m][1] * rs, u0 = acc[ai][1][m][0] * rs, u1 = acc[ai][1][m][1] * rs;
                u32x4 w; w.x = cvt_pk_bf16(silu_mul(g0[0], u0[0]), silu_mul(g0[1], u0[1])); w.y = cvt_pk_bf16(silu_mul(g0[2], u0[2]), silu_mul(g0[3], u0[3]));
                w.z = cvt_pk_bf16(silu_mul(g1[0], u1[0]), silu_mul(g1[1], u1[1])); w.w = cvt_pk_bf16(silu_mul(g1[2], u1[2]), silu_mul(g1[3], u1[3]));
                *(u32x4*)(H + (size_t)row * ldh + col0) = w; }
    }
};
template <bool BASE_F32> struct EpiResid {
    static constexpr bool PERM = true, AFTER_DRAIN = false;
    const float* base; bf16_t* xb; float* part; float alpha;
    __device__ __forceinline__ void operator()(const f32x4 (&acc)[2][2][4][2], const Unit& u, int wr, int wc, int fr, int fq, int) const {
        const int row0 = u.pm * BM + wr * 64 + fr; const int col0 = u.pn * BM + wc * 32 + 8 * fq;
#pragma unroll
        for (int ai = 0; ai < 2; ++ai)
#pragma unroll
            for (int m = 0; m < 4; ++m) { const int row = row0 + ai * HALF + m * 16; float ss = 0.f;
#pragma unroll
                for (int bj = 0; bj < 2; ++bj) { const size_t off = (size_t)row * 1024 + col0 + bj * HALF;
                    f32x4 b0, b1;
                    if (BASE_F32) { b0 = *(const f32x4*)(base + off); b1 = *(const f32x4*)(base + off + 4); }
                    else { const u32x4 r = *(const u32x4*)(xb + off);
                        b0 = (f32x4){__builtin_bit_cast(float, r.x << 16), __builtin_bit_cast(float, r.x & 0xffff0000u), __builtin_bit_cast(float, r.y << 16), __builtin_bit_cast(float, r.y & 0xffff0000u)};
                        b1 = (f32x4){__builtin_bit_cast(float, r.z << 16), __builtin_bit_cast(float, r.z & 0xffff0000u), __builtin_bit_cast(float, r.w << 16), __builtin_bit_cast(float, r.w & 0xffff0000u)}; }
                    const f32x4 v0 = b0 + acc[ai][bj][m][0] * alpha, v1 = b1 + acc[ai][bj][m][1] * alpha;
                    ss += ((v0[0] * v0[0] + v0[1] * v0[1]) + (v0[2] * v0[2] + v0[3] * v0[3])) + ((v1[0] * v1[0] + v1[1] * v1[1]) + (v1[2] * v1[2] + v1[3] * v1[3]));
                    u32x4 w; w.x = cvt_pk_bf16(v0[0], v0[1]); w.y = cvt_pk_bf16(v0[2], v0[3]); w.z = cvt_pk_bf16(v1[0], v1[1]); w.w = cvt_pk_bf16(v1[2], v1[3]);
                    *(u32x4*)(xb + off) = w; }
                ss += __shfl_xor(ss, 16); ss += __shfl_xor(ss, 32);
                if (fq == 0) part[(size_t)row * 16 + u.pn * 4 + wc] = ss; }
    }
};
struct EpiProj {
    static constexpr bool PERM = true, AFTER_DRAIN = false;
    bf16_t* O; int ldc; const PG8_LAS float* rt; int split_cols; size_t split_stride; int qcols; float scale0; float* km;
    __device__ __forceinline__ void operator()(const f32x4 (&acc)[2][2][4][2], const Unit& u, int wr, int wc, int fr, int fq, int ui) const {
        const int row0 = u.pm * BM + wr * 64 + fr; int colt = u.pn * BM; bf16_t* basep = O; int t = 0;
        const float sc = (colt < qcols) ? scale0 : 1.f;
        if (split_cols) { t = colt / split_cols; basep += (size_t)t * split_stride; colt -= t * split_cols; }
        const int col0 = colt + wc * 32 + 8 * fq;
        const bool do_km = (km != nullptr) && (t == 1);
        f32x4 cs[2][2];
#pragma unroll
        for (int bj = 0; bj < 2; ++bj)
#pragma unroll
            for (int n = 0; n < 2; ++n) cs[bj][n] = (f32x4){0.f, 0.f, 0.f, 0.f};
#pragma unroll
        for (int ai = 0; ai < 2; ++ai)
#pragma unroll
            for (int m = 0; m < 4; ++m) { const int row = row0 + ai * HALF + m * 16; const float rs = rt[ui * 256 + wr * 64 + fr + ai * HALF + m * 16]; const float rsc = rs * sc;
                bf16_t* rowp = basep + (size_t)row * ldc + col0;
#pragma unroll
                for (int bj = 0; bj < 2; ++bj) { const f32x4 v0 = acc[ai][bj][m][0] * rsc, v1 = acc[ai][bj][m][1] * rsc;
                    cs[bj][0] += v0; cs[bj][1] += v1;
                    u32x4 w; w.x = cvt_pk_bf16(v0[0], v0[1]); w.y = cvt_pk_bf16(v0[2], v0[3]); w.z = cvt_pk_bf16(v1[0], v1[1]); w.w = cvt_pk_bf16(v1[2], v1[3]);
                    *(u32x4*)(rowp + bj * HALF) = w; } }
        if (do_km) {
#pragma unroll
            for (int bj = 0; bj < 2; ++bj)
#pragma unroll
                for (int n = 0; n < 2; ++n) { f32x4 v = cs[bj][n];
#pragma unroll
                    for (int o = 1; o < 16; o <<= 1) { v[0] += __shfl_xor(v[0], o); v[1] += __shfl_xor(v[1], o); v[2] += __shfl_xor(v[2], o); v[3] += __shfl_xor(v[3], o); }
                    if (fr == 0) *(f32x4*)(km + (size_t)(u.pm * 2 + wr) * 1024 + col0 + bj * HALF + 4 * n) = v; }
        }
    }
};
template <class Epi, class Sched, bool ALIGN_EPI = false, bool SP2 = false>
__device__ __forceinline__ void gemm_phase(PG8_LAS unsigned char* lds, const Gemm g, const Sched& S, const Epi& E) {
    const int tid = threadIdx.x, wid = __builtin_amdgcn_readfirstlane(tid >> 6), lane = tid & 63, wr = wid >> 2, wc = wid & 3, fr = lane & 15, fq = lane >> 4;
    const int K = g.K, nt = K / BK;
    unsigned voffA[2], voffB[2];
#pragma unroll
    for (int i = 0; i < 2; ++i) { int R, C; stage_rc(tid * 16 + i * 8192, R, C); const int Rb = Epi::PERM ? ((R & ~31) + perm32(R & 31)) : R;
        voffA[i] = (unsigned)(R * K + C) * 2u; voffB[i] = (unsigned)(Rb * K + C) * 2u; }
    const size_t kstep = (size_t)(BK * 2);
    const size_t hstep = (size_t)HALF * K * 2;
    const size_t tstep = 2 * hstep;
    const unsigned ldsw = (unsigned)wid * 1024u;
    const int aoff = lds_byte(wr * 64 + fr, fq * 8), boff = lds_byte(wc * 32 + fr, fq * 8);
#define PG8_SA(b, h) (((b) * 2 + (h)) * HTB)
#define PG8_SB(b, h) ((4 + (b) * 2 + (h)) * HTB)
#define PG8_STAGE(bufoff, gbase, voff) do { _Pragma("unroll") for (int _i = 0; _i < 2; ++_i) \
        __builtin_amdgcn_global_load_lds((const unsigned*)((const char*)(gbase) + (voff)[_i]), (PG8_LAS unsigned*)(lds + (bufoff) + ldsw + _i * 8192), 16, 0, 0); } while (0)
#define PG8_LDA(dst, b, h) do { _Pragma("unroll") for (int m = 0; m < 4; ++m) _Pragma("unroll") for (int k = 0; k < 2; ++k) dst[m][k] = *(const PG8_LAS bf16x8*)(lds + PG8_SA(b, h) + aoff + m * 2048 + k * 1024); } while (0)
#define PG8_LDB(dst, b, h) do { _Pragma("unroll") for (int n = 0; n < 2; ++n) _Pragma("unroll") for (int k = 0; k < 2; ++k) dst[n][k] = *(const PG8_LAS bf16x8*)(lds + PG8_SB(b, h) + boff + n * 2048 + k * 1024); } while (0)
#define PG8_MMA(ai, bj, At, Bt) do { __builtin_amdgcn_s_setprio(1); _Pragma("unroll") for (int m = 0; m < 4; ++m) _Pragma("unroll") for (int n = 0; n < 2; ++n) _Pragma("unroll") for (int k = 0; k < 2; ++k) \
        acc[ai][bj][m][n] = __builtin_amdgcn_mfma_f32_16x16x32_bf16(Bt[n][k], At[m][k], acc[ai][bj][m][n], 0, 0, 0); __builtin_amdgcn_s_setprio(0); } while (0)
#define PG8_WAIT_V(n) asm volatile("s_waitcnt vmcnt(" #n ")" ::: "memory")
#define PG8_WAIT_L(n) asm volatile("s_waitcnt lgkmcnt(" #n ")" ::: "memory")
#define PG8_BAR __builtin_amdgcn_s_barrier()
#define PG8_SCHED __builtin_amdgcn_sched_barrier(0)
    Unit cur, nxt; int ui = 0;
    if (!S.next(0, cur)) return;
    f32x4 acc[2][2][4][2];
#pragma unroll
    for (int a = 0; a < 2; ++a)
#pragma unroll
        for (int b = 0; b < 2; ++b)
#pragma unroll
            for (int m = 0; m < 4; ++m)
#pragma unroll
                for (int n = 0; n < 2; ++n) acc[a][b][m][n] = (f32x4){0.f, 0.f, 0.f, 0.f};
    bf16x8 At[4][2], B0[2][2], B1[2][2];
    const char* cA = (const char*)g.A + (size_t)cur.pm * tstep; const char* cB = (const char*)g.Bt + (size_t)cur.pn * tstep;
    S.a_ready(cur);
    if constexpr (SP2) {
        PG8_STAGE(PG8_SB(0, 0), cB, voffB); PG8_STAGE(PG8_SB(0, 1), cB + hstep, voffB); PG8_STAGE(PG8_SA(0, 0), cA, voffA); PG8_STAGE(PG8_SA(0, 1), cA + hstep, voffA);
        if (wr == 1) PG8_BAR;
        PG8_WAIT_V(2); PG8_BAR;
        PG8_STAGE(PG8_SB(1, 0), cB + kstep, voffB); PG8_STAGE(PG8_SA(1, 0), cA + kstep, voffA); PG8_STAGE(PG8_SB(1, 1), cB + hstep + kstep, voffB);
        PG8_WAIT_V(6); PG8_BAR;
    } else {
        PG8_STAGE(PG8_SB(0, 0), cB, voffB); PG8_STAGE(PG8_SA(0, 0), cA, voffA); PG8_STAGE(PG8_SB(0, 1), cB + hstep, voffB); PG8_STAGE(PG8_SA(0, 1), cA + hstep, voffA);
        if (wr == 1) PG8_BAR;
        PG8_WAIT_V(4); PG8_BAR;
        PG8_STAGE(PG8_SB(1, 0), cB + kstep, voffB); PG8_STAGE(PG8_SA(1, 0), cA + kstep, voffA); PG8_STAGE(PG8_SB(1, 1), cB + hstep + kstep, voffB);
        PG8_WAIT_V(6); PG8_BAR;
    }
    for (;;) {
        const bool has_next = S.next(ui + 1, nxt);
        const char* nA = has_next ? (const char*)g.A + (size_t)nxt.pm * tstep : cA; const char* nB = has_next ? (const char*)g.Bt + (size_t)nxt.pn * tstep : cB;
        for (int t = 0; t < nt; t += 2) {
            const bool last = (t == nt - 2);
            const char* a1 = cA + (size_t)(t + 1) * kstep;
            const char* a2 = last ? nA : cA + (size_t)(t + 2) * kstep; const char* b2 = last ? nB : cB + (size_t)(t + 2) * kstep;
            const char* a3 = a2 + kstep; const char* b3 = b2 + kstep;
            if (last && has_next) S.a_ready(nxt);
            if constexpr (SP2) {
            PG8_LDB(B0, 0, 0); PG8_LDB(B1, 0, 1); PG8_SCHED; PG8_LDA(At, 0, 0); PG8_STAGE(PG8_SA(1, 1), a1 + hstep, voffA);
            PG8_WAIT_V(8); PG8_WAIT_L(0); PG8_BAR; PG8_MMA(0, 0, At, B0); PG8_MMA(0, 1, At, B1); PG8_BAR; PG8_SCHED;
            PG8_LDA(At, 0, 1); PG8_STAGE(PG8_SB(0, 0), b2, voffB); PG8_STAGE(PG8_SB(0, 1), b2 + hstep, voffB); PG8_STAGE(PG8_SA(0, 0), a2, voffA);
            PG8_WAIT_V(8); PG8_WAIT_L(0); PG8_BAR; PG8_MMA(1, 0, At, B0); PG8_MMA(1, 1, At, B1); PG8_BAR; PG8_SCHED;
            PG8_LDB(B0, 1, 0); PG8_LDB(B1, 1, 1); PG8_SCHED; PG8_LDA(At, 1, 0); PG8_STAGE(PG8_SA(0, 1), a2 + hstep, voffA);
            PG8_WAIT_V(8); PG8_WAIT_L(0); PG8_BAR; PG8_MMA(0, 0, At, B0); PG8_MMA(0, 1, At, B1); PG8_BAR; PG8_SCHED;
            PG8_LDA(At, 1, 1); PG8_STAGE(PG8_SB(1, 0), b3, voffB); PG8_STAGE(PG8_SB(1, 1), b3 + hstep, voffB); PG8_STAGE(PG8_SA(1, 0), a3, voffA);
            PG8_WAIT_V(8); PG8_WAIT_L(0); PG8_BAR; PG8_MMA(1, 0, At, B0); PG8_MMA(1, 1, At, B1); PG8_BAR; PG8_SCHED;
            } else {
            PG8_LDB(B0, 0, 0); PG8_SCHED; PG8_LDA(At, 0, 0); PG8_STAGE(PG8_SA(1, 1), a1 + hstep, voffA);
            PG8_WAIT_L(8); PG8_BAR; PG8_WAIT_L(0); PG8_MMA(0, 0, At, B0); PG8_BAR; PG8_SCHED;
            PG8_LDB(B1, 0, 1); PG8_STAGE(PG8_SB(0, 0), b2, voffB);
            PG8_BAR; PG8_WAIT_L(0); PG8_MMA(0, 1, At, B1); PG8_BAR;
            PG8_LDA(At, 0, 1); PG8_STAGE(PG8_SA(0, 0), a2, voffA);
            PG8_BAR; PG8_WAIT_L(0); PG8_MMA(1, 0, At, B0); PG8_BAR; PG8_SCHED;
            PG8_STAGE(PG8_SB(0, 1), b2 + hstep, voffB);
            PG8_WAIT_V(6); PG8_BAR; PG8_MMA(1, 1, At, B1); PG8_BAR;
            PG8_LDB(B0, 1, 0); PG8_SCHED; PG8_LDA(At, 1, 0); PG8_STAGE(PG8_SA(0, 1), a2 + hstep, voffA);
            PG8_WAIT_L(8); PG8_BAR; PG8_WAIT_L(0); PG8_MMA(0, 0, At, B0); PG8_BAR; PG8_SCHED;
            PG8_LDB(B1, 1, 1); PG8_STAGE(PG8_SB(1, 0), b3, voffB);
            PG8_BAR; PG8_WAIT_L(0); PG8_MMA(0, 1, At, B1); PG8_BAR;
            PG8_LDA(At, 1, 1); PG8_STAGE(PG8_SA(1, 0), a3, voffA);
            PG8_BAR; PG8_WAIT_L(0); PG8_MMA(1, 0, At, B0); PG8_BAR; PG8_SCHED;
            PG8_STAGE(PG8_SB(1, 1), b3 + hstep, voffB);
            PG8_WAIT_V(6); PG8_BAR; PG8_MMA(1, 1, At, B1); PG8_BAR;
            }
        }
        if constexpr (ALIGN_EPI) { if (wr == 0) PG8_BAR; }
        if constexpr (!Epi::AFTER_DRAIN) { E(acc, cur, wr, wc, fr, fq, ui); S.done(cur); }
        if (!has_next) break;
#pragma unroll
        for (int a = 0; a < 2; ++a)
#pragma unroll
            for (int b = 0; b < 2; ++b)
#pragma unroll
                for (int m = 0; m < 4; ++m)
#pragma unroll
                    for (int n = 0; n < 2; ++n) acc[a][b][m][n] = (f32x4){0.f, 0.f, 0.f, 0.f};
        cur = nxt; cA = nA; cB = nB; ++ui;
        if constexpr (ALIGN_EPI) { if (wr == 1) PG8_BAR; }
    }
    PG8_WAIT_V(0);
    if constexpr (!ALIGN_EPI) { if (wr == 0) PG8_BAR; }
    PG8_BAR;
    if constexpr (Epi::AFTER_DRAIN) { E.fused(acc, cur, wr, wc, fr, fq, lds, wid, lane); S.done(cur); }
#undef PG8_SA
#undef PG8_SB
#undef PG8_STAGE
#undef PG8_LDA
#undef PG8_LDB
#undef PG8_MMA
#undef PG8_WAIT_V
#undef PG8_WAIT_L
#undef PG8_BAR
#undef PG8_SCHED
}
}
#define PG8_SP2 true
#define PG8_ALIGN true
namespace attn_body {
using bf16=__hip_bfloat16;
using bf16x8=__attribute__((ext_vector_type(8)))short;
using s16x4=__attribute__((ext_vector_type(4)))short;
using f32x16=__attribute__((ext_vector_type(16)))float;
using u32x4=__attribute__((ext_vector_type(4)))unsigned;
constexpr int BATCH=2,NHEAD=16,SEQ=8192,D=64,DM=NHEAD*D;
constexpr int NW=8,QBLK=32,QB=QBLK*NW,KVBLK=64,NQB=SEQ/QB;
constexpr int ATTN_PITCH=DM, ATTN_UNIT_ROWS=QB;
__device__ __forceinline__ int crow(int r,int hi){return (r&3)+8*(r>>2)+4*hi;}
#define SBAR() __builtin_amdgcn_sched_barrier(0)
__device__ __forceinline__ void cmask(f32x16&p0,f32x16&p1,int jb,int qrel,int hi){
  const float NEG=-INFINITY; int kb=64*jb+4*hi;
  #pragma unroll
  for(int r=0;r<16;++r){int kv=kb+(r&3)+8*(r>>2); if(kv>qrel)p0[r]=NEG; if(kv+32>qrel)p1[r]=NEG;}
}

constexpr int NSLOT=3, SLOTB=8192; constexpr float NEGBIG=-2048.f;
constexpr int LDS_K=0, LDS_V=NSLOT*SLOTB, LDS_WS=2*NSLOT*SLOTB, LDS_OST=LDS_WS+NW*64*4, LDS_BYTES=LDS_OST+NW*4096;
constexpr float C2=0.125f*1.4426950408889634f;
__device__ __forceinline__ void glds16(const void*gsrc,unsigned lds_dst){unsigned keep;
  asm volatile("s_mov_b32 %0, m0\n\ts_mov_b32 m0, %2\n\ts_nop 0\n\tglobal_load_lds_dwordx4 %1, off\n\ts_mov_b32 m0, %0":"=&s"(keep):"v"(gsrc),"s"(lds_dst):"memory");}
__device__ __forceinline__ float max3f(float a,float b,float c){float r;asm("v_max3_f32 %0, %1, %2, %3":"=v"(r):"v"(a),"v"(b),"v"(c));return r;}
__device__ __forceinline__ float max2f(float a,float b){float r;asm("v_max_f32_e32 %0, %1, %2":"=v"(r):"v"(a),"v"(b));return r;}
__device__ __forceinline__ float fadd_s(float a,float b){float r;asm("v_add_f32_e32 %0, %1, %2":"=v"(r):"v"(a),"v"(b));return r;}
__device__ __forceinline__ float fsub_s(float a,float b){float r;asm("v_sub_f32_e32 %0, %1, %2":"=v"(r):"v"(a),"v"(b));return r;}
typedef float f32x2_t __attribute__((ext_vector_type(2))); typedef __bf16 bf16x2_t __attribute__((ext_vector_type(2)));
__device__ __forceinline__ unsigned cvtpk_s(float lo,float hi){f32x2_t v={lo,hi};bf16x2_t b=__builtin_convertvector(v,bf16x2_t);return __builtin_bit_cast(unsigned,b);}
#define WAIT_BAR(N) asm volatile("s_waitcnt vmcnt(" #N ") lgkmcnt(0)\n\ts_barrier":::"memory")

__device__ __forceinline__ void qkt(f32x16&p0,f32x16&p1,const char*Kslot,const bf16x8*qr,const f32x16&negm,int r32,int hi){
  const char*kb=Kslot+hi*1024+r32*16;
  #pragma unroll
  for(int d0=0;d0<4;++d0){
    const bf16x8 b0=*reinterpret_cast<const bf16x8*>(kb+d0*2048);
    const bf16x8 b1=*reinterpret_cast<const bf16x8*>(kb+d0*2048+512);
    if(d0==0){p0=__builtin_amdgcn_mfma_f32_32x32x16_bf16(b0,qr[0],negm,0,0,0);p1=__builtin_amdgcn_mfma_f32_32x32x16_bf16(b1,qr[0],negm,0,0,0);}
    else{p0=__builtin_amdgcn_mfma_f32_32x32x16_bf16(b0,qr[d0],p0,0,0,0);p1=__builtin_amdgcn_mfma_f32_32x32x16_bf16(b1,qr[d0],p1,0,0,0);}}
}
typedef __attribute__((address_space(3))) const char* lds_cptr;
typedef short v4i16_t __attribute__((ext_vector_type(4)));
__device__ __forceinline__ void kload8(bf16x8*kf,lds_cptr kp){
  kf[0]=*(const __attribute__((address_space(3))) bf16x8*)(kp);      kf[1]=*(const __attribute__((address_space(3))) bf16x8*)(kp+512);
  kf[2]=*(const __attribute__((address_space(3))) bf16x8*)(kp+2048); kf[3]=*(const __attribute__((address_space(3))) bf16x8*)(kp+2560);
  kf[4]=*(const __attribute__((address_space(3))) bf16x8*)(kp+4096); kf[5]=*(const __attribute__((address_space(3))) bf16x8*)(kp+4608);
  kf[6]=*(const __attribute__((address_space(3))) bf16x8*)(kp+6144); kf[7]=*(const __attribute__((address_space(3))) bf16x8*)(kp+6656);
}
__device__ __forceinline__ void kload2(bf16x8*kf,lds_cptr kp,int j){ kf[2*j]=*(const __attribute__((address_space(3))) bf16x8*)(kp+j*2048); kf[2*j+1]=*(const __attribute__((address_space(3))) bf16x8*)(kp+j*2048+512); }
__device__ __forceinline__ s16x4 vtr(lds_cptr p){ return __builtin_bit_cast(s16x4,__builtin_amdgcn_ds_read_tr16_b64_v4i16((__attribute__((address_space(3))) v4i16_t*)p)); }
__device__ __forceinline__ float rowmax(const f32x16&p0,const f32x16&p1){
  float a=max3f(p0[0],p0[1],p1[0]),b=max3f(p0[2],p0[3],p1[1]);a=max3f(a,p1[2],p1[3]);
  #pragma unroll
  for(int r=4;r<16;r+=4){a=max3f(a,p0[r],p0[r+1]);b=max3f(b,p0[r+2],p0[r+3]);a=max3f(a,p1[r],p1[r+1]);b=max3f(b,p1[r+2],p1[r+3]);}
  const float m=max2f(a,b);
  auto rr=__builtin_amdgcn_permlane32_swap(__float_as_uint(m),__float_as_uint(m),false,false);
  return max2f(__uint_as_float(rr[0]),__uint_as_float(rr[1]));
}
__device__ __forceinline__ void pv(f32x16*o,int vb,bf16x8 pa0,bf16x8 pa1,bf16x8 pa2,bf16x8 pa3){
  #pragma unroll
  for(int d0=0;d0<2;++d0){s16x4 lo[4],hi[4];
    #pragma unroll
    for(int ks=0;ks<4;++ks){
      asm volatile("ds_read_b64_tr_b16 %0,%1 offset:%c2":"=&v"(lo[ks]):"v"(vb),"i"(d0*4096+ks*1024):"memory");
      asm volatile("ds_read_b64_tr_b16 %0,%1 offset:%c2":"=&v"(hi[ks]):"v"(vb),"i"(d0*4096+ks*1024+512):"memory");}
    asm volatile("s_waitcnt lgkmcnt(0)":::"memory");SBAR();
    #define PK(k) (bf16x8){lo[k][0],lo[k][1],lo[k][2],lo[k][3],hi[k][0],hi[k][1],hi[k][2],hi[k][3]}
    o[d0]=__builtin_amdgcn_mfma_f32_32x32x16_bf16(pa0,PK(0),o[d0],0,0,0);
    o[d0]=__builtin_amdgcn_mfma_f32_32x32x16_bf16(pa1,PK(1),o[d0],0,0,0);
    o[d0]=__builtin_amdgcn_mfma_f32_32x32x16_bf16(pa2,PK(2),o[d0],0,0,0);
    o[d0]=__builtin_amdgcn_mfma_f32_32x32x16_bf16(pa3,PK(3),o[d0],0,0,0);
    #undef PK
  }
}

#ifndef ATTN_STORE16
#define ATTN_STORE16(p,v) (*(u32x4*)(p)=(v))
#endif
template<int THRL> __device__ __forceinline__ void attn_unit(int b,int h,int qb,const bf16*Q,const bf16*__restrict__ K,const bf16*__restrict__ V,bf16*O,const unsigned*__restrict__ SEL,char*shm){
  const int tid=threadIdx.x,lane=tid&63,r32=lane&31,hi=lane>>5; const int wid=__builtin_amdgcn_readfirstlane(tid>>6);
  const long rowbase=(long)b*SEQ; const int q0=qb*QB;
  const bf16*Qw=Q+(rowbase+q0+wid*QBLK)*DM+h*D;
  const bf16*Kh=K+rowbase*DM+h*D,*Vh=V+rowbase*DM+h*D;
  const unsigned lds0=(unsigned)(uintptr_t)shm;
  float*wsf=(float*)(shm+LDS_WS)+wid*64;
  const bf16*ksrc=Kh+(long)lane*DM+wid*8;
  const bf16*vsrc=Vh+(long)(16*(wid&3)+(lane>>2))*DM+(wid>>2)*32+(lane&3)*8;
  const unsigned kdst=lds0+LDS_K+wid*1024, vdst=lds0+LDS_V+wid*1024;
  #define DMA_K(t,slot) glds16(ksrc+(long)(t)*KVBLK*DM,(unsigned)__builtin_amdgcn_readfirstlane(kdst+(slot)))
  #define DMA_V(t,slot) glds16(vsrc+(long)(t)*KVBLK*DM,(unsigned)__builtin_amdgcn_readfirstlane(vdst+(slot)))
  const int vb0=(int)(lds0+LDS_V)+((lane>>4)&1)*32+(lane&3)*8+(4*hi+((lane&15)>>2))*64;
  const char*Kbase=shm+LDS_K; bf16x8 kf[8];
  const lds_cptr shm3=(lds_cptr)shm; const lds_cptr kp0=shm3+LDS_K+hi*1024+r32*16; const lds_cptr vp0=shm3+LDS_V+((lane>>4)&1)*32+(lane&3)*8+(4*hi+((lane&15)>>2))*64;
  const int NT=(q0+QB)/KVBLK;
  DMA_K(0,0);DMA_V(0,0);DMA_K(1,SLOTB);
  bf16x8 qr[4];
  #pragma unroll
  for(int d0=0;d0<4;++d0)qr[d0]=*reinterpret_cast<const bf16x8*>(&Qw[(long)r32*DM+d0*16+hi*8]);
  float mhat=0.f,l_reg=0.f;f32x16 o[2];o[0]=f32x16{};o[1]=f32x16{};const f32x16 negm=f32x16{};
  const int qrel=wid*QBLK+r32; volatile unsigned*sel_l=(volatile unsigned*)(shm+LDS_BYTES)+wid*32; if(hi==0)sel_l[r32]=SEL[(size_t)(b*NHEAD+h)*SEQ+q0+qrel];
  #define CMASK(P0,P1,t) do{int jb_=(t)-(NT-4); if(jb_>=0){cmask(P0,P1,jb_,qrel,hi);} else if(!((sel_l[r32]>>(((t)>>2)&31))&1u)){ _Pragma("unroll") for(int r_=0;r_<16;++r_){P0[r_]=NEGBIG;P1[r_]=NEGBIG;} } }while(0)
  bool resc=false;
  #define START(P0,P1) do{ const float rm=rowmax(P0,P1); resc=false; \
    { const float dl=rm; mhat=fadd_s(mhat,dl); \
      _Pragma("unroll") for(int r=0;r<16;++r){P0[r]=fsub_s(P0[r],dl);P1[r]=fsub_s(P1[r],dl);} \
      } \
    _Pragma("unroll") for(int r=0;r<16;++r)P0[r]=__builtin_amdgcn_exp2f(P0[r]); }while(0)
  #define RESC() do{ if(resc){ asm volatile("s_waitcnt lgkmcnt(0)":::"memory"); \
      _Pragma("unroll") for(int d_=0;d_<2;++d_) _Pragma("unroll") for(int r=0;r<16;++r)o[d_][r]*=wsf[crow(r,hi)]; } }while(0)
  f32x16 pA0,pA1,pB0,pB1;
  int sl_prev=0,sl_cur=0,sl_next=SLOTB;
  #define ROT() do{sl_prev=sl_cur;sl_cur=sl_next;sl_next=(sl_next==(NSLOT-1)*SLOTB)?0:sl_next+SLOTB;}while(0)
  DMA_K(2,2*SLOTB);
  WAIT_BAR(3);
  qkt(pA0,pA1,Kbase,qr,negm,r32,hi);asm volatile("s_nop 15\n\ts_nop 7":"+v"(pA0),"+v"(pA1));CMASK(pA0,pA1,0);
  START(pA0,pA1);
  _Pragma("unroll") for(int r=0;r<16;++r)pA1[r]=__builtin_amdgcn_exp2f(pA1[r]);
  WAIT_BAR(0);
  DMA_K(3,0);DMA_V(1,SLOTB);
  ROT();
  kload8(kf,kp0+sl_cur);
  WAIT_BAR(2);
  s16x4 vlo[8],vhi[8]; u32x4 pw0,pw1,pw2,pw3;
  #define PKW(P,B) cvtpk_s(P[B],P[B+1])
  #define PAF(k) __builtin_bit_cast(bf16x8,pw##k)
  #define VFR(i) (bf16x8){vlo[i][0],vlo[i][1],vlo[i][2],vlo[i][3],vhi[i][0],vhi[i][1],vhi[i][2],vhi[i][3]}
  #define PIN(x) asm volatile("":"+v"(x))
  #define MX3(a,b,c) __builtin_fmaxf(__builtin_fmaxf((a),(b)),(c))
  #define GAPA(MF,A0,A1,A2,A3,W0,W1,PW) do{ MF; sacc+=A0; sacc+=A1; sacc+=A2; sacc+=A3; PIN(sacc); W0; W1; PIN(PW); SBAR(); }while(0)
  #define EX(v) __builtin_amdgcn_exp2f(v)
  #define GAPB(MF,X,B) do{ MF; X[B]=EX(X[B]); X[B+1]=EX(X[B+1]); X[B+2]=EX(X[B+2]); X[B+3]=EX(X[B+3]); PIN(X); SBAR(); }while(0)
  #define VRD(i) do{ vlo[i]=vtr(vp_+(((i)>>2)*4096+((i)&3)*1024)); vhi[i]=vtr(vp_+(((i)>>2)*4096+((i)&3)*1024+512)); }while(0)
  #define KRD(G,j) do{ if(G){ kload2(kf,kp0+sl_next,j); SBAR(); } }while(0)
  #define STEP(C0,C1,P0,P1,t,GK,GV,GL) do{ SBAR(); \
    const lds_cptr vp_=vp0+sl_prev; \
    VRD(0); SBAR(); float sacc=(P0[0]+P0[1]); \
    GAPA(C0=__builtin_amdgcn_mfma_f32_32x32x16_bf16(kf[0],qr[0],negm,0,0,0), P0[2],P0[3],P0[4],P0[5],     pw0[0]=PKW(P0,0), pw0[1]=PKW(P0,2), pw0); \
    VRD(4); SBAR(); GAPA(C1=__builtin_amdgcn_mfma_f32_32x32x16_bf16(kf[1],qr[0],negm,0,0,0), P0[6],P0[7],P0[8],P0[9],     pw0[2]=PKW(P0,4), pw0[3]=PKW(P0,6), pw0); \
    VRD(1); SBAR(); GAPA(C0=__builtin_amdgcn_mfma_f32_32x32x16_bf16(kf[2],qr[1],C0,0,0,0),   P0[10],P0[11],P0[12],P0[13], pw1[0]=PKW(P0,8), pw1[1]=PKW(P0,10), pw1); \
    VRD(5); SBAR(); GAPA(C1=__builtin_amdgcn_mfma_f32_32x32x16_bf16(kf[3],qr[1],C1,0,0,0),   P0[14],P0[15],P1[0],P1[1],   pw1[2]=PKW(P0,12),pw1[3]=PKW(P0,14), pw1); \
    VRD(2); SBAR(); GAPA(C0=__builtin_amdgcn_mfma_f32_32x32x16_bf16(kf[4],qr[2],C0,0,0,0),   P1[2],P1[3],P1[4],P1[5],     pw2[0]=PKW(P1,0), pw2[1]=PKW(P1,2), pw2); \
    VRD(6); SBAR(); GAPA(C1=__builtin_amdgcn_mfma_f32_32x32x16_bf16(kf[5],qr[2],C1,0,0,0),   P1[6],P1[7],P1[8],P1[9],     pw2[2]=PKW(P1,4), pw2[3]=PKW(P1,6), pw2); \
    VRD(3); SBAR(); GAPA(C0=__builtin_amdgcn_mfma_f32_32x32x16_bf16(kf[6],qr[3],C0,0,0,0),   P1[10],P1[11],P1[12],P1[13], pw3[0]=PKW(P1,8), pw3[1]=PKW(P1,10), pw3); \
    VRD(7); SBAR(); GAPA(C1=__builtin_amdgcn_mfma_f32_32x32x16_bf16(kf[7],qr[3],C1,0,0,0),   P1[14],P1[15],0.f,0.f,       pw3[2]=PKW(P1,12),pw3[3]=PKW(P1,14), pw3); \
    l_reg+=sacc; \
    if(GK){DMA_K((t)+3,sl_cur);} if(GV){DMA_V((t)+1,sl_next);} \
    _Pragma("unroll") for(int r=0;r<16;++r){C0[r]-=mhat;C1[r]-=mhat;} \
    CMASK(C0,C1,t); \
    { float a=MX3(C0[0],C0[1],C1[0]),b=MX3(C0[2],C0[3],C1[1]); a=MX3(a,C1[2],C1[3]); \
      _Pragma("unroll") for(int r=4;r<16;r+=4){a=MX3(a,C0[r],C0[r+1]);b=MX3(b,C0[r+2],C0[r+3]);a=MX3(a,C1[r],C1[r+1]);b=MX3(b,C1[r+2],C1[r+3]);} \
      float rm=__builtin_fmaxf(a,b); { auto rr=__builtin_amdgcn_permlane32_swap(__float_as_uint(rm),__float_as_uint(rm),false,false); rm=__builtin_fmaxf(__uint_as_float(rr[0]),__uint_as_float(rr[1])); } \
      resc=false; \
      if(__builtin_expect(__any(rm>(float)THRL),0)){ const float dl=__builtin_fmaxf(rm,0.f); mhat+=dl; \
        _Pragma("unroll") for(int r=0;r<16;++r){C0[r]-=dl;C1[r]-=dl;} \
        const float f=__builtin_amdgcn_exp2f(-dl); l_reg*=f; if(hi==0)wsf[r32]=f; resc=true; } } \
    SBAR(); \
    GAPB(o[0]=__builtin_amdgcn_mfma_f32_32x32x16_bf16(PAF(0),VFR(0),o[0],0,0,0), C0,0); \
    GAPB(o[1]=__builtin_amdgcn_mfma_f32_32x32x16_bf16(PAF(0),VFR(4),o[1],0,0,0), C0,4); \
    KRD(GL,0); GAPB(o[0]=__builtin_amdgcn_mfma_f32_32x32x16_bf16(PAF(1),VFR(1),o[0],0,0,0), C0,8); \
    KRD(GL,1); GAPB(o[1]=__builtin_amdgcn_mfma_f32_32x32x16_bf16(PAF(1),VFR(5),o[1],0,0,0), C0,12); \
    KRD(GL,2); GAPB(o[0]=__builtin_amdgcn_mfma_f32_32x32x16_bf16(PAF(2),VFR(2),o[0],0,0,0), C1,0); \
    KRD(GL,3); GAPB(o[1]=__builtin_amdgcn_mfma_f32_32x32x16_bf16(PAF(2),VFR(6),o[1],0,0,0), C1,4); \
    GAPB(o[0]=__builtin_amdgcn_mfma_f32_32x32x16_bf16(PAF(3),VFR(3),o[0],0,0,0), C1,8); \
    GAPB(o[1]=__builtin_amdgcn_mfma_f32_32x32x16_bf16(PAF(3),VFR(7),o[1],0,0,0), C1,12); \
    }while(0)
  int t=1;
  #undef CMASK
  #define CMASK(P0,P1,t) do{ if(!((sel_l[r32]>>(((t)>>2)&31))&1u)){ _Pragma("unroll") for(int r_=0;r_<16;++r_){P0[r_]=NEGBIG;P1[r_]=NEGBIG;} } }while(0)
  for(;t+5<NT;t+=2){
    STEP(pB0,pB1,pA0,pA1,t,true,true,true);     WAIT_BAR(2); RESC(); ROT();
    STEP(pA0,pA1,pB0,pB1,t+1,true,true,true);   WAIT_BAR(2); RESC(); ROT();
  }
  #undef CMASK
  #define CMASK(P0,P1,t) do{int jb_=(t)-(NT-4); if(jb_>=0){cmask(P0,P1,jb_,qrel,hi);} else if(!((sel_l[r32]>>(((t)>>2)&31))&1u)){ _Pragma("unroll") for(int r_=0;r_<16;++r_){P0[r_]=NEGBIG;P1[r_]=NEGBIG;} } }while(0)
  #define ENDW(tt) do{ if((tt)+3<NT){WAIT_BAR(2);} else if((tt)+2<NT){WAIT_BAR(1);} else {WAIT_BAR(0);} }while(0)
  for(;t+1<NT;t+=2){
    STEP(pB0,pB1,pA0,pA1,t,(t+3<NT),(t+1<NT),(t+1<NT));       ENDW(t);   RESC(); ROT();
    STEP(pA0,pA1,pB0,pB1,t+1,(t+4<NT),(t+2<NT),(t+2<NT));     ENDW(t+1); RESC(); ROT();
  }
  STEP(pB0,pB1,pA0,pA1,NT-1,false,false,false); RESC();
  { float sacc=pB0[0]+pB0[1]; _Pragma("unroll") for(int r=2;r<16;++r)sacc+=pB0[r]; _Pragma("unroll") for(int r=0;r<16;++r)sacc+=pB1[r]; l_reg+=sacc;
    pw0=(u32x4){PKW(pB0,0),PKW(pB0,2),PKW(pB0,4),PKW(pB0,6)};pw1=(u32x4){PKW(pB0,8),PKW(pB0,10),PKW(pB0,12),PKW(pB0,14)};pw2=(u32x4){PKW(pB1,0),PKW(pB1,2),PKW(pB1,4),PKW(pB1,6)};pw3=(u32x4){PKW(pB1,8),PKW(pB1,10),PKW(pB1,12),PKW(pB1,14)};
    SBAR(); pv(o,vb0+sl_cur,PAF(0),PAF(1),PAF(2),PAF(3)); }
  #undef PKW
  #undef PAF
  #undef VFR
  #undef PIN
  #undef MX3
  #undef GAPA
  #undef GAPB
  #undef EX
  #undef VRD
  #undef KRD
  #undef STEP
  #undef ENDW
  {auto rr=__builtin_amdgcn_permlane32_swap(__float_as_uint(l_reg),__float_as_uint(l_reg),false,false);l_reg=__uint_as_float(rr[0])+__uint_as_float(rr[1]);}
  if(hi==0)wsf[32+r32]=l_reg;asm volatile("s_waitcnt lgkmcnt(0)":::"memory");
  float rli[16];
  #pragma unroll
  for(int r=0;r<16;++r)rli[r]=__builtin_amdgcn_rcpf(wsf[32+crow(r,hi)]);
  bf16*Ow=O+(rowbase+q0+wid*QBLK)*DM+h*D;
  { bf16*stg=(bf16*)(shm+LDS_OST)+wid*2048;
    #pragma unroll
    for(int r=0;r<16;++r){const int orow=crow(r,hi);
      #pragma unroll
      for(int d0=0;d0<2;++d0)stg[orow*64+d0*32+r32]=__float2bfloat16(o[d0][r]*rli[r]);}
    asm volatile("s_waitcnt lgkmcnt(0)":::"memory");
    #pragma unroll
    for(int i=0;i<4;++i){const int row=i*8+(lane>>3),ch=lane&7; const u32x4 v=*(const u32x4*)(stg+row*64+ch*8); ATTN_STORE16(Ow+(long)row*DM+ch*8,v);} }
  asm volatile("s_waitcnt lgkmcnt(0)\n\ts_barrier":::"memory");
  #undef DMA_K
  #undef DMA_V
  #undef CMASK
  #undef START
  #undef RESC
  #undef ROT
}
constexpr int ATTN_LDS_BYTES=LDS_BYTES;
struct AttnTensors { const bf16* Q; const bf16* K; const bf16* V; bf16* O; const unsigned* SEL; };
struct AttnUnit { int bh; int qb; };
struct StaticOrder {
  int vcu;
  __device__ __forceinline__ explicit StaticOrder(int grid,int block):vcu((block%8)*(grid/8)+block/8){}
  __device__ __forceinline__ bool next(int i,AttnUnit&u)const{ if(i>=4)return false; const int s=vcu&7; u.bh=vcu>>3; u.qb=(i==0)?s:(i==1)?15-s:(i==2)?16+s:31-s; return true; }
  __device__ __forceinline__ void a_ready(const AttnUnit&)const{}
  __device__ __forceinline__ void done(const AttnUnit&)const{}
};
template<class Sched,int THRL=8> __device__ __forceinline__ void attn_phase(char*lds,const AttnTensors&T,const Sched&S){
  AttnUnit u;
  for(int i=0;S.next(i,u);++i){ S.a_ready(u); attn_unit<THRL>(u.bh/NHEAD,u.bh%NHEAD,u.qb,T.Q,T.K,T.V,T.O,T.SEL,lds); S.done(u); }
}
#undef SBAR
#undef WAIT_BAR
}
#define LAS __attribute__((address_space(3)))
typedef unsigned short bf16;
typedef unsigned v4u __attribute__((ext_vector_type(4)));
typedef unsigned v2u __attribute__((ext_vector_type(2)));
typedef float f32x4 __attribute__((ext_vector_type(4)));
typedef short bf16x8 __attribute__((ext_vector_type(8)));
typedef short s16x4 __attribute__((ext_vector_type(4)));
constexpr int NWAVES = 8, NTHR = 512;
constexpr int SEQ = 8192, DM = 1024, M = 16384, FF = 2816, ABIN = 2560, CIN = 3072;
constexpr float C2 = 0.125f * 1.4426950408889634f;
constexpr size_t MiB = 1u << 20;
__host__ __device__ constexpr size_t ws_wgu(int f) { return (f == 0 ? 2 : f == 1 ? 13 : f == 2 ? 42 : 53) * MiB; }
__host__ __device__ constexpr size_t ws_wd(int f) { return (f == 0 ? 48 : f == 1 ? 59 : f == 2 ? 128 : 139) * (MiB / 2); }
constexpr size_t WS_WABIN = 35 * MiB, WS_WABOUT = 40 * MiB, WS_WCIN = 75 * MiB, WS_WCOUT = 81 * MiB;
constexpr size_t WS_PO2 = 2 * MiB, WS_LSE = 34 * MiB;
constexpr size_t WS_CNT = 131072;
constexpr size_t WS_LIST = 248 * MiB;
constexpr size_t WS_WSB = 83 * MiB;
constexpr size_t WS_PART = 84 * MiB;
constexpr size_t WS_KM = 85 * MiB;
constexpr size_t WS_SEL = 86 * MiB;
constexpr size_t WS_XB = 88 * MiB;
constexpr size_t WS_ACT = 120 * MiB;
constexpr size_t WS_MIX = 216 * MiB;
constexpr size_t WS_END = 256 * MiB;
constexpr int LDS_BYTES = 147456;
constexpr int MISC_OFF = 131072 + 320;
constexpr size_t WS_BAR = 65536;

__device__ __forceinline__ unsigned f2bf(float f) { unsigned u = __builtin_bit_cast(unsigned, f); return (u + 0x7fffu + ((u >> 16) & 1u)) >> 16; }
typedef float f32x2_t __attribute__((ext_vector_type(2))); typedef __bf16 bf16x2_t __attribute__((ext_vector_type(2)));
__device__ __forceinline__ unsigned pk2(float lo, float hi) { f32x2_t v = {lo, hi}; bf16x2_t b = __builtin_convertvector(v, bf16x2_t); return __builtin_bit_cast(unsigned, b); }
__device__ __forceinline__ float bf2f(unsigned short b) { return __builtin_bit_cast(float, (unsigned)b << 16); }
__device__ __forceinline__ float wave_sum(float v) {
#pragma unroll
    for (int o = 1; o < 64; o <<= 1) v += __shfl_xor(v, o);
    return v;
}
__device__ __forceinline__ float gelu_tanh(float x) {
    const float y = 0.7978845608028654f * (x + 0.044715f * x * x * x);
    return x * __builtin_amdgcn_rcpf(1.0f + __builtin_amdgcn_exp2f(-2.0f * 1.4426950408889634f * y));
}
constexpr int TP_STRIDE = 136;
__device__ __forceinline__ void p0_transpose_item(const float* W, int K, int N, bf16* WT, int mode, const float* gain, LAS unsigned char* scr, int item, int lane) {
    const int nblk = N / 64, kb = item / nblk, nb = item % nblk, k0 = 64 * kb, n0 = 64 * nb;
    const int d0 = (mode == 0) ? n0 : ((n0 >> 7) * 256 + (n0 & 127) + (mode == 2 ? 128 : 0));
    const int kr = lane >> 4, nc = (lane & 15) * 4;
    f32x4 v[16];
#pragma unroll
    for (int i = 0; i < 16; ++i) v[i] = *(const f32x4*)(W + (size_t)(k0 + 4 * i + kr) * N + n0 + nc);
#pragma unroll
    for (int i = 0; i < 16; ++i) { const float gk = gain ? gain[k0 + 4 * i + kr] : 1.0f; v2u w; w.x = pk2(v[i][0] * gk, v[i][1] * gk); w.y = pk2(v[i][2] * gk, v[i][3] * gk);
        *(LAS v2u*)(scr + (4 * i + kr) * TP_STRIDE + nc * 2) = w; }
    asm volatile("s_waitcnt lgkmcnt(0)" ::: "memory");
    const int g = lane >> 4, li = lane & 15, qq = li >> 2, pp = li & 3;
#pragma unroll
    for (int nb16 = 0; nb16 < 4; ++nb16)
#pragma unroll
        for (int half = 0; half < 2; ++half) { const int kc = g + 4 * half;
            LAS unsigned char* a = scr + (8 * kc + qq) * TP_STRIDE + (16 * nb16 + 4 * pp) * 2;
            const s16x4 lo = __builtin_bit_cast(s16x4, __builtin_amdgcn_ds_read_tr16_b64_v4i16((LAS s16x4*)a));
            const s16x4 hi = __builtin_bit_cast(s16x4, __builtin_amdgcn_ds_read_tr16_b64_v4i16((LAS s16x4*)(a + 4 * TP_STRIDE)));
            const bf16x8 o = (bf16x8){lo[0], lo[1], lo[2], lo[3], hi[0], hi[1], hi[2], hi[3]};
            *(bf16x8*)(WT + (size_t)(d0 + 16 * nb16 + li) * K + k0 + 8 * kc) = o; }
    asm volatile("s_waitcnt lgkmcnt(0)" ::: "memory");
}
#define XB_TMO      128
#define XB_XCNT(j)  (256  + 64 * (j))
#define XB_XSUB(j)  (1280 + 64 * (j))
#define XB_XGEN(j)  (2304 + 64 * (j))
#define XB_TOP      3328
#define XB_TOPGEN   3392
#define XCD_BAR_WORDS 3456
#define XB_SPIN_CAP (1u << 18)

__device__ __forceinline__ unsigned xb_ld(unsigned* p)              { return __hip_atomic_load(p, __ATOMIC_RELAXED, __HIP_MEMORY_SCOPE_AGENT); }
__device__ __forceinline__ unsigned xb_add(unsigned* p, unsigned v) { return __hip_atomic_fetch_add(p, v, __ATOMIC_RELAXED, __HIP_MEMORY_SCOPE_AGENT); }
__device__ __forceinline__ unsigned xb_xcc_id() { return (unsigned)__builtin_amdgcn_s_getreg((3 << 11) | 20) & 0xFu; }
#define XB_SPIN(cond, bar) do { unsigned _sp = 0; while (cond) { __builtin_amdgcn_s_sleep(1); \
    if ((++_sp & 255u) == 0u) { if (xb_ld(&(bar)[XB_TMO])) break; if (_sp > XB_SPIN_CAP) { atomicAdd(&(bar)[XB_TMO], 1u); break; } } } } while (0)

struct XcdBarrier {
    unsigned* bar; unsigned x;
    volatile LAS unsigned* st;
};

__device__ __forceinline__ XcdBarrier xcd_barrier_post(unsigned* bar, volatile LAS unsigned* st) {
    XcdBarrier b; b.bar = bar; b.x = xb_xcc_id(); b.st = st;
    if (threadIdx.x == 0) (void)xb_add(&bar[XB_XCNT(b.x)], 1u);
    return b;
}
__device__ __forceinline__ void xcd_barrier_complete(unsigned* bar, unsigned x, unsigned& nloc, unsigned& nx) {
    const unsigned G = gridDim.x * gridDim.y * gridDim.z;
    unsigned sum, cnt, mine, sp = 0u;
    for (;;) {
        sum = 0u; cnt = 0u; mine = 0u;
#pragma unroll
        for (unsigned j = 0; j < 16; ++j) { const unsigned c = xb_ld(&bar[XB_XCNT(j)]); sum += c; cnt += (c > 0u) ? 1u : 0u; mine = (j == x) ? c : mine; }
        if (sum == G) break;
        __builtin_amdgcn_s_sleep(1);
        if ((++sp & 255u) == 0u) { if (xb_ld(&bar[XB_TMO])) break; if (sp > XB_SPIN_CAP) { atomicAdd(&bar[XB_TMO], 1u); break; } }
    }
    nloc = mine > 0u ? mine : 1u; nx = cnt > 0u ? cnt : 1u;
}

__device__ __forceinline__ void xcd_barrier(const XcdBarrier& b) {
    asm volatile("s_waitcnt vmcnt(0)" ::: "memory");
    __syncthreads();
    if (threadIdx.x == 0) {
        unsigned* bar = b.bar;
        __builtin_amdgcn_s_waitcnt(0);
        unsigned nloc = b.st[0], nx = b.st[1];
        if (nloc == 0u) { xcd_barrier_complete(bar, b.x, nloc, nx); b.st[0] = nloc; b.st[1] = nx; }
        const unsigned old = xb_add(&bar[XB_XSUB(b.x)], 1u);
        const unsigned gen = old / nloc;
        if (old + 1u == (gen + 1u) * nloc) {
            __builtin_amdgcn_fence(__ATOMIC_RELEASE, "agent");
            asm volatile("s_waitcnt vmcnt(0)" ::: "memory");
            const unsigned og = xb_add(&bar[XB_TOP], 1u);
            const unsigned tg = og / nx;
            if (og + 1u == (tg + 1u) * nx) xb_add(&bar[XB_TOPGEN], 1u);
            else XB_SPIN(xb_ld(&bar[XB_TOPGEN]) == tg, bar);
            __builtin_amdgcn_fence(__ATOMIC_ACQUIRE, "agent");
            xb_add(&bar[XB_XGEN(b.x)], 1u);
            asm volatile("s_waitcnt vmcnt(0)" ::: "memory");
        } else {
            XB_SPIN(xb_ld(&bar[XB_XGEN(b.x)]) == gen, bar);
            __builtin_amdgcn_fence(__ATOMIC_ACQUIRE, "agent");
            asm volatile("s_waitcnt vmcnt(0)" ::: "memory");
        }
    }
    __syncthreads();
}

struct EpiResidNorm {
    static constexpr bool PERM = true, AFTER_DRAIN = true;
    const bf16* basexb; float* out; float* part; const float* gfin; float alpha; XcdBarrier xb;
    __device__ __forceinline__ void fused(pg8::f32x4 (&acc)[2][2][4][2], const pg8::Unit& u, int wr, int wc, int fr, int fq, LAS unsigned char* lds, int wid, int lane) const {
        const int row0 = u.pm * pg8::BM + wr * 64 + fr; const int col0 = u.pn * pg8::BM + wc * 32 + 8 * fq;
#pragma unroll
        for (int ai = 0; ai < 2; ++ai)
#pragma unroll
            for (int m = 0; m < 4; ++m) { const int row = row0 + ai * pg8::HALF + m * 16; float ss = 0.f;
#pragma unroll
                for (int bj = 0; bj < 2; ++bj) { const size_t off = (size_t)row * 1024 + col0 + bj * pg8::HALF;
                    const v4u r = *(const v4u*)(basexb + off);
                    const pg8::f32x4 b0 = (pg8::f32x4){__builtin_bit_cast(float, r.x << 16), __builtin_bit_cast(float, r.x & 0xffff0000u), __builtin_bit_cast(float, r.y << 16), __builtin_bit_cast(float, r.y & 0xffff0000u)};
                    const pg8::f32x4 b1 = (pg8::f32x4){__builtin_bit_cast(float, r.z << 16), __builtin_bit_cast(float, r.z & 0xffff0000u), __builtin_bit_cast(float, r.w << 16), __builtin_bit_cast(float, r.w & 0xffff0000u)};
                    const pg8::f32x4 v0 = b0 + acc[ai][bj][m][0] * alpha, v1 = b1 + acc[ai][bj][m][1] * alpha;
                    acc[ai][bj][m][0] = v0; acc[ai][bj][m][1] = v1;
                    ss += ((v0[0] * v0[0] + v0[1] * v0[1]) + (v0[2] * v0[2] + v0[3] * v0[3])) + ((v1[0] * v1[0] + v1[1] * v1[1]) + (v1[2] * v1[2] + v1[3] * v1[3])); }
                ss += __shfl_xor(ss, 16); ss += __shfl_xor(ss, 32);
                if (fq == 0) part[(size_t)row * 16 + u.pn * 4 + wc] = ss; }
        xcd_barrier(xb);
#pragma unroll
        for (int ai = 0; ai < 2; ++ai)
#pragma unroll
            for (int m = 0; m < 4; ++m) { const int row = row0 + ai * pg8::HALF + m * 16; const float rs = pg8::row_rstd(part, row);
#pragma unroll
                for (int bj = 0; bj < 2; ++bj) { const size_t off = (size_t)row * 1024 + col0 + bj * pg8::HALF;
                    const pg8::f32x4 g0 = *(const pg8::f32x4*)(gfin + col0 + bj * pg8::HALF), g1 = *(const pg8::f32x4*)(gfin + col0 + bj * pg8::HALF + 4);
                    *(pg8::f32x4*)(out + off) = acc[ai][bj][m][0] * rs * g0; *(pg8::f32x4*)(out + off + 4) = acc[ai][bj][m][1] * rs * g1; } }
    }
};
constexpr int RSTD_OFF = 131072 + 1024;
__device__ __forceinline__ void rstd_table(const float* part, LAS unsigned char* lds, const pg8::StaticOrder& S) {
    LAS float* T = (LAS float*)(lds + RSTD_OFF);
    const int tid = threadIdx.x;
#pragma unroll
    for (int pass = 0; pass < 3; ++pass) { const int i = 2 * pass + (tid >> 8); pg8::Unit u; if (S.next(i, u)) T[i * 256 + (tid & 255)] = pg8::row_rstd(part, u.pm * 256 + (tid & 255)); }
    __syncthreads();
}
struct Args { const float* in[18]; float* out; unsigned char* ws; int ph_lo, ph_hi; };

constexpr int I_G = (DM / 64) * (FF / 64), I_D = (FF / 64) * (DM / 64), I_ABIN = (DM / 64) * (ABIN / 64), I_SQ = (DM / 64) * (DM / 64), I_CIN = (DM / 64) * (CIN / 64);
__device__ __forceinline__ constexpr int mat_items(int id) { return id < 0 ? 0 : id < 4 ? 2 * I_G : id < 8 ? I_D : id == 8 ? I_ABIN : id == 10 ? I_CIN : I_SQ; }
__device__ __forceinline__ void conv_item(const Args& A, LAS unsigned char* scr, int lane, int id, int r) {
    unsigned char* ws = A.ws;
    if (id < 4) { const int f = id, layer = f >> 1, second = f & 1; const float* gain = A.in[second ? 6 : 1] + layer * DM; bf16* wgu = (bf16*)(ws + ws_wgu(f));
        if (r < I_G) p0_transpose_item(A.in[second ? 7 : 2] + (size_t)layer * DM * FF, DM, FF, wgu, 1, gain, scr, r, lane);
        else p0_transpose_item(A.in[second ? 8 : 3] + (size_t)layer * DM * FF, DM, FF, wgu, 2, gain, scr, r - I_G, lane); }
    else if (id < 8) { const int f = id - 4, layer = f >> 1, second = f & 1; p0_transpose_item(A.in[second ? 9 : 4] + (size_t)layer * FF * DM, FF, DM, (bf16*)(ws + ws_wd(f)), 0, nullptr, scr, r, lane); }
    else if (id == 8) p0_transpose_item(A.in[10], DM, ABIN, (bf16*)(ws + WS_WABIN), 0, A.in[5], scr, r, lane);
    else if (id == 9) p0_transpose_item(A.in[14], DM, DM, (bf16*)(ws + WS_WABOUT), 0, nullptr, scr, r, lane);
    else if (id == 10) p0_transpose_item(A.in[15], DM, CIN, (bf16*)(ws + WS_WCIN), 0, A.in[5] + DM, scr, r, lane);
    else p0_transpose_item(A.in[16], DM, DM, (bf16*)(ws + WS_WCOUT), 0, nullptr, scr, r, lane);
}
__device__ __forceinline__ void conv_set(const Args& A, LAS unsigned char* lds, int wave, int lane, int gw, int NGW, int id0, int id1, int id2) {
    LAS unsigned char* scr = lds + wave * 16384;
    const int n0 = mat_items(id0), n1 = mat_items(id1), n2 = mat_items(id2);
    for (int it = gw; it < n0 + n1 + n2; it += NGW) {
        if (it < n0) conv_item(A, scr, lane, id0, it); else if (it < n0 + n1) conv_item(A, scr, lane, id1, it - n0); else conv_item(A, scr, lane, id2, it - n0 - n1); }
}
__device__ __forceinline__ void conv_idle(const Args& A, LAS unsigned char* lds, int id0, int id1, int id2) {
    if (blockIdx.x >= 128) { const int tid_ = threadIdx.x; conv_set(A, lds, __builtin_amdgcn_readfirstlane(tid_ >> 6), tid_ & 63, ((int)blockIdx.x - 128) * NWAVES + (tid_ >> 6), ((int)gridDim.x - 128) * NWAVES, id0, id1, id2); }
}
__device__ __forceinline__ void phase_prologue(const Args& A, LAS unsigned char* lds, int wave, int lane) {
    const int gw = blockIdx.x * NWAVES + wave, NGW = gridDim.x * NWAVES;
    unsigned char* ws = A.ws;
    conv_set(A, lds, wave, lane, gw, NGW, 0, 4, 3);
    { const float* wsp = A.in[12]; bf16* o = (bf16*)(ws + WS_WSB);
      for (int i = blockIdx.x * NTHR + threadIdx.x; i < 4 * 128 * 128; i += gridDim.x * NTHR) { const int p = (i >> 7) & 127, q = i & 127; o[i] = (bf16)f2bf(q <= p ? wsp[i] : 0.f); } }
    const float* x = A.in[0]; bf16* xb = (bf16*)(ws + WS_XB); float* part = (float*)(ws + WS_PART);
    for (int m = gw; m < M; m += NGW) {
        const f32x4* xr = (const f32x4*)(x + (size_t)m * DM) + lane; f32x4 v[4]; float s = 0.f;
#pragma unroll
        for (int j = 0; j < 4; ++j) { v[j] = xr[64 * j]; s += (v[j][0] * v[j][0] + v[j][1] * v[j][1]) + (v[j][2] * v[j][2] + v[j][3] * v[j][3]); }
        s = wave_sum(s);
        v2u* o8 = (v2u*)(xb + (size_t)m * DM) + lane;
#pragma unroll
        for (int j = 0; j < 4; ++j) { v2u w; w.x = pk2(v[j][0], v[j][1]); w.y = pk2(v[j][2], v[j][3]); o8[64 * j] = w; }
        if (lane < 16) part[(size_t)m * 16 + lane] = (lane == 0) ? s : 0.f;
    }
}

constexpr int GV_STRIDE = 272;
__device__ __forceinline__ void gate_unit(const Args& A, LAS unsigned char* lds, int unit, int wave, int lane) {
    const int g4 = unit & 3, n = (unit >> 2) & 63, b = unit >> 8;
    const size_t R0 = (size_t)b * SEQ + (size_t)n * 128;
    const bf16* Z = (const bf16*)(A.ws + WS_ACT); bf16* MIX = (bf16*)(A.ws + WS_MIX); const bf16* WsB = (const bf16*)(A.ws + WS_WSB) + (size_t)g4 * 128 * 128;
    const float* vnorm = A.in[11] + g4 * 128; const float* bsp = A.in[13] + g4 * 128;
    const int tid = threadIdx.x;
    { const int row = tid >> 2, qt = tid & 3; const bf16* vp = Z + (R0 + row) * ABIN + 2048 + 128 * g4 + 32 * qt;
      float v[32]; float ss = 0.f;
#pragma unroll
      for (int i = 0; i < 4; ++i) { const bf16x8 raw = *(const bf16x8*)(vp + 8 * i);
#pragma unroll
          for (int e = 0; e < 8; ++e) { const float gl = gelu_tanh(bf2f((unsigned short)raw[e])); v[8 * i + e] = gl; ss += gl * gl; } }
      ss += __shfl_xor(ss, 1); ss += __shfl_xor(ss, 2);
      const float rs = rsqrtf(ss * (1.0f / 128.0f) + 1e-6f);
#pragma unroll
      for (int i = 0; i < 4; ++i) { const f32x4 g0 = *(const f32x4*)(vnorm + 32 * qt + 8 * i), g1 = *(const f32x4*)(vnorm + 32 * qt + 8 * i + 4);
          v4u w; w.x = pk2(v[8 * i] * rs * g0[0], v[8 * i + 1] * rs * g0[1]); w.y = pk2(v[8 * i + 2] * rs * g0[2], v[8 * i + 3] * rs * g0[3]);
          w.z = pk2(v[8 * i + 4] * rs * g1[0], v[8 * i + 5] * rs * g1[1]); w.w = pk2(v[8 * i + 6] * rs * g1[2], v[8 * i + 7] * rs * g1[3]);
          *(LAS v4u*)(lds + row * GV_STRIDE + qt * 64 + i * 16) = w; } }
    __syncthreads();
    const int pl = lane & 15, g = lane >> 4, qq = pl >> 2, pp = pl & 3;
    f32x4 acc[8];
#pragma unroll
    for (int cb = 0; cb < 8; ++cb) acc[cb] = (f32x4){0.f, 0.f, 0.f, 0.f};
    const int nks = (16 * wave + 15) / 32 + 1;
    for (int ks = 0; ks < nks; ++ks) {
        const bf16x8 bfrag = *(const bf16x8*)(WsB + (size_t)(16 * wave + pl) * 128 + 32 * ks + 8 * g);
        LAS unsigned char* base = lds + (32 * ks + 8 * g + qq) * GV_STRIDE + pp * 8;
#pragma unroll
        for (int cb = 0; cb < 8; ++cb) {
            const s16x4 lo = __builtin_bit_cast(s16x4, __builtin_amdgcn_ds_read_tr16_b64_v4i16((LAS s16x4*)(base + cb * 32)));
            const s16x4 hi = __builtin_bit_cast(s16x4, __builtin_amdgcn_ds_read_tr16_b64_v4i16((LAS s16x4*)(base + cb * 32 + 4 * GV_STRIDE)));
            const bf16x8 afrag = (bf16x8){lo[0], lo[1], lo[2], lo[3], hi[0], hi[1], hi[2], hi[3]};
            acc[cb] = __builtin_amdgcn_mfma_f32_16x16x32_bf16(afrag, bfrag, acc[cb], 0, 0, 0);
        }
    }
    { const int p = 16 * wave + pl; const float bias = bsp[p];
      const bf16* up = Z + (R0 + p) * ABIN + 1536 + 128 * g4 + 4 * g; bf16* op = MIX + (R0 + p) * DM + 512 + 128 * g4 + 4 * g;
#pragma unroll
      for (int cb = 0; cb < 8; ++cb) { const s16x4 ur = *(const s16x4*)(up + 16 * cb);
          v2u w; w.x = pk2(gelu_tanh(bf2f((unsigned short)ur[0])) * (acc[cb][0] + bias), gelu_tanh(bf2f((unsigned short)ur[1])) * (acc[cb][1] + bias));
          w.y = pk2(gelu_tanh(bf2f((unsigned short)ur[2])) * (acc[cb][2] + bias), gelu_tanh(bf2f((unsigned short)ur[3])) * (acc[cb][3] + bias));
          *(v2u*)(op + 16 * cb) = w; } }
    __syncthreads();
}

constexpr int DV_STRIDE = 160, DV_BUF = 32 * DV_STRIDE;
__device__ __forceinline__ void dil_unit(const Args& A, LAS unsigned char* vl, int unit, int lane) {
    const int r16 = unit & 15, sp = (unit >> 4) & 31, h = (unit >> 9) & 7, b = unit >> 12;
    const bf16* Z = (const bf16*)(A.ws + WS_ACT); bf16* MIX = (bf16*)(A.ws + WS_MIX);
    const int qi = lane & 15, g = lane >> 4, T0 = sp * 256;
    const size_t rowb = (size_t)b * SEQ;
    const int tq = T0 + r16 + 16 * qi;
    const bf16* qp = Z + (rowb + tq) * ABIN + h * 64 + 8 * g;
    const bf16x8 qf0 = *(const bf16x8*)qp, qf1 = *(const bf16x8*)(qp + 32);
    const bf16* Kb = Z + rowb * ABIN + 512 + h * 64 + 8 * g;
    const bf16* Vb = Z + rowb * ABIN + 1024 + h * 64 + 8 * (lane & 7);
    float mrun = -INFINITY, lrun = 0.f; f32x4 o[4];
#pragma unroll
    for (int d = 0; d < 4; ++d) o[d] = (f32x4){0.f, 0.f, 0.f, 0.f};
    const int tb = T0 + r16;
    constexpr int DIL_D = 3;
    bf16x8 kn[DIL_D][4], vn[DIL_D][4];
#define DIL_PARAMS(it, dsh, j) const int dsh = ((it) < 12) ? 0 : ((it) < 18) ? 2 : 4; const int j = (it) - (((it) < 12) ? 0 : ((it) < 18) ? 12 : 18);
#define DIL_LOAD(it, S) do { DIL_PARAMS(it, dsh_, j_) const int c_ = tb & ((1 << dsh_) - 1), skb_ = (tb >> dsh_) - 128 + 32 * j_; \
        _Pragma("unroll") for (int s_ = 0; s_ < 2; ++s_) { int t_ = c_ + ((skb_ + 16 * s_ + qi) << dsh_); t_ = t_ < 0 ? 0 : (t_ > SEQ - 1 ? SEQ - 1 : t_); \
            kn[S][2 * s_] = *(const bf16x8*)(Kb + (size_t)t_ * ABIN); kn[S][2 * s_ + 1] = *(const bf16x8*)(Kb + (size_t)t_ * ABIN + 32); } \
        _Pragma("unroll") for (int i_ = 0; i_ < 4; ++i_) { int t_ = c_ + ((skb_ + (lane >> 3) + 8 * i_) << dsh_); t_ = t_ < 0 ? 0 : (t_ > SEQ - 1 ? SEQ - 1 : t_); \
            vn[S][i_] = *(const bf16x8*)(Vb + (size_t)t_ * ABIN); } } while (0)
#pragma unroll
    for (int p = 0; p < DIL_D; ++p) DIL_LOAD(p, p);
#pragma nounroll
    for (int it0 = 0; it0 < 24; it0 += DIL_D) {
#pragma unroll
      for (int S = 0; S < DIL_D; ++S) { const int it = it0 + S; if (it < 23) {
        LAS unsigned char* buf = vl + (it & 1) * DV_BUF;
        const bf16x8 k0 = kn[S][0], k1 = kn[S][1], k2 = kn[S][2], k3 = kn[S][3];
#pragma unroll
        for (int i = 0; i < 4; ++i) *(LAS bf16x8*)(buf + ((lane >> 3) + 8 * i) * DV_STRIDE + (lane & 7) * 16) = vn[S][i];
        if (it + DIL_D < 23) DIL_LOAD(it + DIL_D, S);
        DIL_PARAMS(it, dsh, j)
        const int skb = (tb >> dsh) - 128 + 32 * j, sq = (tb >> dsh) + ((16 >> dsh) * qi);
        f32x4 sa = (f32x4){0.f, 0.f, 0.f, 0.f}, sb = (f32x4){0.f, 0.f, 0.f, 0.f};
        sa = __builtin_amdgcn_mfma_f32_16x16x32_bf16(k0, qf0, sa, 0, 0, 0); sa = __builtin_amdgcn_mfma_f32_16x16x32_bf16(k1, qf1, sa, 0, 0, 0);
        sb = __builtin_amdgcn_mfma_f32_16x16x32_bf16(k2, qf0, sb, 0, 0, 0); sb = __builtin_amdgcn_mfma_f32_16x16x32_bf16(k3, qf1, sb, 0, 0, 0);
        float mx = -INFINITY;
#pragma unroll
        for (int e = 0; e < 4; ++e) { const int ska = skb + 4 * g + e, skq = ska + 16;
            const bool va = (ska >= 0) && (ska <= sq) && (sq - ska <= 128), vb = (skq >= 0) && (skq <= sq) && (sq - skq <= 128);
            sa[e] = va ? sa[e] : -INFINITY; sb[e] = vb ? sb[e] : -INFINITY; mx = fmaxf(mx, fmaxf(sa[e], sb[e])); }
        mx = fmaxf(mx, __shfl_xor(mx, 16)); mx = fmaxf(mx, __shfl_xor(mx, 32));
        const float mnew = fmaxf(mrun, mx), muse = (mnew == -INFINITY) ? 0.f : mnew;
        const float alpha = __builtin_amdgcn_exp2f(mrun - muse);
        float ps = 0.f; float pa[4], pb[4];
#pragma unroll
        for (int e = 0; e < 4; ++e) { pa[e] = __builtin_amdgcn_exp2f(sa[e] - muse); pb[e] = __builtin_amdgcn_exp2f(sb[e] - muse); ps += pa[e] + pb[e]; }
        lrun = lrun * alpha + ps; mrun = mnew;
        v4u pw; pw.x = pk2(pa[0], pa[1]); pw.y = pk2(pa[2], pa[3]); pw.z = pk2(pb[0], pb[1]); pw.w = pk2(pb[2], pb[3]);
        const bf16x8 pf = __builtin_bit_cast(bf16x8, pw);
        asm volatile("s_waitcnt lgkmcnt(0)" ::: "memory");
        LAS unsigned char* rb = buf + (4 * g + (qi >> 2)) * DV_STRIDE + (qi & 3) * 8;
#pragma unroll
        for (int db = 0; db < 4; ++db) {
            const s16x4 lo = __builtin_bit_cast(s16x4, __builtin_amdgcn_ds_read_tr16_b64_v4i16((LAS s16x4*)(rb + db * 32)));
            const s16x4 hi = __builtin_bit_cast(s16x4, __builtin_amdgcn_ds_read_tr16_b64_v4i16((LAS s16x4*)(rb + db * 32 + 16 * DV_STRIDE)));
            const bf16x8 vf = (bf16x8){lo[0], lo[1], lo[2], lo[3], hi[0], hi[1], hi[2], hi[3]};
            o[db] = o[db] * alpha;
            o[db] = __builtin_amdgcn_mfma_f32_16x16x32_bf16(vf, pf, o[db], 0, 0, 0);
        }
    } } }
#undef DIL_LOAD
#undef DIL_PARAMS
    lrun += __shfl_xor(lrun, 16); lrun += __shfl_xor(lrun, 32);
    const float inv = 1.0f / lrun;
    bf16* op = MIX + (rowb + tq) * DM + h * 64 + 4 * g;
#pragma unroll
    for (int db = 0; db < 4; ++db) { v2u w; w.x = pk2(o[db][0] * inv, o[db][1] * inv); w.y = pk2(o[db][2] * inv, o[db][3] * inv); *(v2u*)(op + 16 * db) = w; }
}

constexpr int DS_OFF = 16 * DV_BUF, DS_STRIDE = 144;
__device__ __forceinline__ void dil_wg_unit(const Args& A, LAS unsigned char* lds, int unit, int wave, int lane) {
    const int sp = unit & 31, h = (unit >> 5) & 7, b = unit >> 8;
    const bf16* Z = (const bf16*)(A.ws + WS_ACT); bf16* MIX = (bf16*)(A.ws + WS_MIX);
    const int qi = lane & 15, g = lane >> 4, T0 = sp * 256;
    const size_t rowb = (size_t)b * SEQ;
    const bf16* Kb = Z + rowb * ABIN + 512 + h * 64 + 8 * g;
    const bf16* Vb = Z + rowb * ABIN + 1024 + h * 64 + 8 * (lane & 7);
    LAS unsigned char* ST = lds + DS_OFF;
#pragma unroll 1
    for (int stage = 0; stage < 3; ++stage) {
        const int dsh = 4 - 2 * stage;
        int tbg[2]; bf16x8 qf[2][2]; float mrun[2], lrun[2]; f32x4 o[2][4];
#pragma unroll
        for (int k = 0; k < 2; ++k) { const int G = 2 * wave + k; tbg[k] = T0 + (stage == 0 ? G : stage == 1 ? 64 * (G >> 2) + (G & 3) : 16 * G);
            const bf16* qp = Z + (rowb + tbg[k] + (qi << dsh)) * ABIN + h * 64 + 8 * g; qf[k][0] = *(const bf16x8*)qp; qf[k][1] = *(const bf16x8*)(qp + 32); }
        bf16x8 kn[2][4], vn[2][4];
#define DW_LOAD(jt_) do { _Pragma("unroll") for (int k_ = 0; k_ < 2; ++k_) { const int c_ = tbg[k_] & ((1 << dsh) - 1), skb_ = (tbg[k_] >> dsh) - 128 + 32 * (jt_); \
        _Pragma("unroll") for (int i_ = 0; i_ < 4; ++i_) { int t_ = c_ + ((skb_ + (lane >> 3) + 8 * i_) << dsh); t_ = t_ < 0 ? 0 : (t_ > SEQ - 1 ? SEQ - 1 : t_); \
            kn[k_][i_] = *(const bf16x8*)(Vb + (size_t)t_ * ABIN - 512); vn[k_][i_] = *(const bf16x8*)(Vb + (size_t)t_ * ABIN); } } } while (0)
        DW_LOAD(0);
#pragma unroll
        for (int k = 0; k < 2; ++k) { LAS unsigned char* sq_p = ST + (tbg[k] + (qi << dsh) - T0) * DS_STRIDE;
            if (stage == 0) { mrun[k] = -INFINITY; lrun[k] = 0.f;
#pragma unroll
                for (int d = 0; d < 4; ++d) o[k][d] = (f32x4){0.f, 0.f, 0.f, 0.f}; }
            else { mrun[k] = *(LAS float*)(sq_p + 128); lrun[k] = (g == 0) ? *(LAS float*)(sq_p + 132) : 0.f;
#pragma unroll
                for (int d = 0; d < 4; ++d) { const s16x4 r = *(LAS s16x4*)(sq_p + (16 * d + 4 * g) * 2); o[k][d] = (f32x4){bf2f((unsigned short)r[0]), bf2f((unsigned short)r[1]), bf2f((unsigned short)r[2]), bf2f((unsigned short)r[3])}; } } }
#pragma nounroll
        for (int jt = 0; jt < 5; ++jt) {
            bf16x8 kc[2][4], vc[2][4];
#pragma unroll
            for (int k = 0; k < 2; ++k) { LAS unsigned char* vbuf = lds + (wave * 2 + k) * DV_BUF;
#pragma unroll
                for (int i = 0; i < 4; ++i) { vc[k][i] = vn[k][i]; *(LAS bf16x8*)(vbuf + ((lane >> 3) + 8 * i) * DV_STRIDE + (lane & 7) * 16) = kn[k][i]; } }
            if (jt + 1 < 5) DW_LOAD(jt + 1);
            asm volatile("s_waitcnt lgkmcnt(0)" ::: "memory");
#pragma unroll
            for (int k = 0; k < 2; ++k) { LAS unsigned char* kb_ = lds + (wave * 2 + k) * DV_BUF + qi * DV_STRIDE + 16 * g;
                kc[k][0] = *(LAS bf16x8*)(kb_); kc[k][1] = *(LAS bf16x8*)(kb_ + 64); kc[k][2] = *(LAS bf16x8*)(kb_ + 16 * DV_STRIDE); kc[k][3] = *(LAS bf16x8*)(kb_ + 16 * DV_STRIDE + 64); }
            asm volatile("s_waitcnt lgkmcnt(0)" ::: "memory");
#pragma unroll
            for (int k = 0; k < 2; ++k) { LAS unsigned char* vbuf = lds + (wave * 2 + k) * DV_BUF;
#pragma unroll
                for (int i = 0; i < 4; ++i) *(LAS bf16x8*)(vbuf + ((lane >> 3) + 8 * i) * DV_STRIDE + (lane & 7) * 16) = vc[k][i]; }
            f32x4 sa[2], sb[2]; float alpha[2]; bf16x8 pf[2];
#pragma unroll
            for (int k = 0; k < 2; ++k) {
                sa[k] = (f32x4){0.f, 0.f, 0.f, 0.f}; sb[k] = sa[k];
                sa[k] = __builtin_amdgcn_mfma_f32_16x16x32_bf16(kc[k][0], qf[k][0], sa[k], 0, 0, 0); sa[k] = __builtin_amdgcn_mfma_f32_16x16x32_bf16(kc[k][1], qf[k][1], sa[k], 0, 0, 0);
                sb[k] = __builtin_amdgcn_mfma_f32_16x16x32_bf16(kc[k][2], qf[k][0], sb[k], 0, 0, 0); sb[k] = __builtin_amdgcn_mfma_f32_16x16x32_bf16(kc[k][3], qf[k][1], sb[k], 0, 0, 0); }
#pragma unroll
            for (int k = 0; k < 2; ++k) {
                const int skb = (tbg[k] >> dsh) - 128 + 32 * jt, sq = (tbg[k] >> dsh) + qi;
                float mx = -INFINITY;
#pragma unroll
                for (int e = 0; e < 4; ++e) { const int ska = skb + 4 * g + e, skq = ska + 16;
                    const bool va = (ska >= 0) && (ska <= sq) && (sq - ska <= 128), vb = (skq >= 0) && (skq <= sq) && (sq - skq <= 128);
                    sa[k][e] = va ? sa[k][e] : -INFINITY; sb[k][e] = vb ? sb[k][e] : -INFINITY; mx = fmaxf(mx, fmaxf(sa[k][e], sb[k][e])); }
                mx = fmaxf(mx, __shfl_xor(mx, 16)); mx = fmaxf(mx, __shfl_xor(mx, 32));
                const float mnew = fmaxf(mrun[k], mx), muse = (mnew == -INFINITY) ? 0.f : mnew;
                alpha[k] = __builtin_amdgcn_exp2f(mrun[k] - muse);
                float ps = 0.f; float pa[4], pb[4];
#pragma unroll
                for (int e = 0; e < 4; ++e) { pa[e] = __builtin_amdgcn_exp2f(sa[k][e] - muse); pb[e] = __builtin_amdgcn_exp2f(sb[k][e] - muse); ps += pa[e] + pb[e]; }
                lrun[k] = lrun[k] * alpha[k] + ps; mrun[k] = mnew;
                v4u pw; pw.x = pk2(pa[0], pa[1]); pw.y = pk2(pa[2], pa[3]); pw.z = pk2(pb[0], pb[1]); pw.w = pk2(pb[2], pb[3]);
                pf[k] = __builtin_bit_cast(bf16x8, pw); }
            asm volatile("s_waitcnt lgkmcnt(0)" ::: "memory");
#pragma unroll
            for (int k = 0; k < 2; ++k) { LAS unsigned char* rb = lds + (wave * 2 + k) * DV_BUF + (4 * g + (qi >> 2)) * DV_STRIDE + (qi & 3) * 8;
#pragma unroll
                for (int db = 0; db < 4; ++db) {
                    const s16x4 lo = __builtin_bit_cast(s16x4, __builtin_amdgcn_ds_read_tr16_b64_v4i16((LAS s16x4*)(rb + db * 32)));
                    const s16x4 hi = __builtin_bit_cast(s16x4, __builtin_amdgcn_ds_read_tr16_b64_v4i16((LAS s16x4*)(rb + db * 32 + 16 * DV_STRIDE)));
                    const bf16x8 vf = (bf16x8){lo[0], lo[1], lo[2], lo[3], hi[0], hi[1], hi[2], hi[3]};
                    o[k][db] = o[k][db] * alpha[k];
                    o[k][db] = __builtin_amdgcn_mfma_f32_16x16x32_bf16(vf, pf[k], o[k][db], 0, 0, 0);
                } }
            asm volatile("s_waitcnt lgkmcnt(0)" ::: "memory");
        }
#undef DW_LOAD
#pragma unroll
        for (int k = 0; k < 2; ++k) { const int qpos = tbg[k] + (qi << dsh) - T0; LAS unsigned char* sq_p = ST + qpos * DS_STRIDE;
            float lt = lrun[k]; lt += __shfl_xor(lt, 16); lt += __shfl_xor(lt, 32);
            if (stage < 2) {
#pragma unroll
                for (int d = 0; d < 4; ++d) { v2u w; w.x = pk2(o[k][d][0], o[k][d][1]); w.y = pk2(o[k][d][2], o[k][d][3]); *(LAS v2u*)(sq_p + (16 * d + 4 * g) * 2) = w; }
                if (g == 0) { *(LAS float*)(sq_p + 128) = mrun[k]; *(LAS float*)(sq_p + 132) = lt; }
            } else {
                const float inv = 1.0f / lt;
                bf16* op = MIX + (rowb + T0 + qpos) * DM + h * 64 + 4 * g;
#pragma unroll
                for (int db = 0; db < 4; ++db) { v2u w; w.x = pk2(o[k][db][0] * inv, o[k][db][1] * inv); w.y = pk2(o[k][db][2] * inv, o[k][db][3] * inv); *(v2u*)(op + 16 * db) = w; }
            } }
        __syncthreads();
    }
}
__device__ __forceinline__ void select_phase(const Args& A, LAS unsigned char* lds, int wave, int lane) {
    LAS unsigned* lcnt = (LAS unsigned*)lds; LAS unsigned* lbase = lcnt + 32;
    const int tid = threadIdx.x;
    for (int k = 0; k < 2; ++k) {
        const int U = blockIdx.x + 256 * k, bh = (U >> 4) & 31, c16 = k ? 15 - (U & 15) : (U & 15), b = bh >> 4, h = bh & 15;
        const int ch = c16 * 8 + wave, t = ch * 64 + lane, own = ch >> 2;
        if (tid < 32) lcnt[tid] = 0u;
        __syncthreads();
        unsigned mask = 0u; int i1 = -1, i2 = -1, i3 = -1;
        if (own > 0) {
            const bf16* qp = (const bf16*)(A.ws + WS_ACT) + ((size_t)b * SEQ + t) * DM + h * 64;
            float q[64];
#pragma unroll
            for (int i = 0; i < 8; ++i) { const bf16x8 raw = *(const bf16x8*)(qp + 8 * i);
#pragma unroll
                for (int e = 0; e < 8; ++e) q[8 * i + e] = bf2f((unsigned short)raw[e]); }
            const float* km = (const float*)(A.ws + WS_KM) + (size_t)(b * 32) * 2048 + h * 64 + lane;
            float v1 = -INFINITY, v2 = -INFINITY, v3 = -INFINITY;
            for (int j0 = 0; j0 < own; j0 += 4) {
                float kmv[4];
#pragma unroll
                for (int u = 0; u < 4; ++u) { const int jj = (j0 + u < own) ? j0 + u : own - 1; kmv[u] = km[(size_t)jj * 2048] + km[(size_t)jj * 2048 + 1024]; }
#pragma unroll
                for (int u = 0; u < 4; ++u) { const int j = j0 + u;
                    float s = 0.f;
#pragma unroll
                    for (int d = 0; d < 64; ++d) s += q[d] * __builtin_bit_cast(float, __builtin_amdgcn_readlane(__builtin_bit_cast(int, kmv[u]), d));
                    if (j < own) {
                        if (s > v1) { v3 = v2; i3 = i2; v2 = v1; i2 = i1; v1 = s; i1 = j; }
                        else if (s > v2) { v3 = v2; i3 = i2; v2 = s; i2 = j; }
                        else if (s > v3) { v3 = s; i3 = j; } } }
            }
            if (i1 >= 0) mask |= 1u << i1; if (i2 >= 0) mask |= 1u << i2; if (i3 >= 0) mask |= 1u << i3;
        }
        unsigned p1 = 0, p2 = 0, p3 = 0;
        if (i1 >= 0) p1 = atomicAdd((unsigned*)(lcnt + i1), 1u);
        if (i2 >= 0) p2 = atomicAdd((unsigned*)(lcnt + i2), 1u);
        if (i3 >= 0) p3 = atomicAdd((unsigned*)(lcnt + i3), 1u);
        __syncthreads();
        if (tid < 32) { const unsigned n = lcnt[tid]; lbase[tid] = n ? atomicAdd((unsigned*)(A.ws + WS_CNT) + bh * 32 + tid, n) : 0u; }
        __syncthreads();
        unsigned short* list = (unsigned short*)(A.ws + WS_LIST) + (size_t)bh * 126976;
        if (i1 >= 0) list[256 * (31 * i1 - (i1 * (i1 - 1)) / 2) + lbase[i1] + p1] = (unsigned short)(t | (__popc(mask & ((1u << i1) - 1u)) << 13));
        if (i2 >= 0) list[256 * (31 * i2 - (i2 * (i2 - 1)) / 2) + lbase[i2] + p2] = (unsigned short)(t | (__popc(mask & ((1u << i2) - 1u)) << 13));
        if (i3 >= 0) list[256 * (31 * i3 - (i3 * (i3 - 1)) / 2) + lbase[i3] + p3] = (unsigned short)(t | (__popc(mask & ((1u << i3) - 1u)) << 13));
        ((unsigned*)(A.ws + WS_SEL))[(size_t)bh * SEQ + t] = mask;
        __syncthreads();
    }
}
constexpr int MB_VIRT = 0;
constexpr int MK_STRIDE = 144, MV_STRIDE = 160, MK_OFF = 0, MV_OFF = 256 * MK_STRIDE, MB_CTL = 81920;
__device__ __forceinline__ void moba_stage_load(const Args& A, int bh, int j, bf16x8 (&kk)[4], bf16x8 (&vv)[4]) {
    const int b = bh >> 4, h = bh & 15, row = threadIdx.x >> 3, ch = threadIdx.x & 7;
    const bf16* kp = (const bf16*)(A.ws + WS_ACT) + (size_t)M * DM + ((size_t)b * SEQ + 256 * j + row) * DM + h * 64 + 8 * ch;
    const bf16* vp = kp + (size_t)M * DM;
#pragma unroll
    for (int i = 0; i < 4; ++i) { kk[i] = *(const bf16x8*)(kp + (size_t)64 * i * DM); vv[i] = *(const bf16x8*)(vp + (size_t)64 * i * DM); }
}
__device__ __forceinline__ void moba_stage_store(LAS unsigned char* lds, const bf16x8 (&kk)[4], const bf16x8 (&vv)[4]) {
    const int row = threadIdx.x >> 3, ch = threadIdx.x & 7;
#pragma unroll
    for (int i = 0; i < 4; ++i) { *(LAS bf16x8*)(lds + MK_OFF + (64 * i + row) * MK_STRIDE + 16 * ch) = kk[i]; *(LAS bf16x8*)(lds + MV_OFF + (64 * i + row) * MV_STRIDE + 16 * ch) = vv[i]; }
}
__device__ __forceinline__ void moba_stage(const Args& A, LAS unsigned char* lds, int bh, int j) {
    bf16x8 kk[4], vv[4]; moba_stage_load(A, bh, j, kk, vv); moba_stage_store(lds, kk, vv);
}
__device__ __forceinline__ void moba_block(LAS unsigned char* lds, int ntile, const bf16x8 qf0, const bf16x8 qf1, int qpos, int lane, float& m_out, float& l_out, f32x4 (&o)[4]) {
    const int qi = lane & 15, g = lane >> 4;
    LAS unsigned char* kb = lds + MK_OFF + qi * MK_STRIDE + 16 * g;
    f32x4 sa[8], sb[8];
    float mx = -INFINITY;
#pragma unroll
    for (int t = 0; t < 8; ++t) {
        sa[t] = (f32x4){-INFINITY, -INFINITY, -INFINITY, -INFINITY}; sb[t] = sa[t];
        if (t < ntile) {
            LAS unsigned char* kt = kb + t * 32 * MK_STRIDE;
            const bf16x8 k0 = *(LAS bf16x8*)(kt), k1 = *(LAS bf16x8*)(kt + 64), k2 = *(LAS bf16x8*)(kt + 16 * MK_STRIDE), k3 = *(LAS bf16x8*)(kt + 16 * MK_STRIDE + 64);
            f32x4 a = (f32x4){0.f, 0.f, 0.f, 0.f}, bq = (f32x4){0.f, 0.f, 0.f, 0.f};
            a = __builtin_amdgcn_mfma_f32_16x16x32_bf16(k0, qf0, a, 0, 0, 0); a = __builtin_amdgcn_mfma_f32_16x16x32_bf16(k1, qf1, a, 0, 0, 0);
            bq = __builtin_amdgcn_mfma_f32_16x16x32_bf16(k2, qf0, bq, 0, 0, 0); bq = __builtin_amdgcn_mfma_f32_16x16x32_bf16(k3, qf1, bq, 0, 0, 0);
#pragma unroll
            for (int e = 0; e < 4; ++e) { const int ka = 32 * t + 4 * g + e;
                a[e] = (ka <= qpos) ? a[e] : -INFINITY; bq[e] = (ka + 16 <= qpos) ? bq[e] : -INFINITY; mx = fmaxf(mx, fmaxf(a[e], bq[e])); }
            sa[t] = a; sb[t] = bq;
        }
    }
    mx = fmaxf(mx, __shfl_xor(mx, 16)); mx = fmaxf(mx, __shfl_xor(mx, 32));
    float ps = 0.f;
    LAS unsigned char* rb = lds + MV_OFF + (4 * g + (qi >> 2)) * MV_STRIDE + (qi & 3) * 8;
#pragma unroll
    for (int t = 0; t < 8; ++t) {
        if (t < ntile) {
            float pa[4], pb[4];
#pragma unroll
            for (int e = 0; e < 4; ++e) { pa[e] = __builtin_amdgcn_exp2f(sa[t][e] - mx); pb[e] = __builtin_amdgcn_exp2f(sb[t][e] - mx); ps += pa[e] + pb[e]; }
            v4u pw; pw.x = pk2(pa[0], pa[1]); pw.y = pk2(pa[2], pa[3]); pw.z = pk2(pb[0], pb[1]); pw.w = pk2(pb[2], pb[3]);
            const bf16x8 pf = __builtin_bit_cast(bf16x8, pw);
            LAS unsigned char* rt = rb + t * 32 * MV_STRIDE;
#pragma unroll
            for (int db = 0; db < 4; ++db) {
                const s16x4 lo = __builtin_bit_cast(s16x4, __builtin_amdgcn_ds_read_tr16_b64_v4i16((LAS s16x4*)(rt + db * 32)));
                const s16x4 hi = __builtin_bit_cast(s16x4, __builtin_amdgcn_ds_read_tr16_b64_v4i16((LAS s16x4*)(rt + db * 32 + 16 * MV_STRIDE)));
                const bf16x8 vf = (bf16x8){lo[0], lo[1], lo[2], lo[3], hi[0], hi[1], hi[2], hi[3]};
                o[db] = __builtin_amdgcn_mfma_f32_16x16x32_bf16(vf, pf, o[db], 0, 0, 0);
            }
        }
    }
    m_out = mx; l_out = ps;
}
__device__ __forceinline__ bf16* moba_po(const Args& A, int slot) { return slot == 0 ? (bf16*)(A.ws + WS_MIX) : slot == 1 ? (bf16*)A.out : (bf16*)(A.ws + WS_PO2); }
__device__ __forceinline__ void moba_past_phase(const Args& A, LAS unsigned char* lds, int wave, int lane) {
    LAS unsigned* cntl = (LAS unsigned*)(lds + MB_CTL);
    LAS unsigned* pre = cntl + 1024;
    LAS unsigned* tot = pre + 1025;
    const unsigned* cnt = (const unsigned*)(A.ws + WS_CNT);
    const int tid = threadIdx.x;
    for (int i = tid; i < 1024; i += NTHR) cntl[i] = cnt[i];
    __syncthreads();
    if (tid < 32) { unsigned run = 0; for (int j = 0; j < 32; ++j) { pre[tid * 32 + j] = run; const unsigned n = cntl[tid * 32 + j]; run += n ? ((n + 127u) >> 7) + MB_VIRT : 0u; } tot[tid] = run; }
    __syncthreads();
    if (tid == 0) { unsigned run = 0; for (int b = 0; b < 32; ++b) { const unsigned t = tot[b]; tot[b] = run; run += t; } tot[32] = run; pre[1024] = run; }
    __syncthreads();
    for (int i = tid; i < 1024; i += NTHR) pre[i] += tot[i >> 5];
    __syncthreads();
    const unsigned T = tot[32];
    const unsigned i0 = (unsigned)(((unsigned long long)T * blockIdx.x) / gridDim.x), i1 = (unsigned)(((unsigned long long)T * (blockIdx.x + 1)) / gridDim.x);
    const int qi = lane & 15, g = lane >> 4;
    LAS unsigned short* ents = (LAS unsigned short*)(lds + 98304);
    LAS unsigned short* item_e = (LAS unsigned short*)(lds + 98304 + 24576);
    const int n = (int)(i1 - i0) < 96 ? (int)(i1 - i0) : 96;
    for (int x = tid; x < n * 128; x += NTHR) {
        const unsigned it = i0 + (unsigned)(x >> 7);
        int lo = 0, hi = 1024;
        while (lo < hi) { const int mid = (lo + hi) >> 1; if (pre[mid + 1] > it) hi = mid; else lo = mid + 1; }
        const int e = lo, c = (int)(it - pre[e]), li = c * 128 + (x & 127), j = e & 31;
        const unsigned short* list = (const unsigned short*)(A.ws + WS_LIST) + (size_t)(e >> 5) * 126976 + 256 * (31 * j - (j * (j - 1)) / 2);
        ents[x] = (li < (int)cntl[e]) ? list[li] : (unsigned short)0xFFFF;
        if ((x & 127) == 0) item_e[x >> 7] = (unsigned short)e;
    }
    __syncthreads();
    int cur_e = -1;
#define MB_QP(e_, tq_) ((const bf16*)(A.ws + WS_ACT) + ((size_t)((e_) >> 9) * SEQ + (tq_)) * DM + (((e_) >> 5) & 15) * 64 + 8 * g)
    if (n > 0) {
        int eA = (int)item_e[0]; unsigned entA = ents[wave * 16 + qi];
        bf16x8 qA0, qA1; { const int tq = (entA == 0xFFFFu) ? 0 : (int)(entA & 8191u); qA0 = *(const bf16x8*)MB_QP(eA, tq); qA1 = *(const bf16x8*)(MB_QP(eA, tq) + 32); }
        bf16x8 pkk[4], pvv[4]; bool have_pf = false; int pf_e = -1;
#pragma unroll
        for (int i = 0; i < 4; ++i) { pkk[i] = (bf16x8){0, 0, 0, 0, 0, 0, 0, 0}; pvv[i] = pkk[i]; }
        for (int ii = 0; ii < n; ++ii) {
            const int bh = eA >> 5, j = eA & 31;
            const int iin = (ii + 1 < n) ? ii + 1 : ii;
            const int eB = (int)item_e[iin]; const unsigned entB = ents[iin * 128 + wave * 16 + qi];
            if (eA != cur_e) { __syncthreads(); if (have_pf && pf_e == eA) moba_stage_store(lds, pkk, pvv); else moba_stage(A, lds, bh, j); __syncthreads(); cur_e = eA; have_pf = false; }
            const int tqB = (entB == 0xFFFFu) ? 0 : (int)(entB & 8191u);
            const bf16x8 qB0 = *(const bf16x8*)MB_QP(eB, tqB), qB1 = *(const bf16x8*)(MB_QP(eB, tqB) + 32);
            if (eB != eA) { moba_stage_load(A, eB >> 5, eB & 31, pkk, pvv); have_pf = true; pf_e = eB; }
            float mrun, lrun; f32x4 o[4];
#pragma unroll
            for (int d = 0; d < 4; ++d) o[d] = (f32x4){0.f, 0.f, 0.f, 0.f};
            moba_block(lds, 8, qA0, qA1, 1 << 30, lane, mrun, lrun, o);
            lrun += __shfl_xor(lrun, 16); lrun += __shfl_xor(lrun, 32);
            {
                const bool valA = entA != 0xFFFFu; const int tq = (int)(entA & 8191u), slot = (int)(entA >> 13); const size_t idx = (size_t)bh * SEQ + tq;
                const float inv = 1.0f / lrun;
                bf16* junk = (bf16*)(A.ws + 524288) + threadIdx.x * 64;
                bf16* op = valA ? moba_po(A, slot) + idx * 64 + 4 * g : junk;
#pragma unroll
                for (int db = 0; db < 4; ++db) { v2u w; w.x = pk2(o[db][0] * inv, o[db][1] * inv); w.y = pk2(o[db][2] * inv, o[db][3] * inv); *(v2u*)(op + 16 * db) = w; }
                float* lp = (valA && g == 0) ? (float*)(A.ws + WS_LSE) + (size_t)slot * (32 * SEQ) + idx : (float*)(junk + 32);
                *lp = mrun + __builtin_amdgcn_logf(lrun);
            }
            eA = eB; entA = entB; qA0 = qB0; qA1 = qB1;
        }
    }
#undef MB_QP
    __syncthreads();
}
__device__ __forceinline__ void moba_own_phase(const Args& A, LAS unsigned char* lds, int wave, int lane) {
    const int qi = lane & 15, g = lane >> 4;
    int cur_e = -1;
    for (int u = blockIdx.x * 8; u < blockIdx.x * 8 + 8; ++u) {
        const int hf = u & 1, e = u >> 1, bh = e >> 5, j = e & 31;
        if (e != cur_e) { __syncthreads(); moba_stage(A, lds, bh, j); __syncthreads(); cur_e = e; }
        const int qloc = 128 * hf + 16 * wave + qi, tq = 256 * j + qloc;
        const size_t qrow = (size_t)(bh >> 4) * SEQ + tq;
        bf16* qp = (bf16*)(A.ws + WS_ACT) + qrow * DM + (bh & 15) * 64;
        const bf16x8 qf0 = *(const bf16x8*)(qp + 8 * g), qf1 = *(const bf16x8*)(qp + 8 * g + 32);
        float mrun, lrun; f32x4 o[4];
#pragma unroll
        for (int d = 0; d < 4; ++d) o[d] = (f32x4){0.f, 0.f, 0.f, 0.f};
        const size_t idx = (size_t)bh * SEQ + tq;
        const unsigned selm = ((const unsigned*)(A.ws + WS_SEL))[idx];
        const float* lsep = (const float*)(A.ws + WS_LSE) + idx;
        float lsr[3]; s16x4 pr[3][4];
#pragma unroll
        for (int s = 0; s < 3; ++s) { lsr[s] = lsep[(size_t)s * (32 * SEQ)]; const bf16* pp = moba_po(A, s) + idx * 64 + 4 * g;
#pragma unroll
            for (int db = 0; db < 4; ++db) pr[s][db] = *(const s16x4*)(pp + 16 * db); }
        const int ntile = (128 * hf + 16 * wave + 15) / 32 + 1;
        moba_block(lds, ntile, qf0, qf1, qloc, lane, mrun, lrun, o);
        lrun += __shfl_xor(lrun, 16); lrun += __shfl_xor(lrun, 32);
        const int nsel = __popc(selm);
        float ls[3]; float mx = mrun;
#pragma unroll
        for (int s = 0; s < 3; ++s) { ls[s] = (s < nsel) ? lsr[s] : -INFINITY; mx = fmaxf(mx, ls[s]); }
        const float w0 = __builtin_amdgcn_exp2f(mrun - mx); float den = lrun * w0;
#pragma unroll
        for (int d = 0; d < 4; ++d) o[d] = o[d] * w0;
#pragma unroll
        for (int s = 0; s < 3; ++s) { const bool on = s < nsel; const float ws_ = on ? __builtin_amdgcn_exp2f(ls[s] - mx) : 0.f; den += ws_;
#pragma unroll
            for (int db = 0; db < 4; ++db) { const s16x4 r = pr[s][db];
                o[db][0] += on ? ws_ * bf2f((unsigned short)r[0]) : 0.f; o[db][1] += on ? ws_ * bf2f((unsigned short)r[1]) : 0.f;
                o[db][2] += on ? ws_ * bf2f((unsigned short)r[2]) : 0.f; o[db][3] += on ? ws_ * bf2f((unsigned short)r[3]) : 0.f; } }
        const float inv = 1.0f / den;
#pragma unroll
        for (int db = 0; db < 4; ++db) { v2u w; w.x = pk2(o[db][0] * inv, o[db][1] * inv); w.y = pk2(o[db][2] * inv, o[db][3] * inv); *(v2u*)(qp + 16 * db + 4 * g) = w; }
    }
    __syncthreads();
}
constexpr int N_PHASES = 17;
#ifndef MK_DENSE_MOBA
#define MK_DENSE_MOBA 0
#endif
#ifndef MK_FUSE_FINAL
#define MK_FUSE_FINAL 1
#endif
#ifndef MK_SINGLE
#define MK_SINGLE 1
#endif
__global__ void __launch_bounds__(NTHR, 2) fwd_megakernel(Args args) {
    extern __shared__ __attribute__((aligned(16))) unsigned char lds_raw[];
    __builtin_assume(__builtin_amdgcn_workitem_id_y() == 0); __builtin_assume(__builtin_amdgcn_workitem_id_z() == 0);
    cg::grid_group grid = cg::this_grid();
    LAS unsigned char* lds = (LAS unsigned char*)lds_raw;
    const int tid = threadIdx.x, lane = tid & 63, wave = __builtin_amdgcn_readfirstlane(tid >> 6);
    const int G = gridDim.x;
    unsigned char* ws = args.ws;
    const int lo = args.ph_lo, hi = args.ph_hi;
    bf16* XB = (bf16*)(ws + WS_XB); float* PART = (float*)(ws + WS_PART); bf16* ACT = (bf16*)(ws + WS_ACT); bf16* MIX = (bf16*)(ws + WS_MIX);
    float* X = args.out;
#define IN(k) (lo <= (k) && (k) < hi)
    volatile LAS unsigned* MISC = (volatile LAS unsigned*)(lds + MISC_OFF);
    if (tid < 32) MISC[tid] = 0u;
    unsigned* barw = (unsigned*)(ws + WS_BAR);
    XcdBarrier xbar; xbar.bar = barw; xbar.x = 0; xbar.st = MISC + 8;
    __syncthreads();
    xbar = xcd_barrier_post(barw, MISC + 8);
    if (lo > 1000) grid.sync();
#ifdef PROBE_REP
#define SEAM(k) do { if (IN(k) && IN((k) + 1)) { for (int s_ = 0; s_ < PROBE_SYNC; ++s_) grid.sync(); } } while (0)
#else
#ifdef MK_TS
#define STAMP(i) do { if (blockIdx.x == 0 && tid == 0) ((unsigned long long*)(ws + 262144))[i] = __builtin_amdgcn_s_memrealtime(); } while (0)
#define SEAM(k) do { if (IN(k) && IN((k) + 1)) xcd_barrier(xbar); STAMP((k) + 1); } while (0)
#else
#define STAMP(i) do { } while (0)
#define SEAM(k) do { if (IN(k) && IN((k) + 1)) xcd_barrier(xbar); } while (0)
#endif
#endif
#define GEMM_GU(f) do { pg8::Gemm g{XB, (const bf16*)(ws + ws_wgu(f)), M, 2 * FF, DM}; pg8::StaticOrder S; S.init(M, 2 * FF, G, (int)blockIdx.x); \
        rstd_table(PART, lds, S); pg8::EpiSwiGLU E{ACT, FF, (const LAS float*)(lds + RSTD_OFF)}; pg8::gemm_phase<pg8::EpiSwiGLU, pg8::StaticOrder, true, true>(lds, g, S, E); } while (0)
#define GEMM_DOWN(f, F32B, basep) do { pg8::Gemm g{ACT, (const bf16*)(ws + ws_wd(f)), M, DM, FF}; pg8::StaticOrder S; S.init(M, DM, G, (int)blockIdx.x); \
        pg8::EpiResid<F32B> E{(basep), XB, PART, 0.5f}; pg8::gemm_phase<pg8::EpiResid<F32B>, pg8::StaticOrder, true, true>(lds, g, S, E); } while (0)
#define GEMM_OUT(Ap, Wp) do { pg8::Gemm g{(Ap), (const bf16*)(ws + (Wp)), M, DM, DM}; pg8::StaticOrder S; S.init(M, DM, G, (int)blockIdx.x); \
        pg8::EpiResid<false> E{nullptr, XB, PART, 1.0f}; pg8::gemm_phase<pg8::EpiResid<false>, pg8::StaticOrder, true, true>(lds, g, S, E); } while (0)

#ifdef PROBE_REP
    for (int rep_ = 0; rep_ < PROBE_REP0; ++rep_) { phase_prologue(args, lds, wave, lane); __syncthreads(); }
#endif
    STAMP(0);
    if (IN(0)) { phase_prologue(args, lds, wave, lane); } SEAM(0);
    if (IN(1)) { GEMM_GU(0); conv_idle(args, lds, 8, 9, 5); } SEAM(1);
    if (IN(2)) { GEMM_DOWN(0, false, nullptr); } SEAM(2);
    if (IN(3)) { pg8::Gemm g{XB, (const bf16*)(ws + WS_WABIN), M, ABIN, DM}; pg8::StaticOrder S; S.init(M, ABIN, G, (int)blockIdx.x);
        rstd_table(PART, lds, S); pg8::EpiProj E{ACT, ABIN, (const LAS float*)(lds + RSTD_OFF), 0, 0, 512, C2, nullptr}; pg8::gemm_phase<pg8::EpiProj, pg8::StaticOrder, true, true>(lds, g, S, E); conv_idle(args, lds, 1, -1, -1); } SEAM(3);
#ifndef NO_MIX
#ifdef PROBE_REP
    for (int rep_ = 0; rep_ < PROBE_REP4; ++rep_)
#endif
    if (IN(4)) {
        const bool dil_first = (G == 256) && ((blockIdx.x >> 3) & 1);
        if (!dil_first) {
        for (int u = blockIdx.x; u < 512; u += G) gate_unit(args, lds, u, wave, lane);
        }
        if (G == 256) { for (int r = 0; r < 2; ++r) dil_wg_unit(args, lds, (r << 8) | ((blockIdx.x & 7) << 5) | (blockIdx.x >> 3), wave, lane); }
        else { for (int u = blockIdx.x; u < 512; u += G) dil_wg_unit(args, lds, u, wave, lane); }
        if (dil_first) {
        for (int u = blockIdx.x; u < 512; u += G) gate_unit(args, lds, u, wave, lane);
        }
    }
#endif
    SEAM(4);
    if (IN(5)) { GEMM_OUT(MIX, WS_WABOUT); } SEAM(5);
    if (IN(6)) { GEMM_GU(1); conv_idle(args, lds, 2, -1, -1); } SEAM(6);
    if (IN(7)) { GEMM_DOWN(1, false, nullptr); } SEAM(7);
    if (IN(8)) { GEMM_GU(2); conv_idle(args, lds, 6, 10, 11); } SEAM(8);
    if (IN(9)) { GEMM_DOWN(2, false, nullptr); } SEAM(9);
    if (IN(10)) { pg8::Gemm g{XB, (const bf16*)(ws + WS_WCIN), M, CIN, DM}; pg8::StaticOrder S; S.init(M, CIN, G, (int)blockIdx.x);
        rstd_table(PART, lds, S); pg8::EpiProj E{ACT, DM, (const LAS float*)(lds + RSTD_OFF), DM, (size_t)M * DM, DM, C2, (float*)(ws + WS_KM)}; pg8::gemm_phase<pg8::EpiProj, pg8::StaticOrder, true, true>(lds, g, S, E); } SEAM(10);
    if (IN(11)) { select_phase(args, lds, wave, lane); }
    SEAM(11);
#if MK_DENSE_MOBA
#ifndef NO_ATTN
    if (IN(12)) {
        const attn_body::AttnTensors AT{(const attn_body::bf16*)ACT, (const attn_body::bf16*)(ACT + (size_t)M * DM), (const attn_body::bf16*)(ACT + (size_t)2 * M * DM), (attn_body::bf16*)ACT, (const unsigned*)(ws + WS_SEL)};
        const attn_body::StaticOrder S(G, (int)blockIdx.x);
        attn_body::attn_phase<attn_body::StaticOrder>((char*)lds_raw, AT, S);
    }
#endif
#else
    if (IN(12)) { moba_past_phase(args, lds, wave, lane); xcd_barrier(xbar); STAMP(20); moba_own_phase(args, lds, wave, lane); }
#endif
    SEAM(12);
    if (IN(13)) { GEMM_OUT(ACT, WS_WCOUT); } SEAM(13);
    if (IN(14)) { GEMM_GU(3); conv_idle(args, lds, 7, -1, -1); } SEAM(14);
#if MK_FUSE_FINAL
    if (IN(15)) { pg8::Gemm g{ACT, (const bf16*)(ws + ws_wd(3)), M, DM, FF}; pg8::StaticOrder S; S.init(M, DM, G, (int)blockIdx.x);
        EpiResidNorm E{XB, X, PART, args.in[17], 0.5f, xbar}; pg8::gemm_phase<EpiResidNorm, pg8::StaticOrder, false, true>(lds, g, S, E); }
#ifdef MK_TS
    xcd_barrier(xbar); STAMP(16);
    if (blockIdx.x == 0 && tid == 0) { const unsigned long long* ts = (const unsigned long long*)(ws + 262144);
        auto dur = [&](int p) -> float { if (p == 100) return (float)(ts[20] - ts[12]) * 0.01f; if (p == 101) return (float)(ts[13] - ts[20]) * 0.01f; if (p == 102) return (float)(ts[16] - ts[0]) * 0.01f; return (float)(ts[p + 1] - ts[p]) * 0.01f; };
        X[0] += dur(MK_TS_A); X[1024 * 1000] += dur(MK_TS_B); }
#endif
#else
    if (IN(15)) { GEMM_DOWN(3, false, nullptr); } SEAM(15);
    if (IN(16)) {
        const float* gn = args.in[17];
        int tid16 = threadIdx.x; asm volatile("" : "+v"(tid16)); const int lane = tid16 & 63, wave = __builtin_amdgcn_readfirstlane(tid16 >> 6);
        for (int m = blockIdx.x * NWAVES + wave; m < M; m += G * NWAVES) {
            f32x4* xr = (f32x4*)(X + (size_t)m * DM) + lane; f32x4 v[4]; float s = 0.f;
#pragma unroll
            for (int j = 0; j < 4; ++j) { v[j] = xr[64 * j]; s += (v[j][0] * v[j][0] + v[j][1] * v[j][1]) + (v[j][2] * v[j][2] + v[j][3] * v[j][3]); }
            const float rs = rsqrtf(wave_sum(s) * (1.0f / DM) + 1e-6f);
#pragma unroll
            for (int j = 0; j < 4; ++j) { const f32x4 gg = ((const f32x4*)gn)[64 * j + lane]; xr[64 * j] = v[j] * rs * gg; }
        }
    }
#endif
#undef IN
#undef SEAM
}

extern "C" void kernel_launch(void* const* d_in, const int* in_sizes, int n_in, void* d_out, int out_size, void* d_ws, size_t ws_size, hipStream_t stream) {
    static int grid = 0;
    if (grid == 0) {
        if (n_in != 18 || out_size != M * DM || ws_size < WS_END) { fprintf(stderr, "kernel_launch: unexpected shapes (n_in %d out %d ws %zu)\n", n_in, out_size, ws_size); grid = -1; return; }
        int dev = 0, cus = 0, per_cu = 0;
        hipGetDevice(&dev); hipDeviceGetAttribute(&cus, hipDeviceAttributeMultiprocessorCount, dev);
        hipFuncSetAttribute((const void*)fwd_megakernel, hipFuncAttributeMaxDynamicSharedMemorySize, LDS_BYTES);
        hipOccupancyMaxActiveBlocksPerMultiprocessor(&per_cu, (const void*)fwd_megakernel, NTHR, LDS_BYTES);
        (void)hipGetLastError();
        if (per_cu < 1) { fprintf(stderr, "kernel_launch: occupancy query reports %d blocks per CU\n", per_cu); per_cu = 1; }
        grid = cus;
        if (grid != 256) fprintf(stderr, "kernel_launch: note: %d CUs (the attention order assumes 256)\n", grid);
    }
    if (grid < 0) return;
    if (hipMemsetAsync((char*)d_ws + WS_BAR, 0, (WS_CNT + 4096) - WS_BAR, stream) != hipSuccess) { fprintf(stderr, "kernel_launch: memset failed\n"); return; }
    Args a{};
    for (int i = 0; i < 18; ++i) a.in[i] = (const float*)d_in[i];
    a.out = (float*)d_out; a.ws = (unsigned char*)d_ws;
#if MK_SINGLE
    a.ph_lo = 0; a.ph_hi = N_PHASES;
    { void* kargs[] = {&a}; hipError_t e = hipLaunchCooperativeKernel((const void*)fwd_megakernel, dim3(grid), dim3(NTHR), kargs, LDS_BYTES, stream);
      if (e != hipSuccess) fprintf(stderr, "cooperative launch failed: %s\n", hipGetErrorString(e)); }
#else
    for (int p = 0; p < N_PHASES; ++p) { a.ph_lo = p; a.ph_hi = p + 1; void* kargs[] = {&a};
        hipError_t e = hipLaunchCooperativeKernel((const void*)fwd_megakernel, dim3(grid), dim3(NTHR), kargs, LDS_BYTES, stream);
        if (e != hipSuccess) { fprintf(stderr, "cooperative launch %d failed: %s\n", p, hipGetErrorString(e)); break; } }
#endif
}
```

```cpp
#include <hip/hip_runtime.h>
#include <hip/hip_cooperative_groups.h>
#include <hip/hip_bf16.h>
#include <cstdio>
#include <cstdint>
#include <cmath>
namespace cg = cooperative_groups;
namespace pg8 {
#define PG8_LAS __attribute__((address_space(3)))
typedef unsigned short bf16_t;
typedef short bf16x8 __attribute__((ext_vector_type(8)));
typedef float f32x4 __attribute__((ext_vector_type(4)));
typedef unsigned u32x4 __attribute__((ext_vector_type(4)));
constexpr int BM = 256, BK = 64, HALF = 128, HTB = HALF * BK * 2  , STAGE_BYTES = 8 * HTB, NXCD = 8, WGM = 8;

__host__ __device__ __forceinline__ int lds_byte(int r, int c) { const int st = (r >> 4) * 2 + (c >> 5), rr = r & 15, cc = c & 31, ob = rr * 64 + cc * 2; return st * 1024 + (ob ^ (((ob >> 9) & 1) << 5)); }
__host__ __device__ __forceinline__ void stage_rc(int b, int& R, int& C) { const int st = b / 1024, sb = b % 1024, swz = sb ^ (((sb >> 9) & 1) << 5); R = (st >> 1) * 16 + swz / 64; C = (st & 1) * 32 + (swz % 64) / 2; }
__host__ __device__ __forceinline__ int perm32(int rho) { const int n = rho >> 4, i = rho & 15; return 8 * (i >> 2) + 4 * n + (i & 3); }

struct Unit { int pm, pn; };
struct Gemm { const bf16_t* A; const bf16_t* Bt; int M, N, K; };

struct StaticOrder {
    int nM, nN, nwg, G, c;
    __host__ __device__ void init(int M, int N, int G_, int c_) { nM = M / BM; nN = N / BM; nwg = nM * nN; G = G_; c = c_; }
    __host__ __device__ bool next(int i, Unit& u) const {
        const long L = (long)i * G + c; if (L >= nwg) return false;
        int wgid = (int)L; { const int q = nwg / NXCD, r = nwg % NXCD, xcd = wgid % NXCD, off = wgid / NXCD; wgid = (xcd < r ? xcd * (q + 1) : r * (q + 1) + (xcd - r) * q) + off; }
        const int nig = WGM * nN, gid = wgid / nig, fm = gid * WGM, gsz = (nM - fm) < WGM ? (nM - fm) : WGM;
        u.pm = fm + ((wgid % nig) % gsz); u.pn = (wgid % nig) / gsz; return true;
    }
    __device__ __forceinline__ void a_ready(const Unit&) const {}
    __device__ __forceinline__ void done(const Unit&) const {}
};

__device__ __forceinline__ unsigned cvt_pk_bf16(float lo, float hi) { unsigned r; asm volatile("v_cvt_pk_bf16_f32 %0, %1, %2" : "=v"(r) : "v"(lo), "v"(hi)); return r; }
typedef float f32x2 __attribute__((ext_vector_type(2)));
typedef unsigned u32x2 __attribute__((ext_vector_type(2)));
__device__ __forceinline__ float row_rstd(const float* part, int row) {
    const f32x4* p = (const f32x4*)(part + (size_t)row * 16);
    const f32x4 a = p[0], b = p[1], c = p[2], d = p[3];
    const float s = (((a[0] + a[1]) + (a[2] + a[3])) + ((b[0] + b[1]) + (b[2] + b[3]))) + (((c[0] + c[1]) + (c[2] + c[3])) + ((d[0] + d[1]) + (d[2] + d[3])));
    return rsqrtf(s * (1.0f / 1024.0f) + 1e-6f);
}
__device__ __forceinline__ float silu_mul(float g, float u) { return g * u * __builtin_amdgcn_rcpf(1.0f + __builtin_amdgcn_exp2f(-1.4426950408889634f * g)); }
struct EpiSwiGLU {
    static constexpr bool PERM = true, AFTER_DRAIN = false;
    bf16_t* H; int ldh; const PG8_LAS float* rt;
    __device__ __forceinline__ void operator()(const f32x4 (&acc)[2][2][4][2], const Unit& u, int wr, int wc, int fr, int fq, int ui) const {
        const int row0 = u.pm * BM + wr * 64 + fr; const int col0 = u.pn * HALF + wc * 32 + 8 * fq;
#pragma unroll
        for (int ai = 0; ai < 2; ++ai)
#pragma unroll
            for (int m = 0; m < 4; ++m) { const int row = row0 + ai * HALF + m * 16; const float rs = rt[ui * 256 + wr * 64 + fr + ai * HALF + m * 16];
                const f32x4 g0 = acc[ai][0][m][0] * rs, g1 = acc[ai][0][m][1] * rs, u0 = acc[ai][1][m][0] * rs, u1 = acc[ai][1][m][1] * rs;
                u32x4 w; w.x = cvt_pk_bf16(silu_mul(g0[0], u0[0]), silu_mul(g0[1], u0[1])); w.y = cvt_pk_bf16(silu_mul(g0[2], u0[2]), silu_mul(g0[3], u0[3]));
                w.z = cvt_pk_bf16(silu_mul(g1[0], u1[0]), silu_mul(g1[1], u1[1])); w.w = cvt_pk_bf16(silu_mul(g1[2], u1[2]), silu_mul(g1[3], u1[3]));
                *(u32x4*)(H + (size_t)row * ldh + col0) = w; }
    }
};
template <bool BASE_F32> struct EpiResid {
    static constexpr bool PERM = true, AFTER_DRAIN = false;
    const float* base; bf16_t* xb; float* part; float alpha;
    __device__ __forceinline__ void operator()(const f32x4 (&acc)[2][2][4][2], const Unit& u, int wr, int wc, int fr, int fq, int) const {
        const int row0 = u.pm * BM + wr * 64 + fr; const int col0 = u.pn * BM + wc * 32 + 8 * fq;
#pragma unroll
        for (int ai = 0; ai < 2; ++ai)
#pragma unroll
            for (int m = 0; m < 4; ++m) { const int row = row0 + ai * HALF + m * 16; float ss = 0.f;
#pragma unroll
                for (int bj = 0; bj < 2; ++bj) { const size_t off = (size_t)row * 1024 + col0 + bj * HALF;
                    f32x4 b0, b1;
                    if (BASE_F32) { b0 = *(const f32x4*)(base + off); b1 = *(const f32x4*)(base + off + 4); }
                    else { const u32x4 r = *(const u32x4*)(xb + off);
                        b0 = (f32x4){__builtin_bit_cast(float, r.x << 16), __builtin_bit_cast(float, r.x & 0xffff0000u), __builtin_bit_cast(float, r.y << 16), __builtin_bit_cast(float, r.y & 0xffff0000u)};
                        b1 = (f32x4){__builtin_bit_cast(float, r.z << 16), __builtin_bit_cast(float, r.z & 0xffff0000u), __builtin_bit_cast(float, r.w << 16), __builtin_bit_cast(float, r.w & 0xffff0000u)}; }
                    const f32x4 v0 = b0 + acc[ai][bj][m][0] * alpha, v1 = b1 + acc[ai][bj][m][1] * alpha;
                    ss += ((v0[0] * v0[0] + v0[1] * v0[1]) + (v0[2] * v0[2] + v0[3] * v0[3])) + ((v1[0] * v1[0] + v1[1] * v1[1]) + (v1[2] * v1[2] + v1[3] * v1[3]));
                    u32x4 w; w.x = cvt_pk_bf16(v0[0], v0[1]); w.y = cvt_pk_bf16(v0[2], v0[3]); w.z = cvt_pk_bf16(v1[0], v1[1]); w.w = cvt_pk_bf16(v1[2], v1[3]);
                    *(u32x4*)(xb + off) = w; }
                ss += __shfl_xor(ss, 16); ss += __shfl_xor(ss, 32);
                if (fq == 0) part[(size_t)row * 16 + u.pn * 4 + wc] = ss; }
    }
};
struct EpiProj {
    static constexpr bool PERM = true, AFTER_DRAIN = false;
    bf16_t* O; int ldc; const PG8_LAS float* rt; int split_cols; size_t split_stride; int qcols; float scale0; float* km;
    __device__ __forceinline__ void operator()(const f32x4 (&acc)[2][2][4][2], const Unit& u, int wr, int wc, int fr, int fq, int ui) const {
        const int row0 = u.pm * BM + wr * 64 + fr; int colt = u.pn * BM; bf16_t* basep = O; int t = 0;
        const float sc = (colt < qcols) ? scale0 : 1.f;
        if (split_cols) { t = colt / split_cols; basep += (size_t)t * split_stride; colt -= t * split_cols; }
        const int col0 = colt + wc * 32 + 8 * fq;
        const bool do_km = (km != nullptr) && (t == 1);
        f32x4 cs[2][2];
#pragma unroll
        for (int bj = 0; bj < 2; ++bj)
#pragma unroll
            for (int n = 0; n < 2; ++n) cs[bj][n] = (f32x4){0.f, 0.f, 0.f, 0.f};
#pragma unroll
        for (int ai = 0; ai < 2; ++ai)
#pragma unroll
            for (int m = 0; m < 4; ++m) { const int row = row0 + ai * HALF + m * 16; const float rs = rt[ui * 256 + wr * 64 + fr + ai * HALF + m * 16]; const float rsc = rs * sc;
                bf16_t* rowp = basep + (size_t)row * ldc + col0;
#pragma unroll
                for (int bj = 0; bj < 2; ++bj) { const f32x4 v0 = acc[ai][bj][m][0] * rsc, v1 = acc[ai][bj][m][1] * rsc;
                    cs[bj][0] += v0; cs[bj][1] += v1;
                    u32x4 w; w.x = cvt_pk_bf16(v0[0], v0[1]); w.y = cvt_pk_bf16(v0[2], v0[3]); w.z = cvt_pk_bf16(v1[0], v1[1]); w.w = cvt_pk_bf16(v1[2], v1[3]);
                    *(u32x4*)(rowp + bj * HALF) = w; } }
        if (do_km) {
#pragma unroll
            for (int bj = 0; bj < 2; ++bj)
#pragma unroll
                for (int n = 0; n < 2; ++n) { f32x4 v = cs[bj][n];
#pragma unroll
                    for (int o = 1; o < 16; o <<= 1) { v[0] += __shfl_xor(v[0], o); v[1] += __shfl_xor(v[1], o); v[2] += __shfl_xor(v[2], o); v[3] += __shfl_xor(v[3], o); }
                    if (fr == 0) *(f32x4*)(km + (size_t)(u.pm * 2 + wr) * 1024 + col0 + bj * HALF + 4 * n) = v; }
        }
    }
};
template <class Epi, class Sched, bool ALIGN_EPI = false, bool SP2 = false>
__device__ __forceinline__ void gemm_phase(PG8_LAS unsigned char* lds, const Gemm g, const Sched& S, const Epi& E) {
    const int tid = threadIdx.x, wid = __builtin_amdgcn_readfirstlane(tid >> 6), lane = tid & 63, wr = wid >> 2, wc = wid & 3, fr = lane & 15, fq = lane >> 4;
    const int K = g.K, nt = K / BK;
    unsigned voffA[2], voffB[2];
#pragma unroll
    for (int i = 0; i < 2; ++i) { int R, C; stage_rc(tid * 16 + i * 8192, R, C); const int Rb = Epi::PERM ? ((R & ~31) + perm32(R & 31)) : R;
        voffA[i] = (unsigned)(R * K + C) * 2u; voffB[i] = (unsigned)(Rb * K + C) * 2u; }
    const size_t kstep = (size_t)(BK * 2);
    const size_t hstep = (size_t)HALF * K * 2;
    const size_t tstep = 2 * hstep;
    const unsigned ldsw = (unsigned)wid * 1024u;
    const int aoff = lds_byte(wr * 64 + fr, fq * 8), boff = lds_byte(wc * 32 + fr, fq * 8);
#define PG8_SA(b, h) (((b) * 2 + (h)) * HTB)
#define PG8_SB(b, h) ((4 + (b) * 2 + (h)) * HTB)
#define PG8_STAGE(bufoff, gbase, voff) do { _Pragma("unroll") for (int _i = 0; _i < 2; ++_i) \
        __builtin_amdgcn_global_load_lds((const unsigned*)((const char*)(gbase) + (voff)[_i]), (PG8_LAS unsigned*)(lds + (bufoff) + ldsw + _i * 8192), 16, 0, 0); } while (0)
#define PG8_LDA(dst, b, h) do { _Pragma("unroll") for (int m = 0; m < 4; ++m) _Pragma("unroll") for (int k = 0; k < 2; ++k) dst[m][k] = *(const PG8_LAS bf16x8*)(lds + PG8_SA(b, h) + aoff + m * 2048 + k * 1024); } while (0)
#define PG8_LDB(dst, b, h) do { _Pragma("unroll") for (int n = 0; n < 2; ++n) _Pragma("unroll") for (int k = 0; k < 2; ++k) dst[n][k] = *(const PG8_LAS bf16x8*)(lds + PG8_SB(b, h) + boff + n * 2048 + k * 1024); } while (0)
#define PG8_MMA(ai, bj, At, Bt) do { __builtin_amdgcn_s_setprio(1); _Pragma("unroll") for (int m = 0; m < 4; ++m) _Pragma("unroll") for (int n = 0; n < 2; ++n) _Pragma("unroll") for (int k = 0; k < 2; ++k) \
        acc[ai][bj][m][n] = __builtin_amdgcn_mfma_f32_16x16x32_bf16(Bt[n][k], At[m][k], acc[ai][bj][m][n], 0, 0, 0); __builtin_amdgcn_s_setprio(0); } while (0)
#define PG8_WAIT_V(n) asm volatile("s_waitcnt vmcnt(" #n ")" ::: "memory")
#define PG8_WAIT_L(n) asm volatile("s_waitcnt lgkmcnt(" #n ")" ::: "memory")
#define PG8_BAR __builtin_amdgcn_s_barrier()
#define PG8_SCHED __builtin_amdgcn_sched_barrier(0)
    Unit cur, nxt; int ui = 0;
    if (!S.next(0, cur)) return;
    f32x4 acc[2][2][4][2];
#pragma unroll
    for (int a = 0; a < 2; ++a)
#pragma unroll
        for (int b = 0; b < 2; ++b)
#pragma unroll
            for (int m = 0; m < 4; ++m)
#pragma unroll
                for (int n = 0; n < 2; ++n) acc[a][b][m][n] = (f32x4){0.f, 0.f, 0.f, 0.f};
    bf16x8 At[4][2], B0[2][2], B1[2][2];
    const char* cA = (const char*)g.A + (size_t)cur.pm * tstep; const char* cB = (const char*)g.Bt + (size_t)cur.pn * tstep;
    S.a_ready(cur);
    if constexpr (SP2) {
        PG8_STAGE(PG8_SB(0, 0), cB, voffB); PG8_STAGE(PG8_SB(0, 1), cB + hstep, voffB); PG8_STAGE(PG8_SA(0, 0), cA, voffA); PG8_STAGE(PG8_SA(0, 1), cA + hstep, voffA);
        if (wr == 1) PG8_BAR;
        PG8_WAIT_V(2); PG8_BAR;
        PG8_STAGE(PG8_SB(1, 0), cB + kstep, voffB); PG8_STAGE(PG8_SA(1, 0), cA + kstep, voffA); PG8_STAGE(PG8_SB(1, 1), cB + hstep + kstep, voffB);
        PG8_WAIT_V(6); PG8_BAR;
    } else {
        PG8_STAGE(PG8_SB(0, 0), cB, voffB); PG8_STAGE(PG8_SA(0, 0), cA, voffA); PG8_STAGE(PG8_SB(0, 1), cB + hstep, voffB); PG8_STAGE(PG8_SA(0, 1), cA + hstep, voffA);
        if (wr == 1) PG8_BAR;
        PG8_WAIT_V(4); PG8_BAR;
        PG8_STAGE(PG8_SB(1, 0), cB + kstep, voffB); PG8_STAGE(PG8_SA(1, 0), cA + kstep, voffA); PG8_STAGE(PG8_SB(1, 1), cB + hstep + kstep, voffB);
        PG8_WAIT_V(6); PG8_BAR;
    }
    for (;;) {
        const bool has_next = S.next(ui + 1, nxt);
        const char* nA = has_next ? (const char*)g.A + (size_t)nxt.pm * tstep : cA; const char* nB = has_next ? (const char*)g.Bt + (size_t)nxt.pn * tstep : cB;
        for (int t = 0; t < nt; t += 2) {
            const bool last = (t == nt - 2);
            const char* a1 = cA + (size_t)(t + 1) * kstep;
            const char* a2 = last ? nA : cA + (size_t)(t + 2) * kstep; const char* b2 = last ? nB : cB + (size_t)(t + 2) * kstep;
            const char* a3 = a2 + kstep; const char* b3 = b2 + kstep;
            if (last && has_next) S.a_ready(nxt);
            if constexpr (SP2) {
            PG8_LDB(B0, 0, 0); PG8_LDB(B1, 0, 1); PG8_SCHED; PG8_LDA(At, 0, 0); PG8_STAGE(PG8_SA(1, 1), a1 + hstep, voffA);
            PG8_WAIT_V(8); PG8_WAIT_L(0); PG8_BAR; PG8_MMA(0, 0, At, B0); PG8_MMA(0, 1, At, B1); PG8_BAR; PG8_SCHED;
            PG8_LDA(At, 0, 1); PG8_STAGE(PG8_SB(0, 0), b2, voffB); PG8_STAGE(PG8_SB(0, 1), b2 + hstep, voffB); PG8_STAGE(PG8_SA(0, 0), a2, voffA);
            PG8_WAIT_V(8); PG8_WAIT_L(0); PG8_BAR; PG8_MMA(1, 0, At, B0); PG8_MMA(1, 1, At, B1); PG8_BAR; PG8_SCHED;
            PG8_LDB(B0, 1, 0); PG8_LDB(B1, 1, 1); PG8_SCHED; PG8_LDA(At, 1, 0); PG8_STAGE(PG8_SA(0, 1), a2 + hstep, voffA);
            PG8_WAIT_V(8); PG8_WAIT_L(0); PG8_BAR; PG8_MMA(0, 0, At, B0); PG8_MMA(0, 1, At, B1); PG8_BAR; PG8_SCHED;
            PG8_LDA(At, 1, 1); PG8_STAGE(PG8_SB(1, 0), b3, voffB); PG8_STAGE(PG8_SB(1, 1), b3 + hstep, voffB); PG8_STAGE(PG8_SA(1, 0), a3, voffA);
            PG8_WAIT_V(8); PG8_WAIT_L(0); PG8_BAR; PG8_MMA(1, 0, At, B0); PG8_MMA(1, 1, At, B1); PG8_BAR; PG8_SCHED;
            } else {
            PG8_LDB(B0, 0, 0); PG8_SCHED; PG8_LDA(At, 0, 0); PG8_STAGE(PG8_SA(1, 1), a1 + hstep, voffA);
            PG8_WAIT_L(8); PG8_BAR; PG8_WAIT_L(0); PG8_MMA(0, 0, At, B0); PG8_BAR; PG8_SCHED;
            PG8_LDB(B1, 0, 1); PG8_STAGE(PG8_SB(0, 0), b2, voffB);
            PG8_BAR; PG8_WAIT_L(0); PG8_MMA(0, 1, At, B1); PG8_BAR;
            PG8_LDA(At, 0, 1); PG8_STAGE(PG8_SA(0, 0), a2, voffA);
            PG8_BAR; PG8_WAIT_L(0); PG8_MMA(1, 0, At, B0); PG8_BAR; PG8_SCHED;
            PG8_STAGE(PG8_SB(0, 1), b2 + hstep, voffB);
            PG8_WAIT_V(6); PG8_BAR; PG8_MMA(1, 1, At, B1); PG8_BAR;
            PG8_LDB(B0, 1, 0); PG8_SCHED; PG8_LDA(At, 1, 0); PG8_STAGE(PG8_SA(0, 1), a2 + hstep, voffA);
            PG8_WAIT_L(8); PG8_BAR; PG8_WAIT_L(0); PG8_MMA(0, 0, At, B0); PG8_BAR; PG8_SCHED;
            PG8_LDB(B1, 1, 1); PG8_STAGE(PG8_SB(1, 0), b3, voffB);
            PG8_BAR; PG8_WAIT_L(0); PG8_MMA(0, 1, At, B1); PG8_BAR;
            PG8_LDA(At, 1, 1); PG8_STAGE(PG8_SA(1, 0), a3, voffA);
            PG8_BAR; PG8_WAIT_L(0); PG8_MMA(1, 0, At, B0); PG8_BAR; PG8_SCHED;
            PG8_STAGE(PG8_SB(1, 1), b3 + hstep, voffB);
            PG8_WAIT_V(6); PG8_BAR; PG8_MMA(1, 1, At, B1); PG8_BAR;
            }
        }
        if constexpr (ALIGN_EPI) { if (wr == 0) PG8_BAR; }
        if constexpr (!Epi::AFTER_DRAIN) { E(acc, cur, wr, wc, fr, fq, ui); S.done(cur); }
        if (!has_next) break;
#pragma unroll
        for (int a = 0; a < 2; ++a)
#pragma unroll
            for (int b = 0; b < 2; ++b)
#pragma unroll
                for (int m = 0; m < 4; ++m)
#pragma unroll
                    for (int n = 0; n < 2; ++n) acc[a][b][m][n] = (f32x4){0.f, 0.f, 0.f, 0.f};
        cur = nxt; cA = nA; cB = nB; ++ui;
        if constexpr (ALIGN_EPI) { if (wr == 1) PG8_BAR; }
    }
    PG8_WAIT_V(0);
    if constexpr (!ALIGN_EPI) { if (wr == 0) PG8_BAR; }
    PG8_BAR;
    if constexpr (Epi::AFTER_DRAIN) { E.fused(acc, cur, wr, wc, fr, fq, lds, wid, lane); S.done(cur); }
#undef PG8_SA
#undef PG8_SB
#undef PG8_STAGE
#undef PG8_LDA
#undef PG8_LDB
#undef PG8_MMA
#undef PG8_WAIT_V
#undef PG8_WAIT_L
#undef PG8_BAR
#undef PG8_SCHED
}
}
#define PG8_SP2 true
#define PG8_ALIGN true
namespace attn_body {
using bf16=__hip_bfloat16;
using bf16x8=__attribute__((ext_vector_type(8)))short;
using s16x4=__attribute__((ext_vector_type(4)))short;
using f32x16=__attribute__((ext_vector_type(16)))float;
using u32x4=__attribute__((ext_vector_type(4)))unsigned;
constexpr int BATCH=2,NHEAD=16,SEQ=8192,D=64,DM=NHEAD*D;
constexpr int NW=8,QBLK=32,QB=QBLK*NW,KVBLK=64,NQB=SEQ/QB;
constexpr int ATTN_PITCH=DM, ATTN_UNIT_ROWS=QB;
__device__ __forceinline__ int crow(int r,int hi){return (r&3)+8*(r>>2)+4*hi;}
#define SBAR() __builtin_amdgcn_sched_barrier(0)
__device__ __forceinline__ void cmask(f32x16&p0,f32x16&p1,int jb,int qrel,int hi){
  const float NEG=-INFINITY; int kb=64*jb+4*hi;
  #pragma unroll
  for(int r=0;r<16;++r){int kv=kb+(r&3)+8*(r>>2); if(kv>qrel)p0[r]=NEG; if(kv+32>qrel)p1[r]=NEG;}
}

constexpr int NSLOT=3, SLOTB=8192; constexpr float NEGBIG=-2048.f;
constexpr int LDS_K=0, LDS_V=NSLOT*SLOTB, LDS_WS=2*NSLOT*SLOTB, LDS_OST=LDS_WS+NW*64*4, LDS_BYTES=LDS_OST+NW*4096;
constexpr float C2=0.125f*1.4426950408889634f;
__device__ __forceinline__ void glds16(const void*gsrc,unsigned lds_dst){unsigned keep;
  asm volatile("s_mov_b32 %0, m0\n\ts_mov_b32 m0, %2\n\ts_nop 0\n\tglobal_load_lds_dwordx4 %1, off\n\ts_mov_b32 m0, %0":"=&s"(keep):"v"(gsrc),"s"(lds_dst):"memory");}
__device__ __forceinline__ float max3f(float a,float b,float c){float r;asm("v_max3_f32 %0, %1, %2, %3":"=v"(r):"v"(a),"v"(b),"v"(c));return r;}
__device__ __forceinline__ float max2f(float a,float b){float r;asm("v_max_f32_e32 %0, %1, %2":"=v"(r):"v"(a),"v"(b));return r;}
__device__ __forceinline__ float fadd_s(float a,float b){float r;asm("v_add_f32_e32 %0, %1, %2":"=v"(r):"v"(a),"v"(b));return r;}
__device__ __forceinline__ float fsub_s(float a,float b){float r;asm("v_sub_f32_e32 %0, %1, %2":"=v"(r):"v"(a),"v"(b));return r;}
typedef float f32x2_t __attribute__((ext_vector_type(2))); typedef __bf16 bf16x2_t __attribute__((ext_vector_type(2)));
__device__ __forceinline__ unsigned cvtpk_s(float lo,float hi){f32x2_t v={lo,hi};bf16x2_t b=__builtin_convertvector(v,bf16x2_t);return __builtin_bit_cast(unsigned,b);}
#define WAIT_BAR(N) asm volatile("s_waitcnt vmcnt(" #N ") lgkmcnt(0)\n\ts_barrier":::"memory")

__device__ __forceinline__ void qkt(f32x16&p0,f32x16&p1,const char*Kslot,const bf16x8*qr,const f32x16&negm,int r32,int hi){
  const char*kb=Kslot+hi*1024+r32*16;
  #pragma unroll
  for(int d0=0;d0<4;++d0){
    const bf16x8 b0=*reinterpret_cast<const bf16x8*>(kb+d0*2048);
    const bf16x8 b1=*reinterpret_cast<const bf16x8*>(kb+d0*2048+512);
    if(d0==0){p0=__builtin_amdgcn_mfma_f32_32x32x16_bf16(b0,qr[0],negm,0,0,0);p1=__builtin_amdgcn_mfma_f32_32x32x16_bf16(b1,qr[0],negm,0,0,0);}
    else{p0=__builtin_amdgcn_mfma_f32_32x32x16_bf16(b0,qr[d0],p0,0,0,0);p1=__builtin_amdgcn_mfma_f32_32x32x16_bf16(b1,qr[d0],p1,0,0,0);}}
}
typedef __attribute__((address_space(3))) const char* lds_cptr;
typedef short v4i16_t __attribute__((ext_vector_type(4)));
__device__ __forceinline__ void kload8(bf16x8*kf,lds_cptr kp){
  kf[0]=*(const __attribute__((address_space(3))) bf16x8*)(kp);      kf[1]=*(const __attribute__((address_space(3))) bf16x8*)(kp+512);
  kf[2]=*(const __attribute__((address_space(3))) bf16x8*)(kp+2048); kf[3]=*(const __attribute__((address_space(3))) bf16x8*)(kp+2560);
  kf[4]=*(const __attribute__((address_space(3))) bf16x8*)(kp+4096); kf[5]=*(const __attribute__((address_space(3))) bf16x8*)(kp+4608);
  kf[6]=*(const __attribute__((address_space(3))) bf16x8*)(kp+6144); kf[7]=*(const __attribute__((address_space(3))) bf16x8*)(kp+6656);
}
__device__ __forceinline__ void kload2(bf16x8*kf,lds_cptr kp,int j){ kf[2*j]=*(const __attribute__((address_space(3))) bf16x8*)(kp+j*2048); kf[2*j+1]=*(const __attribute__((address_space(3))) bf16x8*)(kp+j*2048+512); }
__device__ __forceinline__ s16x4 vtr(lds_cptr p){ return __builtin_bit_cast(s16x4,__builtin_amdgcn_ds_read_tr16_b64_v4i16((__attribute__((address_space(3))) v4i16_t*)p)); }
__device__ __forceinline__ float rowmax(const f32x16&p0,const f32x16&p1){
  float a=max3f(p0[0],p0[1],p1[0]),b=max3f(p0[2],p0[3],p1[1]);a=max3f(a,p1[2],p1[3]);
  #pragma unroll
  for(int r=4;r<16;r+=4){a=max3f(a,p0[r],p0[r+1]);b=max3f(b,p0[r+2],p0[r+3]);a=max3f(a,p1[r],p1[r+1]);b=max3f(b,p1[r+2],p1[r+3]);}
  const float m=max2f(a,b);
  auto rr=__builtin_amdgcn_permlane32_swap(__float_as_uint(m),__float_as_uint(m),false,false);
  return max2f(__uint_as_float(rr[0]),__uint_as_float(rr[1]));
}
__device__ __forceinline__ void pv(f32x16*o,int vb,bf16x8 pa0,bf16x8 pa1,bf16x8 pa2,bf16x8 pa3){
  #pragma unroll
  for(int d0=0;d0<2;++d0){s16x4 lo[4],hi[4];
    #pragma unroll
    for(int ks=0;ks<4;++ks){
      asm volatile("ds_read_b64_tr_b16 %0,%1 offset:%c2":"=&v"(lo[ks]):"v"(vb),"i"(d0*4096+ks*1024):"memory");
      asm volatile("ds_read_b64_tr_b16 %0,%1 offset:%c2":"=&v"(hi[ks]):"v"(vb),"i"(d0*4096+ks*1024+512):"memory");}
    asm volatile("s_waitcnt lgkmcnt(0)":::"memory");SBAR();
    #define PK(k) (bf16x8){lo[k][0],lo[k][1],lo[k][2],lo[k][3],hi[k][0],hi[k][1],hi[k][2],hi[k][3]}
    o[d0]=__builtin_amdgcn_mfma_f32_32x32x16_bf16(pa0,PK(0),o[d0],0,0,0);
    o[d0]=__builtin_amdgcn_mfma_f32_32x32x16_bf16(pa1,PK(1),o[d0],0,0,0);
    o[d0]=__builtin_amdgcn_mfma_f32_32x32x16_bf16(pa2,PK(2),o[d0],0,0,0);
    o[d0]=__builtin_amdgcn_mfma_f32_32x32x16_bf16(pa3,PK(3),o[d0],0,0,0);
    #undef PK
  }
}

#ifndef ATTN_STORE16
#define ATTN_STORE16(p,v) (*(u32x4*)(p)=(v))
#endif
template<int THRL> __device__ __forceinline__ void attn_unit(int b,int h,int qb,const bf16*Q,const bf16*__restrict__ K,const bf16*__restrict__ V,bf16*O,const unsigned*__restrict__ SEL,char*shm){
  const int tid=threadIdx.x,lane=tid&63,r32=lane&31,hi=lane>>5; const int wid=__builtin_amdgcn_readfirstlane(tid>>6);
  const long rowbase=(long)b*SEQ; const int q0=qb*QB;
  const bf16*Qw=Q+(rowbase+q0+wid*QBLK)*DM+h*D;
  const bf16*Kh=K+rowbase*DM+h*D,*Vh=V+rowbase*DM+h*D;
  const unsigned lds0=(unsigned)(uintptr_t)shm;
  float*wsf=(float*)(shm+LDS_WS)+wid*64;
  const bf16*ksrc=Kh+(long)lane*DM+wid*8;
  const bf16*vsrc=Vh+(long)(16*(wid&3)+(lane>>2))*DM+(wid>>2)*32+(lane&3)*8;
  const unsigned kdst=lds0+LDS_K+wid*1024, vdst=lds0+LDS_V+wid*1024;
  #define DMA_K(t,slot) glds16(ksrc+(long)(t)*KVBLK*DM,(unsigned)__builtin_amdgcn_readfirstlane(kdst+(slot)))
  #define DMA_V(t,slot) glds16(vsrc+(long)(t)*KVBLK*DM,(unsigned)__builtin_amdgcn_readfirstlane(vdst+(slot)))
  const int vb0=(int)(lds0+LDS_V)+((lane>>4)&1)*32+(lane&3)*8+(4*hi+((lane&15)>>2))*64;
  const char*Kbase=shm+LDS_K; bf16x8 kf[8];
  const lds_cptr shm3=(lds_cptr)shm; const lds_cptr kp0=shm3+LDS_K+hi*1024+r32*16; const lds_cptr vp0=shm3+LDS_V+((lane>>4)&1)*32+(lane&3)*8+(4*hi+((lane&15)>>2))*64;
  const int NT=(q0+QB)/KVBLK;
  DMA_K(0,0);DMA_V(0,0);DMA_K(1,SLOTB);
  bf16x8 qr[4];
  #pragma unroll
  for(int d0=0;d0<4;++d0)qr[d0]=*reinterpret_cast<const bf16x8*>(&Qw[(long)r32*DM+d0*16+hi*8]);
  float mhat=0.f,l_reg=0.f;f32x16 o[2];o[0]=f32x16{};o[1]=f32x16{};const f32x16 negm=f32x16{};
  const int qrel=wid*QBLK+r32; volatile unsigned*sel_l=(volatile unsigned*)(shm+LDS_BYTES)+wid*32; if(hi==0)sel_l[r32]=SEL[(size_t)(b*NHEAD+h)*SEQ+q0+qrel];
  #define CMASK(P0,P1,t) do{int jb_=(t)-(NT-4); if(jb_>=0){cmask(P0,P1,jb_,qrel,hi);} else if(!((sel_l[r32]>>(((t)>>2)&31))&1u)){ _Pragma("unroll") for(int r_=0;r_<16;++r_){P0[r_]=NEGBIG;P1[r_]=NEGBIG;} } }while(0)
  bool resc=false;
  #define START(P0,P1) do{ const float rm=rowmax(P0,P1); resc=false; \
    { const float dl=rm; mhat=fadd_s(mhat,dl); \
      _Pragma("unroll") for(int r=0;r<16;++r){P0[r]=fsub_s(P0[r],dl);P1[r]=fsub_s(P1[r],dl);} \
      } \
    _Pragma("unroll") for(int r=0;r<16;++r)P0[r]=__builtin_amdgcn_exp2f(P0[r]); }while(0)
  #define RESC() do{ if(resc){ asm volatile("s_waitcnt lgkmcnt(0)":::"memory"); \
      _Pragma("unroll") for(int d_=0;d_<2;++d_) _Pragma("unroll") for(int r=0;r<16;++r)o[d_][r]*=wsf[crow(r,hi)]; } }while(0)
  f32x16 pA0,pA1,pB0,pB1;
  int sl_prev=0,sl_cur=0,sl_next=SLOTB;
  #define ROT() do{sl_prev=sl_cur;sl_cur=sl_next;sl_next=(sl_next==(NSLOT-1)*SLOTB)?0:sl_next+SLOTB;}while(0)
  DMA_K(2,2*SLOTB);
  WAIT_BAR(3);
  qkt(pA0,pA1,Kbase,qr,negm,r32,hi);asm volatile("s_nop 15\n\ts_nop 7":"+v"(pA0),"+v"(pA1));CMASK(pA0,pA1,0);
  START(pA0,pA1);
  _Pragma("unroll") for(int r=0;r<16;++r)pA1[r]=__builtin_amdgcn_exp2f(pA1[r]);
  WAIT_BAR(0);
  DMA_K(3,0);DMA_V(1,SLOTB);
  ROT();
  kload8(kf,kp0+sl_cur);
  WAIT_BAR(2);
  s16x4 vlo[8],vhi[8]; u32x4 pw0,pw1,pw2,pw3;
  #define PKW(P,B) cvtpk_s(P[B],P[B+1])
  #define PAF(k) __builtin_bit_cast(bf16x8,pw##k)
  #define VFR(i) (bf16x8){vlo[i][0],vlo[i][1],vlo[i][2],vlo[i][3],vhi[i][0],vhi[i][1],vhi[i][2],vhi[i][3]}
  #define PIN(x) asm volatile("":"+v"(x))
  #define MX3(a,b,c) __builtin_fmaxf(__builtin_fmaxf((a),(b)),(c))
  #define GAPA(MF,A0,A1,A2,A3,W0,W1,PW) do{ MF; sacc+=A0; sacc+=A1; sacc+=A2; sacc+=A3; PIN(sacc); W0; W1; PIN(PW); SBAR(); }while(0)
  #define EX(v) __builtin_amdgcn_exp2f(v)
  #define GAPB(MF,X,B) do{ MF; X[B]=EX(X[B]); X[B+1]=EX(X[B+1]); X[B+2]=EX(X[B+2]); X[B+3]=EX(X[B+3]); PIN(X); SBAR(); }while(0)
  #define VRD(i) do{ vlo[i]=vtr(vp_+(((i)>>2)*4096+((i)&3)*1024)); vhi[i]=vtr(vp_+(((i)>>2)*4096+((i)&3)*1024+512)); }while(0)
  #define KRD(G,j) do{ if(G){ kload2(kf,kp0+sl_next,j); SBAR(); } }while(0)
  #define STEP(C0,C1,P0,P1,t,GK,GV,GL) do{ SBAR(); \
    const lds_cptr vp_=vp0+sl_prev; \
    VRD(0); SBAR(); float sacc=(P0[0]+P0[1]); \
    GAPA(C0=__builtin_amdgcn_mfma_f32_32x32x16_bf16(kf[0],qr[0],negm,0,0,0), P0[2],P0[3],P0[4],P0[5],     pw0[0]=PKW(P0,0), pw0[1]=PKW(P0,2), pw0); \
    VRD(4); SBAR(); GAPA(C1=__builtin_amdgcn_mfma_f32_32x32x16_bf16(kf[1],qr[0],negm,0,0,0), P0[6],P0[7],P0[8],P0[9],     pw0[2]=PKW(P0,4), pw0[3]=PKW(P0,6), pw0); \
    VRD(1); SBAR(); GAPA(C0=__builtin_amdgcn_mfma_f32_32x32x16_bf16(kf[2],qr[1],C0,0,0,0),   P0[10],P0[11],P0[12],P0[13], pw1[0]=PKW(P0,8), pw1[1]=PKW(P0,10), pw1); \
    VRD(5); SBAR(); GAPA(C1=__builtin_amdgcn_mfma_f32_32x32x16_bf16(kf[3],qr[1],C1,0,0,0),   P0[14],P0[15],P1[0],P1[1],   pw1[2]=PKW(P0,12),pw1[3]=PKW(P0,14), pw1); \
    VRD(2); SBAR(); GAPA(C0=__builtin_amdgcn_mfma_f32_32x32x16_bf16(kf[4],qr[2],C0,0,0,0),   P1[2],P1[3],P1[4],P1[5],     pw2[0]=PKW(P1,0), pw2[1]=PKW(P1,2), pw2); \
    VRD(6); SBAR(); GAPA(C1=__builtin_amdgcn_mfma_f32_32x32x16_bf16(kf[5],qr[2],C1,0,0,0),   P1[6],P1[7],P1[8],P1[9],     pw2[2]=PKW(P1,4), pw2[3]=PKW(P1,6), pw2); \
    VRD(3); SBAR(); GAPA(C0=__builtin_amdgcn_mfma_f32_32x32x16_bf16(kf[6],qr[3],C0,0,0,0),   P1[10],P1[11],P1[12],P1[13], pw3[0]=PKW(P1,8), pw3[1]=PKW(P1,10), pw3); \
    VRD(7); SBAR(); GAPA(C1=__builtin_amdgcn_mfma_f32_32x32x16_bf16(kf[7],qr[3],C1,0,0,0),   P1[14],P1[15],0.f,0.f,       pw3[2]=PKW(P1,12),pw3[3]=PKW(P1,14), pw3); \
    l_reg+=sacc; \
    if(GK){DMA_K((t)+3,sl_cur);} if(GV){DMA_V((t)+1,sl_next);} \
    _Pragma("unroll") for(int r=0;r<16;++r){C0[r]-=mhat;C1[r]-=mhat;} \
    CMASK(C0,C1,t); \
    { float a=MX3(C0[0],C0[1],C1[0]),b=MX3(C0[2],C0[3],C1[1]); a=MX3(a,C1[2],C1[3]); \
      _Pragma("unroll") for(int r=4;r<16;r+=4){a=MX3(a,C0[r],C0[r+1]);b=MX3(b,C0[r+2],C0[r+3]);a=MX3(a,C1[r],C1[r+1]);b=MX3(b,C1[r+2],C1[r+3]);} \
      float rm=__builtin_fmaxf(a,b); { auto rr=__builtin_amdgcn_permlane32_swap(__float_as_uint(rm),__float_as_uint(rm),false,false); rm=__builtin_fmaxf(__uint_as_float(rr[0]),__uint_as_float(rr[1])); } \
      resc=false; \
      if(__builtin_expect(__any(rm>(float)THRL),0)){ const float dl=__builtin_fmaxf(rm,0.f); mhat+=dl; \
        _Pragma("unroll") for(int r=0;r<16;++r){C0[r]-=dl;C1[r]-=dl;} \
        const float f=__builtin_amdgcn_exp2f(-dl); l_reg*=f; if(hi==0)wsf[r32]=f; resc=true; } } \
    SBAR(); \
    GAPB(o[0]=__builtin_amdgcn_mfma_f32_32x32x16_bf16(PAF(0),VFR(0),o[0],0,0,0), C0,0); \
    GAPB(o[1]=__builtin_amdgcn_mfma_f32_32x32x16_bf16(PAF(0),VFR(4),o[1],0,0,0), C0,4); \
    KRD(GL,0); GAPB(o[0]=__builtin_amdgcn_mfma_f32_32x32x16_bf16(PAF(1),VFR(1),o[0],0,0,0), C0,8); \
    KRD(GL,1); GAPB(o[1]=__builtin_amdgcn_mfma_f32_32x32x16_bf16(PAF(1),VFR(5),o[1],0,0,0), C0,12); \
    KRD(GL,2); GAPB(o[0]=__builtin_amdgcn_mfma_f32_32x32x16_bf16(PAF(2),VFR(2),o[0],0,0,0), C1,0); \
    KRD(GL,3); GAPB(o[1]=__builtin_amdgcn_mfma_f32_32x32x16_bf16(PAF(2),VFR(6),o[1],0,0,0), C1,4); \
    GAPB(o[0]=__builtin_amdgcn_mfma_f32_32x32x16_bf16(PAF(3),VFR(3),o[0],0,0,0), C1,8); \
    GAPB(o[1]=__builtin_amdgcn_mfma_f32_32x32x16_bf16(PAF(3),VFR(7),o[1],0,0,0), C1,12); \
    }while(0)
  int t=1;
  #undef CMASK
  #define CMASK(P0,P1,t) do{ if(!((sel_l[r32]>>(((t)>>2)&31))&1u)){ _Pragma("unroll") for(int r_=0;r_<16;++r_){P0[r_]=NEGBIG;P1[r_]=NEGBIG;} } }while(0)
  for(;t+5<NT;t+=2){
    STEP(pB0,pB1,pA0,pA1,t,true,true,true);     WAIT_BAR(2); RESC(); ROT();
    STEP(pA0,pA1,pB0,pB1,t+1,true,true,true);   WAIT_BAR(2); RESC(); ROT();
  }
  #undef CMASK
  #define CMASK(P0,P1,t) do{int jb_=(t)-(NT-4); if(jb_>=0){cmask(P0,P1,jb_,qrel,hi);} else if(!((sel_l[r32]>>(((t)>>2)&31))&1u)){ _Pragma("unroll") for(int r_=0;r_<16;++r_){P0[r_]=NEGBIG;P1[r_]=NEGBIG;} } }while(0)
  #define ENDW(tt) do{ if((tt)+3<NT){WAIT_BAR(2);} else if((tt)+2<NT){WAIT_BAR(1);} else {WAIT_BAR(0);} }while(0)
  for(;t+1<NT;t+=2){
    STEP(pB0,pB1,pA0,pA1,t,(t+3<NT),(t+1<NT),(t+1<NT));       ENDW(t);   RESC(); ROT();
    STEP(pA0,pA1,pB0,pB1,t+1,(t+4<NT),(t+2<NT),(t+2<NT));     ENDW(t+1); RESC(); ROT();
  }
  STEP(pB0,pB1,pA0,pA1,NT-1,false,false,false); RESC();
  { float sacc=pB0[0]+pB0[1]; _Pragma("unroll") for(int r=2;r<16;++r)sacc+=pB0[r]; _Pragma("unroll") for(int r=0;r<16;++r)sacc+=pB1[r]; l_reg+=sacc;
    pw0=(u32x4){PKW(pB0,0),PKW(pB0,2),PKW(pB0,4),PKW(pB0,6)};pw1=(u32x4){PKW(pB0,8),PKW(pB0,10),PKW(pB0,12),PKW(pB0,14)};pw2=(u32x4){PKW(pB1,0),PKW(pB1,2),PKW(pB1,4),PKW(pB1,6)};pw3=(u32x4){PKW(pB1,8),PKW(pB1,10),PKW(pB1,12),PKW(pB1,14)};
    SBAR(); pv(o,vb0+sl_cur,PAF(0),PAF(1),PAF(2),PAF(3)); }
  #undef PKW
  #undef PAF
  #undef VFR
  #undef PIN
  #undef MX3
  #undef GAPA
  #undef GAPB
  #undef EX
  #undef VRD
  #undef KRD
  #undef STEP
  #undef ENDW
  {auto rr=__builtin_amdgcn_permlane32_swap(__float_as_uint(l_reg),__float_as_uint(l_reg),false,false);l_reg=__uint_as_float(rr[0])+__uint_as_float(rr[1]);}
  if(hi==0)wsf[32+r32]=l_reg;asm volatile("s_waitcnt lgkmcnt(0)":::"memory");
  float rli[16];
  #pragma unroll
  for(int r=0;r<16;++r)rli[r]=__builtin_amdgcn_rcpf(wsf[32+crow(r,hi)]);
  bf16*Ow=O+(rowbase+q0+wid*QBLK)*DM+h*D;
  { bf16*stg=(bf16*)(shm+LDS_OST)+wid*2048;
    #pragma unroll
    for(int r=0;r<16;++r){const int orow=crow(r,hi);
      #pragma unroll
      for(int d0=0;d0<2;++d0)stg[orow*64+d0*32+r32]=__float2bfloat16(o[d0][r]*rli[r]);}
    asm volatile("s_waitcnt lgkmcnt(0)":::"memory");
    #pragma unroll
    for(int i=0;i<4;++i){const int row=i*8+(lane>>3),ch=lane&7; const u32x4 v=*(const u32x4*)(stg+row*64+ch*8); ATTN_STORE16(Ow+(long)row*DM+ch*8,v);} }
  asm volatile("s_waitcnt lgkmcnt(0)\n\ts_barrier":::"memory");
  #undef DMA_K
  #undef DMA_V
  #undef CMASK
  #undef START
  #undef RESC
  #undef ROT
}
constexpr int ATTN_LDS_BYTES=LDS_BYTES;
struct AttnTensors { const bf16* Q; const bf16* K; const bf16* V; bf16* O; const unsigned* SEL; };
struct AttnUnit { int bh; int qb; };
struct StaticOrder {
  int vcu;
  __device__ __forceinline__ explicit StaticOrder(int grid,int block):vcu((block%8)*(grid/8)+block/8){}
  __device__ __forceinline__ bool next(int i,AttnUnit&u)const{ if(i>=4)return false; const int s=vcu&7; u.bh=vcu>>3; u.qb=(i==0)?s:(i==1)?15-s:(i==2)?16+s:31-s; return true; }
  __device__ __forceinline__ void a_ready(const AttnUnit&)const{}
  __device__ __forceinline__ void done(const AttnUnit&)const{}
};
template<class Sched,int THRL=8> __device__ __forceinline__ void attn_phase(char*lds,const AttnTensors&T,const Sched&S){
  AttnUnit u;
  for(int i=0;S.next(i,u);++i){ S.a_ready(u); attn_unit<THRL>(u.bh/NHEAD,u.bh%NHEAD,u.qb,T.Q,T.K,T.V,T.O,T.SEL,lds); S.done(u); }
}
#undef SBAR
#undef WAIT_BAR
}
#define LAS __attribute__((address_space(3)))
typedef unsigned short bf16;
typedef unsigned v4u __attribute__((ext_vector_type(4)));
typedef unsigned v2u __attribute__((ext_vector_type(2)));
typedef float f32x4 __attribute__((ext_vector_type(4)));
typedef short bf16x8 __attribute__((ext_vector_type(8)));
typedef short s16x4 __attribute__((ext_vector_type(4)));
constexpr int NWAVES = 8, NTHR = 512;
constexpr int SEQ = 8192, DM = 1024, M = 16384, FF = 2816, ABIN = 2560, CIN = 3072;
constexpr float C2 = 0.125f * 1.4426950408889634f;
constexpr size_t MiB = 1u << 20;
__host__ __device__ constexpr size_t ws_wgu(int f) { return (f == 0 ? 2 : f == 1 ? 13 : f == 2 ? 42 : 53) * MiB; }
__host__ __device__ constexpr size_t ws_wd(int f) { return (f == 0 ? 48 : f == 1 ? 59 : f == 2 ? 128 : 139) * (MiB / 2); }
constexpr size_t WS_WABIN = 35 * MiB, WS_WABOUT = 40 * MiB, WS_WCIN = 75 * MiB, WS_WCOUT = 81 * MiB;
constexpr size_t WS_PO2 = 2 * MiB, WS_LSE = 34 * MiB;
constexpr size_t WS_CNT = 131072;
constexpr size_t WS_LIST = 248 * MiB;
constexpr size_t WS_WSB = 83 * MiB;
constexpr size_t WS_PART = 84 * MiB;
constexpr size_t WS_KM = 85 * MiB;
constexpr size_t WS_SEL = 86 * MiB;
constexpr size_t WS_XB = 88 * MiB;
constexpr size_t WS_ACT = 120 * MiB;
constexpr size_t WS_MIX = 216 * MiB;
constexpr size_t WS_END = 256 * MiB;
constexpr int LDS_BYTES = 147456;
constexpr int MISC_OFF = 131072 + 320;
constexpr size_t WS_BAR = 65536;

__device__ __forceinline__ unsigned f2bf(float f) { unsigned u = __builtin_bit_cast(unsigned, f); return (u + 0x7fffu + ((u >> 16) & 1u)) >> 16; }
typedef float f32x2_t __attribute__((ext_vector_type(2))); typedef __bf16 bf16x2_t __attribute__((ext_vector_type(2)));
__device__ __forceinline__ unsigned pk2(float lo, float hi) { f32x2_t v = {lo, hi}; bf16x2_t b = __builtin_convertvector(v, bf16x2_t); return __builtin_bit_cast(unsigned, b); }
__device__ __forceinline__ float bf2f(unsigned short b) { return __builtin_bit_cast(float, (unsigned)b << 16); }
__device__ __forceinline__ float wave_sum(float v) {
#pragma unroll
    for (int o = 1; o < 64; o <<= 1) v += __shfl_xor(v, o);
    return v;
}
__device__ __forceinline__ float gelu_tanh(float x) {
    const float y = 0.7978845608028654f * (x + 0.044715f * x * x * x);
    return x * __builtin_amdgcn_rcpf(1.0f + __builtin_amdgcn_exp2f(-2.0f * 1.4426950408889634f * y));
}
constexpr int TP_STRIDE = 136;
__device__ __forceinline__ void p0_transpose_item(const float* W, int K, int N, bf16* WT, int mode, const float* gain, LAS unsigned char* scr, int item, int lane) {
    const int nblk = N / 64, kb = item / nblk, nb = item % nblk, k0 = 64 * kb, n0 = 64 * nb;
    const int d0 = (mode == 0) ? n0 : ((n0 >> 7) * 256 + (n0 & 127) + (mode == 2 ? 128 : 0));
    const int kr = lane >> 4, nc = (lane & 15) * 4;
    f32x4 v[16];
#pragma unroll
    for (int i = 0; i < 16; ++i) v[i] = *(const f32x4*)(W + (size_t)(k0 + 4 * i + kr) * N + n0 + nc);
#pragma unroll
    for (int i = 0; i < 16; ++i) { const float gk = gain ? gain[k0 + 4 * i + kr] : 1.0f; v2u w; w.x = pk2(v[i][0] * gk, v[i][1] * gk); w.y = pk2(v[i][2] * gk, v[i][3] * gk);
        *(LAS v2u*)(scr + (4 * i + kr) * TP_STRIDE + nc * 2) = w; }
    asm volatile("s_waitcnt lgkmcnt(0)" ::: "memory");
    const int g = lane >> 4, li = lane & 15, qq = li >> 2, pp = li & 3;
#pragma unroll
    for (int nb16 = 0; nb16 < 4; ++nb16)
#pragma unroll
        for (int half = 0; half < 2; ++half) { const int kc = g + 4 * half;
            LAS unsigned char* a = scr + (8 * kc + qq) * TP_STRIDE + (16 * nb16 + 4 * pp) * 2;
            const s16x4 lo = __builtin_bit_cast(s16x4, __builtin_amdgcn_ds_read_tr16_b64_v4i16((LAS s16x4*)a));
            const s16x4 hi = __builtin_bit_cast(s16x4, __builtin_amdgcn_ds_read_tr16_b64_v4i16((LAS s16x4*)(a + 4 * TP_STRIDE)));
            const bf16x8 o = (bf16x8){lo[0], lo[1], lo[2], lo[3], hi[0], hi[1], hi[2], hi[3]};
            *(bf16x8*)(WT + (size_t)(d0 + 16 * nb16 + li) * K + k0 + 8 * kc) = o; }
    asm volatile("s_waitcnt lgkmcnt(0)" ::: "memory");
}
#define XB_TMO      128
#define XB_XCNT(j)  (256  + 64 * (j))
#define XB_XSUB(j)  (1280 + 64 * (j))
#define XB_XGEN(j)  (2304 + 64 * (j))
#define XB_TOP      3328
#define XB_TOPGEN   3392
#define XCD_BAR_WORDS 3456
#define XB_SPIN_CAP (1u << 18)

__device__ __forceinline__ unsigned xb_ld(unsigned* p)              { return __hip_atomic_load(p, __ATOMIC_RELAXED, __HIP_MEMORY_SCOPE_AGENT); }
__device__ __forceinline__ unsigned xb_add(unsigned* p, unsigned v) { return __hip_atomic_fetch_add(p, v, __ATOMIC_RELAXED, __HIP_MEMORY_SCOPE_AGENT); }
__device__ __forceinline__ unsigned xb_xcc_id() { return (unsigned)__builtin_amdgcn_s_getreg((3 << 11) | 20) & 0xFu; }
#define XB_SPIN(cond, bar) do { unsigned _sp = 0; while (cond) { __builtin_amdgcn_s_sleep(1); \
    if ((++_sp & 255u) == 0u) { if (xb_ld(&(bar)[XB_TMO])) break; if (_sp > XB_SPIN_CAP) { atomicAdd(&(bar)[XB_TMO], 1u); break; } } } } while (0)

struct XcdBarrier {
    unsigned* bar; unsigned x;
    volatile LAS unsigned* st;
};

__device__ __forceinline__ XcdBarrier xcd_barrier_post(unsigned* bar, volatile LAS unsigned* st) {
    XcdBarrier b; b.bar = bar; b.x = xb_xcc_id(); b.st = st;
    if (threadIdx.x == 0) (void)xb_add(&bar[XB_XCNT(b.x)], 1u);
    return b;
}
__device__ __forceinline__ void xcd_barrier_complete(unsigned* bar, unsigned x, unsigned& nloc, unsigned& nx) {
    const unsigned G = gridDim.x * gridDim.y * gridDim.z;
    unsigned sum, cnt, mine, sp = 0u;
    for (;;) {
        sum = 0u; cnt = 0u; mine = 0u;
#pragma unroll
        for (unsigned j = 0; j < 16; ++j) { const unsigned c = xb_ld(&bar[XB_XCNT(j)]); sum += c; cnt += (c > 0u) ? 1u : 0u; mine = (j == x) ? c : mine; }
        if (sum == G) break;
        __builtin_amdgcn_s_sleep(1);
        if ((++sp & 255u) == 0u) { if (xb_ld(&bar[XB_TMO])) break; if (sp > XB_SPIN_CAP) { atomicAdd(&bar[XB_TMO], 1u); break; } }
    }
    nloc = mine > 0u ? mine : 1u; nx = cnt > 0u ? cnt : 1u;
}

__device__ __forceinline__ void xcd_barrier(const XcdBarrier& b) {
    asm volatile("s_waitcnt vmcnt(0)" ::: "memory");
    __syncthreads();
    if (threadIdx.x == 0) {
        unsigned* bar = b.bar;
        __builtin_amdgcn_s_waitcnt(0);
        unsigned nloc = b.st[0], nx = b.st[1];
        if (nloc == 0u) { xcd_barrier_complete(bar, b.x, nloc, nx); b.st[0] = nloc; b.st[1] = nx; }
        const unsigned old = xb_add(&bar[XB_XSUB(b.x)], 1u);
        const unsigned gen = old / nloc;
        if (old + 1u == (gen + 1u) * nloc) {
            __builtin_amdgcn_fence(__ATOMIC_RELEASE, "agent");
            asm volatile("s_waitcnt vmcnt(0)" ::: "memory");
            const unsigned og = xb_add(&bar[XB_TOP], 1u);
            const unsigned tg = og / nx;
            if (og + 1u == (tg + 1u) * nx) xb_add(&bar[XB_TOPGEN], 1u);
            else XB_SPIN(xb_ld(&bar[XB_TOPGEN]) == tg, bar);
            __builtin_amdgcn_fence(__ATOMIC_ACQUIRE, "agent");
            xb_add(&bar[XB_XGEN(b.x)], 1u);
            asm volatile("s_waitcnt vmcnt(0)" ::: "memory");
        } else {
            XB_SPIN(xb_ld(&bar[XB_XGEN(b.x)]) == gen, bar);
            __builtin_amdgcn_fence(__ATOMIC_ACQUIRE, "agent");
            asm volatile("s_waitcnt vmcnt(0)" ::: "memory");
        }
    }
    __syncthreads();
}

struct EpiResidNorm {
    static constexpr bool PERM = true, AFTER_DRAIN = true;
    const bf16* basexb; float* out; float* part; const float* gfin; float alpha; XcdBarrier xb;
    __device__ __forceinline__ void fused(pg8::f32x4 (&acc)[2][2][4][2], const pg8::Unit& u, int wr, int wc, int fr, int fq, LAS unsigned char* lds, int wid, int lane) const {
        const int row0 = u.pm * pg8::BM + wr * 64 + fr; const int col0 = u.pn * pg8::BM + wc * 32 + 8 * fq;
#pragma unroll
        for (int ai = 0; ai < 2; ++ai)
#pragma unroll
            for (int m = 0; m < 4; ++m) { const int row = row0 + ai * pg8::HALF + m * 16; float ss = 0.f;
#pragma unroll
                for (int bj = 0; bj < 2; ++bj) { const size_t off = (size_t)row * 1024 + col0 + bj * pg8::HALF;
                    const v4u r = *(const v4u*)(basexb + off);
                    const pg8::f32x4 b0 = (pg8::f32x4){__builtin_bit_cast(float, r.x << 16), __builtin_bit_cast(float, r.x & 0xffff0000u), __builtin_bit_cast(float, r.y << 16), __builtin_bit_cast(float, r.y & 0xffff0000u)};
                    const pg8::f32x4 b1 = (pg8::f32x4){__builtin_bit_cast(float, r.z << 16), __builtin_bit_cast(float, r.z & 0xffff0000u), __builtin_bit_cast(float, r.w << 16), __builtin_bit_cast(float, r.w & 0xffff0000u)};
                    const pg8::f32x4 v0 = b0 + acc[ai][bj][m][0] * alpha, v1 = b1 + acc[ai][bj][m][1] * alpha;
                    acc[ai][bj][m][0] = v0; acc[ai][bj][m][1] = v1;
                    ss += ((v0[0] * v0[0] + v0[1] * v0[1]) + (v0[2] * v0[2] + v0[3] * v0[3])) + ((v1[0] * v1[0] + v1[1] * v1[1]) + (v1[2] * v1[2] + v1[3] * v1[3])); }
                ss += __shfl_xor(ss, 16); ss += __shfl_xor(ss, 32);
                if (fq == 0) part[(size_t)row * 16 + u.pn * 4 + wc] = ss; }
        xcd_barrier(xb);
#pragma unroll
        for (int ai = 0; ai < 2; ++ai)
#pragma unroll
            for (int m = 0; m < 4; ++m) { const int row = row0 + ai * pg8::HALF + m * 16; const float rs = pg8::row_rstd(part, row);
#pragma unroll
                for (int bj = 0; bj < 2; ++bj) { const size_t off = (size_t)row * 1024 + col0 + bj * pg8::HALF;
                    const pg8::f32x4 g0 = *(const pg8::f32x4*)(gfin + col0 + bj * pg8::HALF), g1 = *(const pg8::f32x4*)(gfin + col0 + bj * pg8::HALF + 4);
                    *(pg8::f32x4*)(out + off) = acc[ai][bj][m][0] * rs * g0; *(pg8::f32x4*)(out + off + 4) = acc[ai][bj][m][1] * rs * g1; } }
    }
};
constexpr int RSTD_OFF = 131072 + 1024;
__device__ __forceinline__ void rstd_table(const float* part, LAS unsigned char* lds, const pg8::StaticOrder& S) {
    LAS float* T = (LAS float*)(lds + RSTD_OFF);
    const int tid = threadIdx.x;
#pragma unroll
    for (int pass = 0; pass < 3; ++pass) { const int i = 2 * pass + (tid >> 8); pg8::Unit u; if (S.next(i, u)) T[i * 256 + (tid & 255)] = pg8::row_rstd(part, u.pm * 256 + (tid & 255)); }
    __syncthreads();
}
struct Args { const float* in[18]; float* out; unsigned char* ws; int ph_lo, ph_hi; };

constexpr int I_G = (DM / 64) * (FF / 64), I_D = (FF / 64) * (DM / 64), I_ABIN = (DM / 64) * (ABIN / 64), I_SQ = (DM / 64) * (DM / 64), I_CIN = (DM / 64) * (CIN / 64);
__device__ __forceinline__ constexpr int mat_items(int id) { return id < 0 ? 0 : id < 4 ? 2 * I_G : id < 8 ? I_D : id == 8 ? I_ABIN : id == 10 ? I_CIN : I_SQ; }
__device__ __forceinline__ void conv_item(const Args& A, LAS unsigned char* scr, int lane, int id, int r) {
    unsigned char* ws = A.ws;
    if (id < 4) { const int f = id, layer = f >> 1, second = f & 1; const float* gain = A.in[second ? 6 : 1] + layer * DM; bf16* wgu = (bf16*)(ws + ws_wgu(f));
        if (r < I_G) p0_transpose_item(A.in[second ? 7 : 2] + (size_t)layer * DM * FF, DM, FF, wgu, 1, gain, scr, r, lane);
        else p0_transpose_item(A.in[second ? 8 : 3] + (size_t)layer * DM * FF, DM, FF, wgu, 2, gain, scr, r - I_G, lane); }
    else if (id < 8) { const int f = id - 4, layer = f >> 1, second = f & 1; p0_transpose_item(A.in[second ? 9 : 4] + (size_t)layer * FF * DM, FF, DM, (bf16*)(ws + ws_wd(f)), 0, nullptr, scr, r, lane); }
    else if (id == 8) p0_transpose_item(A.in[10], DM, ABIN, (bf16*)(ws + WS_WABIN), 0, A.in[5], scr, r, lane);
    else if (id == 9) p0_transpose_item(A.in[14], DM, DM, (bf16*)(ws + WS_WABOUT), 0, nullptr, scr, r, lane);
    else if (id == 10) p0_transpose_item(A.in[15], DM, CIN, (bf16*)(ws + WS_WCIN), 0, A.in[5] + DM, scr, r, lane);
    else p0_transpose_item(A.in[16], DM, DM, (bf16*)(ws + WS_WCOUT), 0, nullptr, scr, r, lane);
}
__device__ __forceinline__ void conv_set(const Args& A, LAS unsigned char* lds, int wave, int lane, int gw, int NGW, int id0, int id1, int id2) {
    LAS unsigned char* scr = lds + wave * 16384;
    const int n0 = mat_items(id0), n1 = mat_items(id1), n2 = mat_items(id2);
    for (int it = gw; it < n0 + n1 + n2; it += NGW) {
        if (it < n0) conv_item(A, scr, lane, id0, it); else if (it < n0 + n1) conv_item(A, scr, lane, id1, it - n0); else conv_item(A, scr, lane, id2, it - n0 - n1); }
}
__device__ __forceinline__ void conv_idle(const Args& A, LAS unsigned char* lds, int id0, int id1, int id2) {
    if (blockIdx.x >= 128) { const int tid_ = threadIdx.x; conv_set(A, lds, __builtin_amdgcn_readfirstlane(tid_ >> 6), tid_ & 63, ((int)blockIdx.x - 128) * NWAVES + (tid_ >> 6), ((int)gridDim.x - 128) * NWAVES, id0, id1, id2); }
}
__device__ __forceinline__ void phase_prologue(const Args& A, LAS unsigned char* lds, int wave, int lane) {
    const int gw = blockIdx.x * NWAVES + wave, NGW = gridDim.x * NWAVES;
    unsigned char* ws = A.ws;
    conv_set(A, lds, wave, lane, gw, NGW, 0, 4, 3);
    { const float* wsp = A.in[12]; bf16* o = (bf16*)(ws + WS_WSB);
      for (int i = blockIdx.x * NTHR + threadIdx.x; i < 4 * 128 * 128; i += gridDim.x * NTHR) { const int p = (i >> 7) & 127, q = i & 127; o[i] = (bf16)f2bf(q <= p ? wsp[i] : 0.f); } }
    const float* x = A.in[0]; bf16* xb = (bf16*)(ws + WS_XB); float* part = (float*)(ws + WS_PART);
    for (int m = gw; m < M; m += NGW) {
        const f32x4* xr = (const f32x4*)(x + (size_t)m * DM) + lane; f32x4 v[4]; float s = 0.f;
#pragma unroll
        for (int j = 0; j < 4; ++j) { v[j] = xr[64 * j]; s += (v[j][0] * v[j][0] + v[j][1] * v[j][1]) + (v[j][2] * v[j][2] + v[j][3] * v[j][3]); }
        s = wave_sum(s);
        v2u* o8 = (v2u*)(xb + (size_t)m * DM) + lane;
#pragma unroll
        for (int j = 0; j < 4; ++j) { v2u w; w.x = pk2(v[j][0], v[j][1]); w.y = pk2(v[j][2], v[j][3]); o8[64 * j] = w; }
        if (lane < 16) part[(size_t)m * 16 + lane] = (lane == 0) ? s : 0.f;
    }
}

constexpr int GV_STRIDE = 272;
__device__ __forceinline__ void gate_unit(const Args& A, LAS unsigned char* lds, int unit, int wave, int lane) {
    const int g4 = unit & 3, n = (unit >> 2) & 63, b = unit >> 8;
    const size_t R0 = (size_t)b * SEQ + (size_t)n * 128;
    const bf16* Z = (const bf16*)(A.ws + WS_ACT); bf16* MIX = (bf16*)(A.ws + WS_MIX); const bf16* WsB = (const bf16*)(A.ws + WS_WSB) + (size_t)g4 * 128 * 128;
    const float* vnorm = A.in[11] + g4 * 128; const float* bsp = A.in[13] + g4 * 128;
    const int tid = threadIdx.x;
    { const int row = tid >> 2, qt = tid & 3; const bf16* vp = Z + (R0 + row) * ABIN + 2048 + 128 * g4 + 32 * qt;
      float v[32]; float ss = 0.f;
#pragma unroll
      for (int i = 0; i < 4; ++i) { const bf16x8 raw = *(const bf16x8*)(vp + 8 * i);
#pragma unroll
          for (int e = 0; e < 8; ++e) { const float gl = gelu_tanh(bf2f((unsigned short)raw[e])); v[8 * i + e] = gl; ss += gl * gl; } }
      ss += __shfl_xor(ss, 1); ss += __shfl_xor(ss, 2);
      const float rs = rsqrtf(ss * (1.0f / 128.0f) + 1e-6f);
#pragma unroll
      for (int i = 0; i < 4; ++i) { const f32x4 g0 = *(const f32x4*)(vnorm + 32 * qt + 8 * i), g1 = *(const f32x4*)(vnorm + 32 * qt + 8 * i + 4);
          v4u w; w.x = pk2(v[8 * i] * rs * g0[0], v[8 * i + 1] * rs * g0[1]); w.y = pk2(v[8 * i + 2] * rs * g0[2], v[8 * i + 3] * rs * g0[3]);
          w.z = pk2(v[8 * i + 4] * rs * g1[0], v[8 * i + 5] * rs * g1[1]); w.w = pk2(v[8 * i + 6] * rs * g1[2], v[8 * i + 7] * rs * g1[3]);
          *(LAS v4u*)(lds + row * GV_STRIDE + qt * 64 + i * 16) = w; } }
    __syncthreads();
    const int pl = lane & 15, g = lane >> 4, qq = pl >> 2, pp = pl & 3;
    f32x4 acc[8];
#pragma unroll
    for (int cb = 0; cb < 8; ++cb) acc[cb] = (f32x4){0.f, 0.f, 0.f, 0.f};
    const int nks = (16 * wave + 15) / 32 + 1;
    for (int ks = 0; ks < nks; ++ks) {
        const bf16x8 bfrag = *(const bf16x8*)(WsB + (size_t)(16 * wave + pl) * 128 + 32 * ks + 8 * g);
        LAS unsigned char* base = lds + (32 * ks + 8 * g + qq) * GV_STRIDE + pp * 8;
#pragma unroll
        for (int cb = 0; cb < 8; ++cb) {
            const s16x4 lo = __builtin_bit_cast(s16x4, __builtin_amdgcn_ds_read_tr16_b64_v4i16((LAS s16x4*)(base + cb * 32)));
            const s16x4 hi = __builtin_bit_cast(s16x4, __builtin_amdgcn_ds_read_tr16_b64_v4i16((LAS s16x4*)(base + cb * 32 + 4 * GV_STRIDE)));
            const bf16x8 afrag = (bf16x8){lo[0], lo[1], lo[2], lo[3], hi[0], hi[1], hi[2], hi[3]};
            acc[cb] = __builtin_amdgcn_mfma_f32_16x16x32_bf16(afrag, bfrag, acc[cb], 0, 0, 0);
        }
    }
    { const int p = 16 * wave + pl; const float bias = bsp[p];
      const bf16* up = Z + (R0 + p) * ABIN + 1536 + 128 * g4 + 4 * g; bf16* op = MIX + (R0 + p) * DM + 512 + 128 * g4 + 4 * g;
#pragma unroll
      for (int cb = 0; cb < 8; ++cb) { const s16x4 ur = *(const s16x4*)(up + 16 * cb);
          v2u w; w.x = pk2(gelu_tanh(bf2f((unsigned short)ur[0])) * (acc[cb][0] + bias), gelu_tanh(bf2f((unsigned short)ur[1])) * (acc[cb][1] + bias));
          w.y = pk2(gelu_tanh(bf2f((unsigned short)ur[2])) * (acc[cb][2] + bias), gelu_tanh(bf2f((unsigned short)ur[3])) * (acc[cb][3] + bias));
          *(v2u*)(op + 16 * cb) = w; } }
    __syncthreads();
}

constexpr int DV_STRIDE = 160, DV_BUF = 32 * DV_STRIDE;
__device__ __forceinline__ void dil_unit(const Args& A, LAS unsigned char* vl, int unit, int lane) {
    const int r16 = unit & 15, sp = (unit >> 4) & 31, h = (unit >> 9) & 7, b = unit >> 12;
    const bf16* Z = (const bf16*)(A.ws + WS_ACT); bf16* MIX = (bf16*)(A.ws + WS_MIX);
    const int qi = lane & 15, g = lane >> 4, T0 = sp * 256;
    const size_t rowb = (size_t)b * SEQ;
    const int tq = T0 + r16 + 16 * qi;
    const bf16* qp = Z + (rowb + tq) * ABIN + h * 64 + 8 * g;
    const bf16x8 qf0 = *(const bf16x8*)qp, qf1 = *(const bf16x8*)(qp + 32);
    const bf16* Kb = Z + rowb * ABIN + 512 + h * 64 + 8 * g;
    const bf16* Vb = Z + rowb * ABIN + 1024 + h * 64 + 8 * (lane & 7);
    float mrun = -INFINITY, lrun = 0.f; f32x4 o[4];
#pragma unroll
    for (int d = 0; d < 4; ++d) o[d] = (f32x4){0.f, 0.f, 0.f, 0.f};
    const int tb = T0 + r16;
    constexpr int DIL_D = 3;
    bf16x8 kn[DIL_D][4], vn[DIL_D][4];
#define DIL_PARAMS(it, dsh, j) const int dsh = ((it) < 12) ? 0 : ((it) < 18) ? 2 : 4; const int j = (it) - (((it) < 12) ? 0 : ((it) < 18) ? 12 : 18);
#define DIL_LOAD(it, S) do { DIL_PARAMS(it, dsh_, j_) const int c_ = tb & ((1 << dsh_) - 1), skb_ = (tb >> dsh_) - 128 + 32 * j_; \
        _Pragma("unroll") for (int s_ = 0; s_ < 2; ++s_) { int t_ = c_ + ((skb_ + 16 * s_ + qi) << dsh_); t_ = t_ < 0 ? 0 : (t_ > SEQ - 1 ? SEQ - 1 : t_); \
            kn[S][2 * s_] = *(const bf16x8*)(Kb + (size_t)t_ * ABIN); kn[S][2 * s_ + 1] = *(const bf16x8*)(Kb + (size_t)t_ * ABIN + 32); } \
        _Pragma("unroll") for (int i_ = 0; i_ < 4; ++i_) { int t_ = c_ + ((skb_ + (lane >> 3) + 8 * i_) << dsh_); t_ = t_ < 0 ? 0 : (t_ > SEQ - 1 ? SEQ - 1 : t_); \
            vn[S][i_] = *(const bf16x8*)(Vb + (size_t)t_ * ABIN); } } while (0)
#pragma unroll
    for (int p = 0; p < DIL_D; ++p) DIL_LOAD(p, p);
#pragma nounroll
    for (int it0 = 0; it0 < 24; it0 += DIL_D) {
#pragma unroll
      for (int S = 0; S < DIL_D; ++S) { const int it = it0 + S; if (it < 23) {
        LAS unsigned char* buf = vl + (it & 1) * DV_BUF;
        const bf16x8 k0 = kn[S][0], k1 = kn[S][1], k2 = kn[S][2], k3 = kn[S][3];
#pragma unroll
        for (int i = 0; i < 4; ++i) *(LAS bf16x8*)(buf + ((lane >> 3) + 8 * i) * DV_STRIDE + (lane & 7) * 16) = vn[S][i];
        if (it + DIL_D < 23) DIL_LOAD(it + DIL_D, S);
        DIL_PARAMS(it, dsh, j)
        const int skb = (tb >> dsh) - 128 + 32 * j, sq = (tb >> dsh) + ((16 >> dsh) * qi);
        f32x4 sa = (f32x4){0.f, 0.f, 0.f, 0.f}, sb = (f32x4){0.f, 0.f, 0.f, 0.f};
        sa = __builtin_amdgcn_mfma_f32_16x16x32_bf16(k0, qf0, sa, 0, 0, 0); sa = __builtin_amdgcn_mfma_f32_16x16x32_bf16(k1, qf1, sa, 0, 0, 0);
        sb = __builtin_amdgcn_mfma_f32_16x16x32_bf16(k2, qf0, sb, 0, 0, 0); sb = __builtin_amdgcn_mfma_f32_16x16x32_bf16(k3, qf1, sb, 0, 0, 0);
        float mx = -INFINITY;
#pragma unroll
        for (int e = 0; e < 4; ++e) { const int ska = skb + 4 * g + e, skq = ska + 16;
            const bool va = (ska >= 0) && (ska <= sq) && (sq - ska <= 128), vb = (skq >= 0) && (skq <= sq) && (sq - skq <= 128);
            sa[e] = va ? sa[e] : -INFINITY; sb[e] = vb ? sb[e] : -INFINITY; mx = fmaxf(mx, fmaxf(sa[e], sb[e])); }
        mx = fmaxf(mx, __shfl_xor(mx, 16)); mx = fmaxf(mx, __shfl_xor(mx, 32));
        const float mnew = fmaxf(mrun, mx), muse = (mnew == -INFINITY) ? 0.f : mnew;
        const float alpha = __builtin_amdgcn_exp2f(mrun - muse);
        float ps = 0.f; float pa[4], pb[4];
#pragma unroll
        for (int e = 0; e < 4; ++e) { pa[e] = __builtin_amdgcn_exp2f(sa[e] - muse); pb[e] = __builtin_amdgcn_exp2f(sb[e] - muse); ps += pa[e] + pb[e]; }
        lrun = lrun * alpha + ps; mrun = mnew;
        v4u pw; pw.x = pk2(pa[0], pa[1]); pw.y = pk2(pa[2], pa[3]); pw.z = pk2(pb[0], pb[1]); pw.w = pk2(pb[2], pb[3]);
        const bf16x8 pf = __builtin_bit_cast(bf16x8, pw);
        asm volatile("s_waitcnt lgkmcnt(0)" ::: "memory");
        LAS unsigned char* rb = buf + (4 * g + (qi >> 2)) * DV_STRIDE + (qi & 3) * 8;
#pragma unroll
        for (int db = 0; db < 4; ++db) {
            const s16x4 lo = __builtin_bit_cast(s16x4, __builtin_amdgcn_ds_read_tr16_b64_v4i16((LAS s16x4*)(rb + db * 32)));
            const s16x4 hi = __builtin_bit_cast(s16x4, __builtin_amdgcn_ds_read_tr16_b64_v4i16((LAS s16x4*)(rb + db * 32 + 16 * DV_STRIDE)));
            const bf16x8 vf = (bf16x8){lo[0], lo[1], lo[2], lo[3], hi[0], hi[1], hi[2], hi[3]};
            o[db] = o[db] * alpha;
            o[db] = __builtin_amdgcn_mfma_f32_16x16x32_bf16(vf, pf, o[db], 0, 0, 0);
        }
    } } }
#undef DIL_LOAD
#undef DIL_PARAMS
    lrun += __shfl_xor(lrun, 16); lrun += __shfl_xor(lrun, 32);
    const float inv = 1.0f / lrun;
    bf16* op = MIX + (rowb + tq) * DM + h * 64 + 4 * g;
#pragma unroll
    for (int db = 0; db < 4; ++db) { v2u w; w.x = pk2(o[db][0] * inv, o[db][1] * inv); w.y = pk2(o[db][2] * inv, o[db][3] * inv); *(v2u*)(op + 16 * db) = w; }
}

constexpr int DS_OFF = 16 * DV_BUF, DS_STRIDE = 144;
__device__ __forceinline__ void dil_wg_unit(const Args& A, LAS unsigned char* lds, int unit, int wave, int lane) {
    const int sp = unit & 31, h = (unit >> 5) & 7, b = unit >> 8;
    const bf16* Z = (const bf16*)(A.ws + WS_ACT); bf16* MIX = (bf16*)(A.ws + WS_MIX);
    const int qi = lane & 15, g = lane >> 4, T0 = sp * 256;
    const size_t rowb = (size_t)b * SEQ;
    const bf16* Kb = Z + rowb * ABIN + 512 + h * 64 + 8 * g;
    const bf16* Vb = Z + rowb * ABIN + 1024 + h * 64 + 8 * (lane & 7);
    LAS unsigned char* ST = lds + DS_OFF;
#pragma unroll 1
    for (int stage = 0; stage < 3; ++stage) {
        const int dsh = 4 - 2 * stage;
        int tbg[2]; bf16x8 qf[2][2]; float mrun[2], lrun[2]; f32x4 o[2][4];
#pragma unroll
        for (int k = 0; k < 2; ++k) { const int G = 2 * wave + k; tbg[k] = T0 + (stage == 0 ? G : stage == 1 ? 64 * (G >> 2) + (G & 3) : 16 * G);
            const bf16* qp = Z + (rowb + tbg[k] + (qi << dsh)) * ABIN + h * 64 + 8 * g; qf[k][0] = *(const bf16x8*)qp; qf[k][1] = *(const bf16x8*)(qp + 32); }
        bf16x8 kn[2][4], vn[2][4];
#define DW_LOAD(jt_) do { _Pragma("unroll") for (int k_ = 0; k_ < 2; ++k_) { const int c_ = tbg[k_] & ((1 << dsh) - 1), skb_ = (tbg[k_] >> dsh) - 128 + 32 * (jt_); \
        _Pragma("unroll") for (int i_ = 0; i_ < 4; ++i_) { int t_ = c_ + ((skb_ + (lane >> 3) + 8 * i_) << dsh); t_ = t_ < 0 ? 0 : (t_ > SEQ - 1 ? SEQ - 1 : t_); \
            kn[k_][i_] = *(const bf16x8*)(Vb + (size_t)t_ * ABIN - 512); vn[k_][i_] = *(const bf16x8*)(Vb + (size_t)t_ * ABIN); } } } while (0)
        DW_LOAD(0);
#pragma unroll
        for (int k = 0; k < 2; ++k) { LAS unsigned char* sq_p = ST + (tbg[k] + (qi << dsh) - T0) * DS_STRIDE;
            if (stage == 0) { mrun[k] = -INFINITY; lrun[k] = 0.f;
#pragma unroll
                for (int d = 0; d < 4; ++d) o[k][d] = (f32x4){0.f, 0.f, 0.f, 0.f}; }
            else { mrun[k] = *(LAS float*)(sq_p + 128); lrun[k] = (g == 0) ? *(LAS float*)(sq_p + 132) : 0.f;
#pragma unroll
                for (int d = 0; d < 4; ++d) { const s16x4 r = *(LAS s16x4*)(sq_p + (16 * d + 4 * g) * 2); o[k][d] = (f32x4){bf2f((unsigned short)r[0]), bf2f((unsigned short)r[1]), bf2f((unsigned short)r[2]), bf2f((unsigned short)r[3])}; } } }
#pragma nounroll
        for (int jt = 0; jt < 5; ++jt) {
            bf16x8 kc[2][4], vc[2][4];
#pragma unroll
            for (int k = 0; k < 2; ++k) { LAS unsigned char* vbuf = lds + (wave * 2 + k) * DV_BUF;
#pragma unroll
                for (int i = 0; i < 4; ++i) { vc[k][i] = vn[k][i]; *(LAS bf16x8*)(vbuf + ((lane >> 3) + 8 * i) * DV_STRIDE + (lane & 7) * 16) = kn[k][i]; } }
            if (jt + 1 < 5) DW_LOAD(jt + 1);
            asm volatile("s_waitcnt lgkmcnt(0)" ::: "memory");
#pragma unroll
            for (int k = 0; k < 2; ++k) { LAS unsigned char* kb_ = lds + (wave * 2 + k) * DV_BUF + qi * DV_STRIDE + 16 * g;
                kc[k][0] = *(LAS bf16x8*)(kb_); kc[k][1] = *(LAS bf16x8*)(kb_ + 64); kc[k][2] = *(LAS bf16x8*)(kb_ + 16 * DV_STRIDE); kc[k][3] = *(LAS bf16x8*)(kb_ + 16 * DV_STRIDE + 64); }
            asm volatile("s_waitcnt lgkmcnt(0)" ::: "memory");
#pragma unroll
            for (int k = 0; k < 2; ++k) { LAS unsigned char* vbuf = lds + (wave * 2 + k) * DV_BUF;
#pragma unroll
                for (int i = 0; i < 4; ++i) *(LAS bf16x8*)(vbuf + ((lane >> 3) + 8 * i) * DV_STRIDE + (lane & 7) * 16) = vc[k][i]; }
            f32x4 sa[2], sb[2]; float alpha[2]; bf16x8 pf[2];
#pragma unroll
            for (int k = 0; k < 2; ++k) {
                sa[k] = (f32x4){0.f, 0.f, 0.f, 0.f}; sb[k] = sa[k];
                sa[k] = __builtin_amdgcn_mfma_f32_16x16x32_bf16(kc[k][0], qf[k][0], sa[k], 0, 0, 0); sa[k] = __builtin_amdgcn_mfma_f32_16x16x32_bf16(kc[k][1], qf[k][1], sa[k], 0, 0, 0);
                sb[k] = __builtin_amdgcn_mfma_f32_16x16x32_bf16(kc[k][2], qf[k][0], sb[k], 0, 0, 0); sb[k] = __builtin_amdgcn_mfma_f32_16x16x32_bf16(kc[k][3], qf[k][1], sb[k], 0, 0, 0); }
#pragma unroll
            for (int k = 0; k < 2; ++k) {
                const int skb = (tbg[k] >> dsh) - 128 + 32 * jt, sq = (tbg[k] >> dsh) + qi;
                float mx = -INFINITY;
#pragma unroll
                for (int e = 0; e < 4; ++e) { const int ska = skb + 4 * g + e, skq = ska + 16;
                    const bool va = (ska >= 0) && (ska <= sq) && (sq - ska <= 128), vb = (skq >= 0) && (skq <= sq) && (sq - skq <= 128);
                    sa[k][e] = va ? sa[k][e] : -INFINITY; sb[k][e] = vb ? sb[k][e] : -INFINITY; mx = fmaxf(mx, fmaxf(sa[k][e], sb[k][e])); }
                mx = fmaxf(mx, __shfl_xor(mx, 16)); mx = fmaxf(mx, __shfl_xor(mx, 32));
                const float mnew = fmaxf(mrun[k], mx), muse = (mnew == -INFINITY) ? 0.f : mnew;
                alpha[k] = __builtin_amdgcn_exp2f(mrun[k] - muse);
                float ps = 0.f; float pa[4], pb[4];
#pragma unroll
                for (int e = 0; e < 4; ++e) { pa[e] = __builtin_amdgcn_exp2f(sa[k][e] - muse); pb[e] = __builtin_amdgcn_exp2f(sb[k][e] - muse); ps += pa[e] + pb[e]; }
                lrun[k] = lrun[k] * alpha[k] + ps; mrun[k] = mnew;
                v4u pw; pw.x = pk2(pa[0], pa[1]); pw.y = pk2(pa[2], pa[3]); pw.z = pk2(pb[0], pb[1]); pw.w = pk2(pb[2], pb[3]);
                pf[k] = __builtin_bit_cast(bf16x8, pw); }
            asm volatile("s_waitcnt lgkmcnt(0)" ::: "memory");
#pragma unroll
            for (int k = 0; k < 2; ++k) { LAS unsigned char* rb = lds + (wave * 2 + k) * DV_BUF + (4 * g + (qi >> 2)) * DV_STRIDE + (qi & 3) * 8;
#pragma unroll
                for (int db = 0; db < 4; ++db) {
                    const s16x4 lo = __builtin_bit_cast(s16x4, __builtin_amdgcn_ds_read_tr16_b64_v4i16((LAS s16x4*)(rb + db * 32)));
                    const s16x4 hi = __builtin_bit_cast(s16x4, __builtin_amdgcn_ds_read_tr16_b64_v4i16((LAS s16x4*)(rb + db * 32 + 16 * DV_STRIDE)));
                    const bf16x8 vf = (bf16x8){lo[0], lo[1], lo[2], lo[3], hi[0], hi[1], hi[2], hi[3]};
                    o[k][db] = o[k][db] * alpha[k];
                    o[k][db] = __builtin_amdgcn_mfma_f32_16x16x32_bf16(vf, pf[k], o[k][db], 0, 0, 0);
                } }
            asm volatile("s_waitcnt lgkmcnt(0)" ::: "memory");
        }
#undef DW_LOAD
#pragma unroll
        for (int k = 0; k < 2; ++k) { const int qpos = tbg[k] + (qi << dsh) - T0; LAS unsigned char* sq_p = ST + qpos * DS_STRIDE;
            float lt = lrun[k]; lt += __shfl_xor(lt, 16); lt += __shfl_xor(lt, 32);
            if (stage < 2) {
#pragma unroll
                for (int d = 0; d < 4; ++d) { v2u w; w.x = pk2(o[k][d][0], o[k][d][1]); w.y = pk2(o[k][d][2], o[k][d][3]); *(LAS v2u*)(sq_p + (16 * d + 4 * g) * 2) = w; }
                if (g == 0) { *(LAS float*)(sq_p + 128) = mrun[k]; *(LAS float*)(sq_p + 132) = lt; }
            } else {
                const float inv = 1.0f / lt;
                bf16* op = MIX + (rowb + T0 + qpos) * DM + h * 64 + 4 * g;
#pragma unroll
                for (int db = 0; db < 4; ++db) { v2u w; w.x = pk2(o[k][db][0] * inv, o[k][db][1] * inv); w.y = pk2(o[k][db][2] * inv, o[k][db][3] * inv); *(v2u*)(op + 16 * db) = w; }
            } }
        __syncthreads();
    }
}
__device__ __forceinline__ void select_phase(const Args& A, LAS unsigned char* lds, int wave, int lane) {
    LAS unsigned* lcnt = (LAS unsigned*)lds; LAS unsigned* lbase = lcnt + 32;
    const int tid = threadIdx.x;
    for (int k = 0; k < 2; ++k) {
        const int U = blockIdx.x + 256 * k, bh = (U >> 4) & 31, c16 = k ? 15 - (U & 15) : (U & 15), b = bh >> 4, h = bh & 15;
        const int ch = c16 * 8 + wave, t = ch * 64 + lane, own = ch >> 2;
        if (tid < 32) lcnt[tid] = 0u;
        __syncthreads();
        unsigned mask = 0u; int i1 = -1, i2 = -1, i3 = -1;
        if (own > 0) {
            const bf16* qp = (const bf16*)(A.ws + WS_ACT) + ((size_t)b * SEQ + t) * DM + h * 64;
            float q[64];
#pragma unroll
            for (int i = 0; i < 8; ++i) { const bf16x8 raw = *(const bf16x8*)(qp + 8 * i);
#pragma unroll
                for (int e = 0; e < 8; ++e) q[8 * i + e] = bf2f((unsigned short)raw[e]); }
            const float* km = (const float*)(A.ws + WS_KM) + (size_t)(b * 32) * 2048 + h * 64 + lane;
            float v1 = -INFINITY, v2 = -INFINITY, v3 = -INFINITY;
            for (int j0 = 0; j0 < own; j0 += 4) {
                float kmv[4];
#pragma unroll
                for (int u = 0; u < 4; ++u) { const int jj = (j0 + u < own) ? j0 + u : own - 1; kmv[u] = km[(size_t)jj * 2048] + km[(size_t)jj * 2048 + 1024]; }
#pragma unroll
                for (int u = 0; u < 4; ++u) { const int j = j0 + u;
                    float s = 0.f;
#pragma unroll
                    for (int d = 0; d < 64; ++d) s += q[d] * __builtin_bit_cast(float, __builtin_amdgcn_readlane(__builtin_bit_cast(int, kmv[u]), d));
                    if (j < own) {
                        if (s > v1) { v3 = v2; i3 = i2; v2 = v1; i2 = i1; v1 = s; i1 = j; }
                        else if (s > v2) { v3 = v2; i3 = i2; v2 = s; i2 = j; }
                        else if (s > v3) { v3 = s; i3 = j; } } }
            }
            if (i1 >= 0) mask |= 1u << i1; if (i2 >= 0) mask |= 1u << i2; if (i3 >= 0) mask |= 1u << i3;
        }
        unsigned p1 = 0, p2 = 0, p3 = 0;
        if (i1 >= 0) p1 = atomicAdd((unsigned*)(lcnt + i1), 1u);
        if (i2 >= 0) p2 = atomicAdd((unsigned*)(lcnt + i2), 1u);
        if (i3 >= 0) p3 = atomicAdd((unsigned*)(lcnt + i3), 1u);
        __syncthreads();
        if (tid < 32) { const unsigned n = lcnt[tid]; lbase[tid] = n ? atomicAdd((unsigned*)(A.ws + WS_CNT) + bh * 32 + tid, n) : 0u; }
        __syncthreads();
        unsigned short* list = (unsigned short*)(A.ws + WS_LIST) + (size_t)bh * 126976;
        if (i1 >= 0) list[256 * (31 * i1 - (i1 * (i1 - 1)) / 2) + lbase[i1] + p1] = (unsigned short)(t | (__popc(mask & ((1u << i1) - 1u)) << 13));
        if (i2 >= 0) list[256 * (31 * i2 - (i2 * (i2 - 1)) / 2) + lbase[i2] + p2] = (unsigned short)(t | (__popc(mask & ((1u << i2) - 1u)) << 13));
        if (i3 >= 0) list[256 * (31 * i3 - (i3 * (i3 - 1)) / 2) + lbase[i3] + p3] = (unsigned short)(t | (__popc(mask & ((1u << i3) - 1u)) << 13));
        ((unsigned*)(A.ws + WS_SEL))[(size_t)bh * SEQ + t] = mask;
        __syncthreads();
    }
}
constexpr int MB_VIRT = 0;
constexpr int MK_STRIDE = 144, MV_STRIDE = 160, MK_OFF = 0, MV_OFF = 256 * MK_STRIDE, MB_CTL = 81920;
__device__ __forceinline__ void moba_stage_load(const Args& A, int bh, int j, bf16x8 (&kk)[4], bf16x8 (&vv)[4]) {
    const int b = bh >> 4, h = bh & 15, row = threadIdx.x >> 3, ch = threadIdx.x & 7;
    const bf16* kp = (const bf16*)(A.ws + WS_ACT) + (size_t)M * DM + ((size_t)b * SEQ + 256 * j + row) * DM + h * 64 + 8 * ch;
    const bf16* vp = kp + (size_t)M * DM;
#pragma unroll
    for (int i = 0; i < 4; ++i) { kk[i] = *(const bf16x8*)(kp + (size_t)64 * i * DM); vv[i] = *(const bf16x8*)(vp + (size_t)64 * i * DM); }
}
__device__ __forceinline__ void moba_stage_store(LAS unsigned char* lds, const bf16x8 (&kk)[4], const bf16x8 (&vv)[4]) {
    const int row = threadIdx.x >> 3, ch = threadIdx.x & 7;
#pragma unroll
    for (int i = 0; i < 4; ++i) { *(LAS bf16x8*)(lds + MK_OFF + (64 * i + row) * MK_STRIDE + 16 * ch) = kk[i]; *(LAS bf16x8*)(lds + MV_OFF + (64 * i + row) * MV_STRIDE + 16 * ch) = vv[i]; }
}
__device__ __forceinline__ void moba_stage(const Args& A, LAS unsigned char* lds, int bh, int j) {
    bf16x8 kk[4], vv[4]; moba_stage_load(A, bh, j, kk, vv); moba_stage_store(lds, kk, vv);
}
__device__ __forceinline__ void moba_block(LAS unsigned char* lds, int ntile, const bf16x8 qf0, const bf16x8 qf1, int qpos, int lane, float& m_out, float& l_out, f32x4 (&o)[4]) {
    const int qi = lane & 15, g = lane >> 4;
    LAS unsigned char* kb = lds + MK_OFF + qi * MK_STRIDE + 16 * g;
    f32x4 sa[8], sb[8];
    float mx = -INFINITY;
#pragma unroll
    for (int t = 0; t < 8; ++t) {
        sa[t] = (f32x4){-INFINITY, -INFINITY, -INFINITY, -INFINITY}; sb[t] = sa[t];
        if (t < ntile) {
            LAS unsigned char* kt = kb + t * 32 * MK_STRIDE;
            const bf16x8 k0 = *(LAS bf16x8*)(kt), k1 = *(LAS bf16x8*)(kt + 64), k2 = *(LAS bf16x8*)(kt + 16 * MK_STRIDE), k3 = *(LAS bf16x8*)(kt + 16 * MK_STRIDE + 64);
            f32x4 a = (f32x4){0.f, 0.f, 0.f, 0.f}, bq = (f32x4){0.f, 0.f, 0.f, 0.f};
            a = __builtin_amdgcn_mfma_f32_16x16x32_bf16(k0, qf0, a, 0, 0, 0); a = __builtin_amdgcn_mfma_f32_16x16x32_bf16(k1, qf1, a, 0, 0, 0);
            bq = __builtin_amdgcn_mfma_f32_16x16x32_bf16(k2, qf0, bq, 0, 0, 0); bq = __builtin_amdgcn_mfma_f32_16x16x32_bf16(k3, qf1, bq, 0, 0, 0);
#pragma unroll
            for (int e = 0; e < 4; ++e) { const int ka = 32 * t + 4 * g + e;
                a[e] = (ka <= qpos) ? a[e] : -INFINITY; bq[e] = (ka + 16 <= qpos) ? bq[e] : -INFINITY; mx = fmaxf(mx, fmaxf(a[e], bq[e])); }
            sa[t] = a; sb[t] = bq;
        }
    }
    mx = fmaxf(mx, __shfl_xor(mx, 16)); mx = fmaxf(mx, __shfl_xor(mx, 32));
    float ps = 0.f;
    LAS unsigned char* rb = lds + MV_OFF + (4 * g + (qi >> 2)) * MV_STRIDE + (qi & 3) * 8;
#pragma unroll
    for (int t = 0; t < 8; ++t) {
        if (t < ntile) {
            float pa[4], pb[4];
#pragma unroll
            for (int e = 0; e < 4; ++e) { pa[e] = __builtin_amdgcn_exp2f(sa[t][e] - mx); pb[e] = __builtin_amdgcn_exp2f(sb[t][e] - mx); ps += pa[e] + pb[e]; }
            v4u pw; pw.x = pk2(pa[0], pa[1]); pw.y = pk2(pa[2], pa[3]); pw.z = pk2(pb[0], pb[1]); pw.w = pk2(pb[2], pb[3]);
            const bf16x8 pf = __builtin_bit_cast(bf16x8, pw);
            LAS unsigned char* rt = rb + t * 32 * MV_STRIDE;
#pragma unroll
            for (int db = 0; db < 4; ++db) {
                const s16x4 lo = __builtin_bit_cast(s16x4, __builtin_amdgcn_ds_read_tr16_b64_v4i16((LAS s16x4*)(rt + db * 32)));
                const s16x4 hi = __builtin_bit_cast(s16x4, __builtin_amdgcn_ds_read_tr16_b64_v4i16((LAS s16x4*)(rt + db * 32 + 16 * MV_STRIDE)));
                const bf16x8 vf = (bf16x8){lo[0], lo[1], lo[2], lo[3], hi[0], hi[1], hi[2], hi[3]};
                o[db] = __builtin_amdgcn_mfma_f32_16x16x32_bf16(vf, pf, o[db], 0, 0, 0);
            }
        }
    }
    m_out = mx; l_out = ps;
}
__device__ __forceinline__ bf16* moba_po(const Args& A, int slot) { return slot == 0 ? (bf16*)(A.ws + WS_MIX) : slot == 1 ? (bf16*)A.out : (bf16*)(A.ws + WS_PO2); }
__device__ __forceinline__ void moba_past_phase(const Args& A, LAS unsigned char* lds, int wave, int lane) {
    LAS unsigned* cntl = (LAS unsigned*)(lds + MB_CTL);
    LAS unsigned* pre = cntl + 1024;
    LAS unsigned* tot = pre + 1025;
    const unsigned* cnt = (const unsigned*)(A.ws + WS_CNT);
    const int tid = threadIdx.x;
    for (int i = tid; i < 1024; i += NTHR) cntl[i] = cnt[i];
    __syncthreads();
    if (tid < 32) { unsigned run = 0; for (int j = 0; j < 32; ++j) { pre[tid * 32 + j] = run; const unsigned n = cntl[tid * 32 + j]; run += n ? ((n + 127u) >> 7) + MB_VIRT : 0u; } tot[tid] = run; }
    __syncthreads();
    if (tid == 0) { unsigned run = 0; for (int b = 0; b < 32; ++b) { const unsigned t = tot[b]; tot[b] = run; run += t; } tot[32] = run; pre[1024] = run; }
    __syncthreads();
    for (int i = tid; i < 1024; i += NTHR) pre[i] += tot[i >> 5];
    __syncthreads();
    const unsigned T = tot[32];
    const unsigned i0 = (unsigned)(((unsigned long long)T * blockIdx.x) / gridDim.x), i1 = (unsigned)(((unsigned long long)T * (blockIdx.x + 1)) / gridDim.x);
    const int qi = lane & 15, g = lane >> 4;
    LAS unsigned short* ents = (LAS unsigned short*)(lds + 98304);
    LAS unsigned short* item_e = (LAS unsigned short*)(lds + 98304 + 24576);
    const int n = (int)(i1 - i0) < 96 ? (int)(i1 - i0) : 96;
    for (int x = tid; x < n * 128; x += NTHR) {
        const unsigned it = i0 + (unsigned)(x >> 7);
        int lo = 0, hi = 1024;
        while (lo < hi) { const int mid = (lo + hi) >> 1; if (pre[mid + 1] > it) hi = mid; else lo = mid + 1; }
        const int e = lo, c = (int)(it - pre[e]), li = c * 128 + (x & 127), j = e & 31;
        const unsigned short* list = (const unsigned short*)(A.ws + WS_LIST) + (size_t)(e >> 5) * 126976 + 256 * (31 * j - (j * (j - 1)) / 2);
        ents[x] = (li < (int)cntl[e]) ? list[li] : (unsigned short)0xFFFF;
        if ((x & 127) == 0) item_e[x >> 7] = (unsigned short)e;
    }
    __syncthreads();
    int cur_e = -1;
#define MB_QP(e_, tq_) ((const bf16*)(A.ws + WS_ACT) + ((size_t)((e_) >> 9) * SEQ + (tq_)) * DM + (((e_) >> 5) & 15) * 64 + 8 * g)
    if (n > 0) {
        int eA = (int)item_e[0]; unsigned entA = ents[wave * 16 + qi];
        bf16x8 qA0, qA1; { const int tq = (entA == 0xFFFFu) ? 0 : (int)(entA & 8191u); qA0 = *(const bf16x8*)MB_QP(eA, tq); qA1 = *(const bf16x8*)(MB_QP(eA, tq) + 32); }
        bf16x8 pkk[4], pvv[4]; bool have_pf = false; int pf_e = -1;
#pragma unroll
        for (int i = 0; i < 4; ++i) { pkk[i] = (bf16x8){0, 0, 0, 0, 0, 0, 0, 0}; pvv[i] = pkk[i]; }
        for (int ii = 0; ii < n; ++ii) {
            const int bh = eA >> 5, j = eA & 31;
            const int iin = (ii + 1 < n) ? ii + 1 : ii;
            const int eB = (int)item_e[iin]; const unsigned entB = ents[iin * 128 + wave * 16 + qi];
            if (eA != cur_e) { __syncthreads(); if (have_pf && pf_e == eA) moba_stage_store(lds, pkk, pvv); else moba_stage(A, lds, bh, j); __syncthreads(); cur_e = eA; have_pf = false; }
            const int tqB = (entB == 0xFFFFu) ? 0 : (int)(entB & 8191u);
            const bf16x8 qB0 = *(const bf16x8*)MB_QP(eB, tqB), qB1 = *(const bf16x8*)(MB_QP(eB, tqB) + 32);
            if (eB != eA) { moba_stage_load(A, eB >> 5, eB & 31, pkk, pvv); have_pf = true; pf_e = eB; }
            float mrun, lrun; f32x4 o[4];
#pragma unroll
            for (int d = 0; d < 4; ++d) o[d] = (f32x4){0.f, 0.f, 0.f, 0.f};
            moba_block(lds, 8, qA0, qA1, 1 << 30, lane, mrun, lrun, o);
            lrun += __shfl_xor(lrun, 16); lrun += __shfl_xor(lrun, 32);
            {
                const bool valA = entA != 0xFFFFu; const int tq = (int)(entA & 8191u), slot = (int)(entA >> 13); const size_t idx = (size_t)bh * SEQ + tq;
                const float inv = 1.0f / lrun;
                bf16* junk = (bf16*)(A.ws + 524288) + threadIdx.x * 64;
                bf16* op = valA ? moba_po(A, slot) + idx * 64 + 16 * g : junk;
#pragma unroll
                for (int hh = 0; hh < 2; ++hh) { v4u w; w.x = pk2(o[2 * hh][0] * inv, o[2 * hh][1] * inv); w.y = pk2(o[2 * hh][2] * inv, o[2 * hh][3] * inv);
                    w.z = pk2(o[2 * hh + 1][0] * inv, o[2 * hh + 1][1] * inv); w.w = pk2(o[2 * hh + 1][2] * inv, o[2 * hh + 1][3] * inv); *(v4u*)(op + 8 * hh) = w; }
                float* lp = (valA && g == 0) ? (float*)(A.ws + WS_LSE) + (size_t)slot * (32 * SEQ) + idx : (float*)(junk + 32);
                *lp = mrun + __builtin_amdgcn_logf(lrun);
            }
            eA = eB; entA = entB; qA0 = qB0; qA1 = qB1;
        }
    }
#undef MB_QP
    __syncthreads();
}
__device__ __forceinline__ void moba_own_phase(const Args& A, LAS unsigned char* lds, int wave, int lane) {
    const int qi = lane & 15, g = lane >> 4;
    int cur_e = -1;
    for (int u = blockIdx.x * 8; u < blockIdx.x * 8 + 8; ++u) {
        const int hf = u & 1, e = u >> 1, bh = e >> 5, j = e & 31;
        if (e != cur_e) { __syncthreads(); moba_stage(A, lds, bh, j); __syncthreads(); cur_e = e; }
        const int qloc = 128 * hf + 16 * wave + qi, tq = 256 * j + qloc;
        const size_t qrow = (size_t)(bh >> 4) * SEQ + tq;
        bf16* qp = (bf16*)(A.ws + WS_ACT) + qrow * DM + (bh & 15) * 64;
        const bf16x8 qf0 = *(const bf16x8*)(qp + 8 * g), qf1 = *(const bf16x8*)(qp + 8 * g + 32);
        float mrun, lrun; f32x4 o[4];
#pragma unroll
        for (int d = 0; d < 4; ++d) o[d] = (f32x4){0.f, 0.f, 0.f, 0.f};
        const size_t idx = (size_t)bh * SEQ + tq;
        const unsigned selm = ((const unsigned*)(A.ws + WS_SEL))[idx];
        const float* lsep = (const float*)(A.ws + WS_LSE) + idx;
        float lsr[3]; s16x4 pr[3][4];
#pragma unroll
        for (int s = 0; s < 3; ++s) { lsr[s] = lsep[(size_t)s * (32 * SEQ)]; const bf16* pp = moba_po(A, s) + idx * 64 + 16 * g;
#pragma unroll
            for (int hh = 0; hh < 2; ++hh) { const bf16x8 r8 = *(const bf16x8*)(pp + 8 * hh);
                pr[s][2 * hh] = (s16x4){r8[0], r8[1], r8[2], r8[3]}; pr[s][2 * hh + 1] = (s16x4){r8[4], r8[5], r8[6], r8[7]}; } }
        const int ntile = (128 * hf + 16 * wave + 15) / 32 + 1;
        moba_block(lds, ntile, qf0, qf1, qloc, lane, mrun, lrun, o);
        lrun += __shfl_xor(lrun, 16); lrun += __shfl_xor(lrun, 32);
        const int nsel = __popc(selm);
        float ls[3]; float mx = mrun;
#pragma unroll
        for (int s = 0; s < 3; ++s) { ls[s] = (s < nsel) ? lsr[s] : -INFINITY; mx = fmaxf(mx, ls[s]); }
        const float w0 = __builtin_amdgcn_exp2f(mrun - mx); float den = lrun * w0;
#pragma unroll
        for (int d = 0; d < 4; ++d) o[d] = o[d] * w0;
#pragma unroll
        for (int s = 0; s < 3; ++s) { const bool on = s < nsel; const float ws_ = on ? __builtin_amdgcn_exp2f(ls[s] - mx) : 0.f; den += ws_;
#pragma unroll
            for (int db = 0; db < 4; ++db) { const s16x4 r = pr[s][db];
                o[db][0] += on ? ws_ * bf2f((unsigned short)r[0]) : 0.f; o[db][1] += on ? ws_ * bf2f((unsigned short)r[1]) : 0.f;
                o[db][2] += on ? ws_ * bf2f((unsigned short)r[2]) : 0.f; o[db][3] += on ? ws_ * bf2f((unsigned short)r[3]) : 0.f; } }
        const float inv = 1.0f / den;
#pragma unroll
        for (int db = 0; db < 4; ++db) { v2u w; w.x = pk2(o[db][0] * inv, o[db][1] * inv); w.y = pk2(o[db][2] * inv, o[db][3] * inv); *(v2u*)(qp + 16 * db + 4 * g) = w; }
    }
    __syncthreads();
}
constexpr int N_PHASES = 17;
#ifndef MK_DENSE_MOBA
#define MK_DENSE_MOBA 0
#endif
#ifndef MK_FUSE_FINAL
#define MK_FUSE_FINAL 1
#endif
#ifndef MK_SINGLE
#define MK_SINGLE 1
#endif
__global__ void __launch_bounds__(NTHR, 2) fwd_megakernel(Args args) {
    extern __shared__ __attribute__((aligned(16))) unsigned char lds_raw[];
    __builtin_assume(__builtin_amdgcn_workitem_id_y() == 0); __builtin_assume(__builtin_amdgcn_workitem_id_z() == 0);
    cg::grid_group grid = cg::this_grid();
    LAS unsigned char* lds = (LAS unsigned char*)lds_raw;
    const int tid = threadIdx.x, lane = tid & 63, wave = __builtin_amdgcn_readfirstlane(tid >> 6);
    const int G = gridDim.x;
    unsigned char* ws = args.ws;
    const int lo = args.ph_lo, hi = args.ph_hi;
    bf16* XB = (bf16*)(ws + WS_XB); float* PART = (float*)(ws + WS_PART); bf16* ACT = (bf16*)(ws + WS_ACT); bf16* MIX = (bf16*)(ws + WS_MIX);
    float* X = args.out;
#define IN(k) (lo <= (k) && (k) < hi)
    volatile LAS unsigned* MISC = (volatile LAS unsigned*)(lds + MISC_OFF);
    if (tid < 32) MISC[tid] = 0u;
    unsigned* barw = (unsigned*)(ws + WS_BAR);
    XcdBarrier xbar; xbar.bar = barw; xbar.x = 0; xbar.st = MISC + 8;
    __syncthreads();
    xbar = xcd_barrier_post(barw, MISC + 8);
    if (lo > 1000) grid.sync();
#ifdef PROBE_REP
#define SEAM(k) do { if (IN(k) && IN((k) + 1)) { for (int s_ = 0; s_ < PROBE_SYNC; ++s_) grid.sync(); } } while (0)
#else
#ifdef MK_TS
#define STAMP(i) do { if (blockIdx.x == 0 && tid == 0) ((unsigned long long*)(ws + 262144))[i] = __builtin_amdgcn_s_memrealtime(); } while (0)
#define SEAM(k) do { if (IN(k) && IN((k) + 1)) xcd_barrier(xbar); STAMP((k) + 1); } while (0)
#else
#define STAMP(i) do { } while (0)
#define SEAM(k) do { if (IN(k) && IN((k) + 1)) xcd_barrier(xbar); } while (0)
#endif
#endif
#define GEMM_GU(f) do { pg8::Gemm g{XB, (const bf16*)(ws + ws_wgu(f)), M, 2 * FF, DM}; pg8::StaticOrder S; S.init(M, 2 * FF, G, (int)blockIdx.x); \
        rstd_table(PART, lds, S); pg8::EpiSwiGLU E{ACT, FF, (const LAS float*)(lds + RSTD_OFF)}; pg8::gemm_phase<pg8::EpiSwiGLU, pg8::StaticOrder, true, true>(lds, g, S, E); } while (0)
#define GEMM_DOWN(f, F32B, basep) do { pg8::Gemm g{ACT, (const bf16*)(ws + ws_wd(f)), M, DM, FF}; pg8::StaticOrder S; S.init(M, DM, G, (int)blockIdx.x); \
        pg8::EpiResid<F32B> E{(basep), XB, PART, 0.5f}; pg8::gemm_phase<pg8::EpiResid<F32B>, pg8::StaticOrder, true, true>(lds, g, S, E); } while (0)
#define GEMM_OUT(Ap, Wp) do { pg8::Gemm g{(Ap), (const bf16*)(ws + (Wp)), M, DM, DM}; pg8::StaticOrder S; S.init(M, DM, G, (int)blockIdx.x); \
        pg8::EpiResid<false> E{nullptr, XB, PART, 1.0f}; pg8::gemm_phase<pg8::EpiResid<false>, pg8::StaticOrder, true, true>(lds, g, S, E); } while (0)

#ifdef PROBE_REP
    for (int rep_ = 0; rep_ < PROBE_REP0; ++rep_) { phase_prologue(args, lds, wave, lane); __syncthreads(); }
#endif
    STAMP(0);
    if (IN(0)) { phase_prologue(args, lds, wave, lane); } SEAM(0);
    if (IN(1)) { GEMM_GU(0); conv_idle(args, lds, 8, 9, 5); } SEAM(1);
    if (IN(2)) { GEMM_DOWN(0, false, nullptr); } SEAM(2);
    if (IN(3)) { pg8::Gemm g{XB, (const bf16*)(ws + WS_WABIN), M, ABIN, DM}; pg8::StaticOrder S; S.init(M, ABIN, G, (int)blockIdx.x);
        rstd_table(PART, lds, S); pg8::EpiProj E{ACT, ABIN, (const LAS float*)(lds + RSTD_OFF), 0, 0, 512, C2, nullptr}; pg8::gemm_phase<pg8::EpiProj, pg8::StaticOrder, true, true>(lds, g, S, E); conv_idle(args, lds, 1, -1, -1); } SEAM(3);
#ifndef NO_MIX
#ifdef PROBE_REP
    for (int rep_ = 0; rep_ < PROBE_REP4; ++rep_)
#endif
    if (IN(4)) {
        for (int u = blockIdx.x; u < 512; u += G) gate_unit(args, lds, u, wave, lane);
        if (G == 256) { for (int r = 0; r < 2; ++r) dil_wg_unit(args, lds, (r << 8) | ((blockIdx.x & 7) << 5) | (blockIdx.x >> 3), wave, lane); }
        else { for (int u = blockIdx.x; u < 512; u += G) dil_wg_unit(args, lds, u, wave, lane); }
    }
#endif
    SEAM(4);
    if (IN(5)) { GEMM_OUT(MIX, WS_WABOUT); } SEAM(5);
    if (IN(6)) { GEMM_GU(1); conv_idle(args, lds, 2, -1, -1); } SEAM(6);
    if (IN(7)) { GEMM_DOWN(1, false, nullptr); } SEAM(7);
    if (IN(8)) { GEMM_GU(2); conv_idle(args, lds, 6, 10, 11); } SEAM(8);
    if (IN(9)) { GEMM_DOWN(2, false, nullptr); } SEAM(9);
    if (IN(10)) { pg8::Gemm g{XB, (const bf16*)(ws + WS_WCIN), M, CIN, DM}; pg8::StaticOrder S; S.init(M, CIN, G, (int)blockIdx.x);
        rstd_table(PART, lds, S); pg8::EpiProj E{ACT, DM, (const LAS float*)(lds + RSTD_OFF), DM, (size_t)M * DM, DM, C2, (float*)(ws + WS_KM)}; pg8::gemm_phase<pg8::EpiProj, pg8::StaticOrder, true, true>(lds, g, S, E); } SEAM(10);
    if (IN(11)) { select_phase(args, lds, wave, lane); }
    SEAM(11);
#if MK_DENSE_MOBA
#ifndef NO_ATTN
    if (IN(12)) {
        const attn_body::AttnTensors AT{(const attn_body::bf16*)ACT, (const attn_body::bf16*)(ACT + (size_t)M * DM), (const attn_body::bf16*)(ACT + (size_t)2 * M * DM), (attn_body::bf16*)ACT, (const unsigned*)(ws + WS_SEL)};
        const attn_body::StaticOrder S(G, (int)blockIdx.x);
        attn_body::attn_phase<attn_body::StaticOrder>((char*)lds_raw, AT, S);
    }
#endif
#else
    if (IN(12)) { moba_past_phase(args, lds, wave, lane); xcd_barrier(xbar); STAMP(20); moba_own_phase(args, lds, wave, lane); }
#endif
    SEAM(12);
    if (IN(13)) { GEMM_OUT(ACT, WS_WCOUT); } SEAM(13);
    if (IN(14)) { GEMM_GU(3); conv_idle(args, lds, 7, -1, -1); } SEAM(14);
#if MK_FUSE_FINAL
    if (IN(15)) { pg8::Gemm g{ACT, (const bf16*)(ws + ws_wd(3)), M, DM, FF}; pg8::StaticOrder S; S.init(M, DM, G, (int)blockIdx.x);
        EpiResidNorm E{XB, X, PART, args.in[17], 0.5f, xbar}; pg8::gemm_phase<EpiResidNorm, pg8::StaticOrder, false, true>(lds, g, S, E); }
#ifdef MK_TS
    xcd_barrier(xbar); STAMP(16);
    if (blockIdx.x == 0 && tid == 0) { const unsigned long long* ts = (const unsigned long long*)(ws + 262144);
        auto dur = [&](int p) -> float { if (p == 100) return (float)(ts[20] - ts[12]) * 0.01f; if (p == 101) return (float)(ts[13] - ts[20]) * 0.01f; if (p == 102) return (float)(ts[16] - ts[0]) * 0.01f; return (float)(ts[p + 1] - ts[p]) * 0.01f; };
        X[0] += dur(MK_TS_A); X[1024 * 1000] += dur(MK_TS_B); }
#endif
#else
    if (IN(15)) { GEMM_DOWN(3, false, nullptr); } SEAM(15);
    if (IN(16)) {
        const float* gn = args.in[17];
        int tid16 = threadIdx.x; asm volatile("" : "+v"(tid16)); const int lane = tid16 & 63, wave = __builtin_amdgcn_readfirstlane(tid16 >> 6);
        for (int m = blockIdx.x * NWAVES + wave; m < M; m += G * NWAVES) {
            f32x4* xr = (f32x4*)(X + (size_t)m * DM) + lane; f32x4 v[4]; float s = 0.f;
#pragma unroll
            for (int j = 0; j < 4; ++j) { v[j] = xr[64 * j]; s += (v[j][0] * v[j][0] + v[j][1] * v[j][1]) + (v[j][2] * v[j][2] + v[j][3] * v[j][3]); }
            const float rs = rsqrtf(wave_sum(s) * (1.0f / DM) + 1e-6f);
#pragma unroll
            for (int j = 0; j < 4; ++j) { const f32x4 gg = ((const f32x4*)gn)[64 * j + lane]; xr[64 * j] = v[j] * rs * gg; }
        }
    }
#endif
#undef IN
#undef SEAM
}

extern "C" void kernel_launch(void* const* d_in, const int* in_sizes, int n_in, void* d_out, int out_size, void* d_ws, size_t ws_size, hipStream_t stream) {
    static int grid = 0;
    if (grid == 0) {
        if (n_in != 18 || out_size != M * DM || ws_size < WS_END) { fprintf(stderr, "kernel_launch: unexpected shapes (n_in %d out %d ws %zu)\n", n_in, out_size, ws_size); grid = -1; return; }
        int dev = 0, cus = 0, per_cu = 0;
        hipGetDevice(&dev); hipDeviceGetAttribute(&cus, hipDeviceAttributeMultiprocessorCount, dev);
        hipFuncSetAttribute((const void*)fwd_megakernel, hipFuncAttributeMaxDynamicSharedMemorySize, LDS_BYTES);
        hipOccupancyMaxActiveBlocksPerMultiprocessor(&per_cu, (const void*)fwd_megakernel, NTHR, LDS_BYTES);
        (void)hipGetLastError();
        if (per_cu < 1) { fprintf(stderr, "kernel_launch: occupancy query reports %d blocks per CU\n", per_cu); per_cu = 1; }
        grid = cus;
        if (grid != 256) fprintf(stderr, "kernel_launch: note: %d CUs (the attention order assumes 256)\n", grid);
    }
    if (grid < 0) return;
    if (hipMemsetAsync((char*)d_ws + WS_BAR, 0, (WS_CNT + 4096) - WS_BAR, stream) != hipSuccess) { fprintf(stderr, "kernel_launch: memset failed\n"); return; }
    Args a{};
    for (int i = 0; i < 18; ++i) a.in[i] = (const float*)d_in[i];
    a.out = (float*)d_out; a.ws = (unsigned char*)d_ws;
#if MK_SINGLE
    a.ph_lo = 0; a.ph_hi = N_PHASES;
    { void* kargs[] = {&a}; hipError_t e = hipLaunchCooperativeKernel((const void*)fwd_megakernel, dim3(grid), dim3(NTHR), kargs, LDS_BYTES, stream);
      if (e != hipSuccess) fprintf(stderr, "cooperative launch failed: %s\n", hipGetErrorString(e)); }
#else
    for (int p = 0; p < N_PHASES; ++p) { a.ph_lo = p; a.ph_hi = p + 1; void* kargs[] = {&a};
        hipError_t e = hipLaunchCooperativeKernel((const void*)fwd_megakernel, dim3(grid), dim3(NTHR), kargs, LDS_BYTES, stream);
        if (e != hipSuccess) { fprintf(stderr, "cooperative launch %d failed: %s\n", p, hipGetErrorString(e)); break; } }
#endif
}
```

```cpp
#include <hip/hip_runtime.h>
#include <hip/hip_cooperative_groups.h>
#include <hip/hip_bf16.h>
#include <cstdio>
#include <cstdint>
#include <cmath>
namespace cg = cooperative_groups;
namespace pg8 {
#define PG8_LAS __attribute__((address_space(3)))
typedef unsigned short bf16_t;
typedef short bf16x8 __attribute__((ext_vector_type(8)));
typedef float f32x4 __attribute__((ext_vector_type(4)));
typedef unsigned u32x4 __attribute__((ext_vector_type(4)));
constexpr int BM = 256, BK = 64, HALF = 128, HTB = HALF * BK * 2  , STAGE_BYTES = 8 * HTB, NXCD = 8, WGM = 8;

__host__ __device__ __forceinline__ int lds_byte(int r, int c) { const int st = (r >> 4) * 2 + (c >> 5), rr = r & 15, cc = c & 31, ob = rr * 64 + cc * 2; return st * 1024 + (ob ^ (((ob >> 9) & 1) << 5)); }
__host__ __device__ __forceinline__ void stage_rc(int b, int& R, int& C) { const int st = b / 1024, sb = b % 1024, swz = sb ^ (((sb >> 9) & 1) << 5); R = (st >> 1) * 16 + swz / 64; C = (st & 1) * 32 + (swz % 64) / 2; }
__host__ __device__ __forceinline__ int perm32(int rho) { const int n = rho >> 4, i = rho & 15; return 8 * (i >> 2) + 4 * n + (i & 3); }

struct Unit { int pm, pn; };
struct Gemm { const bf16_t* A; const bf16_t* Bt; int M, N, K; };

struct StaticOrder {
    int nM, nN, nwg, G, c;
    __host__ __device__ void init(int M, int N, int G_, int c_) { nM = M / BM; nN = N / BM; nwg = nM * nN; G = G_; c = c_; }
    __host__ __device__ bool next(int i, Unit& u) const {
        const long L = (long)i * G + c; if (L >= nwg) return false;
        int wgid = (int)L; { const int q = nwg / NXCD, r = nwg % NXCD, xcd = wgid % NXCD, off = wgid / NXCD; wgid = (xcd < r ? xcd * (q + 1) : r * (q + 1) + (xcd - r) * q) + off; }
        const int nig = WGM * nN, gid = wgid / nig, fm = gid * WGM, gsz = (nM - fm) < WGM ? (nM - fm) : WGM;
        u.pm = fm + ((wgid % nig) % gsz); u.pn = (wgid % nig) / gsz; return true;
    }
    __device__ __forceinline__ void a_ready(const Unit&) const {}
    __device__ __forceinline__ void done(const Unit&) const {}
};

__device__ __forceinline__ unsigned cvt_pk_bf16(float lo, float hi) { unsigned r; asm volatile("v_cvt_pk_bf16_f32 %0, %1, %2" : "=v"(r) : "v"(lo), "v"(hi)); return r; }
typedef float f32x2 __attribute__((ext_vector_type(2)));
typedef unsigned u32x2 __attribute__((ext_vector_type(2)));
__device__ __forceinline__ float row_rstd(const float* part, int row) {
    const f32x4* p = (const f32x4*)(part + (size_t)row * 16);
    const f32x4 a = p[0], b = p[1], c = p[2], d = p[3];
    const float s = (((a[0] + a[1]) + (a[2] + a[3])) + ((b[0] + b[1]) + (b[2] + b[3]))) + (((c[0] + c[1]) + (c[2] + c[3])) + ((d[0] + d[1]) + (d[2] + d[3])));
    return rsqrtf(s * (1.0f / 1024.0f) + 1e-6f);
}
__device__ __forceinline__ float silu_mul(float g, float u) { return g * u * __builtin_amdgcn_rcpf(1.0f + __builtin_amdgcn_exp2f(-1.4426950408889634f * g)); }
struct EpiSwiGLU {
    static constexpr bool PERM = true, AFTER_DRAIN = false;
    bf16_t* H; int ldh; const PG8_LAS float* rt;
    __device__ __forceinline__ void operator()(const f32x4 (&acc)[2][2][4][2], const Unit& u, int wr, int wc, int fr, int fq, int ui) const {
        const int row0 = u.pm * BM + wr * 64 + fr; const int col0 = u.pn * HALF + wc * 32 + 8 * fq;
#pragma unroll
        for (int ai = 0; ai < 2; ++ai)
#pragma unroll
            for (int m = 0; m < 4; ++m) { const int row = row0 + ai * HALF + m * 16; const float rs = rt[ui * 256 + wr * 64 + fr + ai * HALF + m * 16];
                const f32x4 g0 = acc[ai][0][m][0] * rs, g1 = acc[ai][0][m][1] * rs, u0 = acc[ai][1][m][0] * rs, u1 = acc[ai][1][m][1] * rs;
                u32x4 w; w.x = cvt_pk_bf16(silu_mul(g0[0], u0[0]), silu_mul(g0[1], u0[1])); w.y = cvt_pk_bf16(silu_mul(g0[2], u0[2]), silu_mul(g0[3], u0[3]));
                w.z = cvt_pk_bf16(silu_mul(g1[0], u1[0]), silu_mul(g1[1], u1[1])); w.w = cvt_pk_bf16(silu_mul(g1[2], u1[2]), silu_mul(g1[3], u1[3]));
                *(u32x4*)(H + (size_t)row * ldh + col0) = w; }
    }
};
template <bool BASE_F32> struct EpiResid {
    static constexpr bool PERM = true, AFTER_DRAIN = false;
    const float* base; bf16_t* xb; float* part; float alpha;
    __device__ __forceinline__ void operator()(const f32x4 (&acc)[2][2][4][2], const Unit& u, int wr, int wc, int fr, int fq, int) const {
        const int row0 = u.pm * BM + wr * 64 + fr; const int col0 = u.pn * BM + wc * 32 + 8 * fq;
#pragma unroll
        for (int ai = 0; ai < 2; ++ai)
#pragma unroll
            for (int m = 0; m < 4; ++m) { const int row = row0 + ai * HALF + m * 16; float ss = 0.f;
#pragma unroll
                for (int bj = 0; bj < 2; ++bj) { const size_t off = (size_t)row * 1024 + col0 + bj * HALF;
                    f32x4 b0, b1;
                    if (BASE_F32) { b0 = *(const f32x4*)(base + off); b1 = *(const f32x4*)(base + off + 4); }
                    else { const u32x4 r = *(const u32x4*)(xb + off);
                        b0 = (f32x4){__builtin_bit_cast(float, r.x << 16), __builtin_bit_cast(float, r.x & 0xffff0000u), __builtin_bit_cast(float, r.y << 16), __builtin_bit_cast(float, r.y & 0xffff0000u)};
                        b1 = (f32x4){__builtin_bit_cast(float, r.z << 16), __builtin_bit_cast(float, r.z & 0xffff0000u), __builtin_bit_cast(float, r.w << 16), __builtin_bit_cast(float, r.w & 0xffff0000u)}; }
                    const f32x4 v0 = b0 + acc[ai][bj][m][0] * alpha, v1 = b1 + acc[ai][bj][m][1] * alpha;
                    ss += ((v0[0] * v0[0] + v0[1] * v0[1]) + (v0[2] * v0[2] + v0[3] * v0[3])) + ((v1[0] * v1[0] + v1[1] * v1[1]) + (v1[2] * v1[2] + v1[3] * v1[3]));
                    u32x4 w; w.x = cvt_pk_bf16(v0[0], v0[1]); w.y = cvt_pk_bf16(v0[2], v0[3]); w.z = cvt_pk_bf16(v1[0], v1[1]); w.w = cvt_pk_bf16(v1[2], v1[3]);
                    *(u32x4*)(xb + off) = w; }
                ss += __shfl_xor(ss, 16); ss += __shfl_xor(ss, 32);
                if (fq == 0) part[(size_t)row * 16 + u.pn * 4 + wc] = ss; }
    }
};
struct EpiProj {
    static constexpr bool PERM = true, AFTER_DRAIN = false;
    bf16_t* O; int ldc; const PG8_LAS float* rt; int split_cols; size_t split_stride; int qcols; float scale0; float* km;
    __device__ __forceinline__ void operator()(const f32x4 (&acc)[2][2][4][2], const Unit& u, int wr, int wc, int fr, int fq, int ui) const {
        const int row0 = u.pm * BM + wr * 64 + fr; int colt = u.pn * BM; bf16_t* basep = O; int t = 0;
        const float sc = (colt < qcols) ? scale0 : 1.f;
        if (split_cols) { t = colt / split_cols; basep += (size_t)t * split_stride; colt -= t * split_cols; }
        const int col0 = colt + wc * 32 + 8 * fq;
        const bool do_km = (km != nullptr) && (t == 1);
        f32x4 cs[2][2];
#pragma unroll
        for (int bj = 0; bj < 2; ++bj)
#pragma unroll
            for (int n = 0; n < 2; ++n) cs[bj][n] = (f32x4){0.f, 0.f, 0.f, 0.f};
#pragma unroll
        for (int ai = 0; ai < 2; ++ai)
#pragma unroll
            for (int m = 0; m < 4; ++m) { const int row = row0 + ai * HALF + m * 16; const float rs = rt[ui * 256 + wr * 64 + fr + ai * HALF + m * 16]; const float rsc = rs * sc;
                bf16_t* rowp = basep + (size_t)row * ldc + col0;
#pragma unroll
                for (int bj = 0; bj < 2; ++bj) { const f32x4 v0 = acc[ai][bj][m][0] * rsc, v1 = acc[ai][bj][m][1] * rsc;
                    cs[bj][0] += v0; cs[bj][1] += v1;
                    u32x4 w; w.x = cvt_pk_bf16(v0[0], v0[1]); w.y = cvt_pk_bf16(v0[2], v0[3]); w.z = cvt_pk_bf16(v1[0], v1[1]); w.w = cvt_pk_bf16(v1[2], v1[3]);
                    *(u32x4*)(rowp + bj * HALF) = w; } }
        if (do_km) {
#pragma unroll
            for (int bj = 0; bj < 2; ++bj)
#pragma unroll
                for (int n = 0; n < 2; ++n) { f32x4 v = cs[bj][n];
#pragma unroll
                    for (int o = 1; o < 16; o <<= 1) { v[0] += __shfl_xor(v[0], o); v[1] += __shfl_xor(v[1], o); v[2] += __shfl_xor(v[2], o); v[3] += __shfl_xor(v[3], o); }
                    if (fr == 0) *(f32x4*)(km + (size_t)(u.pm * 2 + wr) * 1024 + col0 + bj * HALF + 4 * n) = v; }
        }
    }
};
template <class Epi, class Sched, bool ALIGN_EPI = false, bool SP2 = false>
__device__ __forceinline__ void gemm_phase(PG8_LAS unsigned char* lds, const Gemm g, const Sched& S, const Epi& E) {
    const int tid = threadIdx.x, wid = __builtin_amdgcn_readfirstlane(tid >> 6), lane = tid & 63, wr = wid >> 2, wc = wid & 3, fr = lane & 15, fq = lane >> 4;
    const int K = g.K, nt = K / BK;
    unsigned voffA[2], voffB[2];
#pragma unroll
    for (int i = 0; i < 2; ++i) { int R, C; stage_rc(tid * 16 + i * 8192, R, C); const int Rb = Epi::PERM ? ((R & ~31) + perm32(R & 31)) : R;
        voffA[i] = (unsigned)(R * K + C) * 2u; voffB[i] = (unsigned)(Rb * K + C) * 2u; }
    const size_t kstep = (size_t)(BK * 2);
    const size_t hstep = (size_t)HALF * K * 2;
    const size_t tstep = 2 * hstep;
    const unsigned ldsw = (unsigned)wid * 1024u;
    const int aoff = lds_byte(wr * 64 + fr, fq * 8), boff = lds_byte(wc * 32 + fr, fq * 8);
#define PG8_SA(b, h) (((b) * 2 + (h)) * HTB)
#define PG8_SB(b, h) ((4 + (b) * 2 + (h)) * HTB)
#define PG8_STAGE(bufoff, gbase, voff) do { _Pragma("unroll") for (int _i = 0; _i < 2; ++_i) \
        __builtin_amdgcn_global_load_lds((const unsigned*)((const char*)(gbase) + (voff)[_i]), (PG8_LAS unsigned*)(lds + (bufoff) + ldsw + _i * 8192), 16, 0, 0); } while (0)
#define PG8_LDA(dst, b, h) do { _Pragma("unroll") for (int m = 0; m < 4; ++m) _Pragma("unroll") for (int k = 0; k < 2; ++k) dst[m][k] = *(const PG8_LAS bf16x8*)(lds + PG8_SA(b, h) + aoff + m * 2048 + k * 1024); } while (0)
#define PG8_LDB(dst, b, h) do { _Pragma("unroll") for (int n = 0; n < 2; ++n) _Pragma("unroll") for (int k = 0; k < 2; ++k) dst[n][k] = *(const PG8_LAS bf16x8*)(lds + PG8_SB(b, h) + boff + n * 2048 + k * 1024); } while (0)
#define PG8_MMA(ai, bj, At, Bt) do { __builtin_amdgcn_s_setprio(1); _Pragma("unroll") for (int m = 0; m < 4; ++m) _Pragma("unroll") for (int n = 0; n < 2; ++n) _Pragma("unroll") for (int k = 0; k < 2; ++k) \
        acc[ai][bj][m][n] = __builtin_amdgcn_mfma_f32_16x16x32_bf16(Bt[n][k], At[m][k], acc[ai][bj][m][n], 0, 0, 0); __builtin_amdgcn_s_setprio(0); } while (0)
#define PG8_WAIT_V(n) asm volatile("s_waitcnt vmcnt(" #n ")" ::: "memory")
#define PG8_WAIT_L(n) asm volatile("s_waitcnt lgkmcnt(" #n ")" ::: "memory")
#define PG8_BAR __builtin_amdgcn_s_barrier()
#define PG8_SCHED __builtin_amdgcn_sched_barrier(0)
    Unit cur, nxt; int ui = 0;
    if (!S.next(0, cur)) return;
    f32x4 acc[2][2][4][2];
#pragma unroll
    for (int a = 0; a < 2; ++a)
#pragma unroll
        for (int b = 0; b < 2; ++b)
#pragma unroll
            for (int m = 0; m < 4; ++m)
#pragma unroll
                for (int n = 0; n < 2; ++n) acc[a][b][m][n] = (f32x4){0.f, 0.f, 0.f, 0.f};
    bf16x8 At[4][2], B0[2][2], B1[2][2];
    const char* cA = (const char*)g.A + (size_t)cur.pm * tstep; const char* cB = (const char*)g.Bt + (size_t)cur.pn * tstep;
    S.a_ready(cur);
    if constexpr (SP2) {
        PG8_STAGE(PG8_SB(0, 0), cB, voffB); PG8_STAGE(PG8_SB(0, 1), cB + hstep, voffB); PG8_STAGE(PG8_SA(0, 0), cA, voffA); PG8_STAGE(PG8_SA(0, 1), cA + hstep, voffA);
        if (wr == 1) PG8_BAR;
        PG8_WAIT_V(2); PG8_BAR;
        PG8_STAGE(PG8_SB(1, 0), cB + kstep, voffB); PG8_STAGE(PG8_SA(1, 0), cA + kstep, voffA); PG8_STAGE(PG8_SB(1, 1), cB + hstep + kstep, voffB);
        PG8_WAIT_V(6); PG8_BAR;
    } else {
        PG8_STAGE(PG8_SB(0, 0), cB, voffB); PG8_STAGE(PG8_SA(0, 0), cA, voffA); PG8_STAGE(PG8_SB(0, 1), cB + hstep, voffB); PG8_STAGE(PG8_SA(0, 1), cA + hstep, voffA);
        if (wr == 1) PG8_BAR;
        PG8_WAIT_V(4); PG8_BAR;
        PG8_STAGE(PG8_SB(1, 0), cB + kstep, voffB); PG8_STAGE(PG8_SA(1, 0), cA + kstep, voffA); PG8_STAGE(PG8_SB(1, 1), cB + hstep + kstep, voffB);
        PG8_WAIT_V(6); PG8_BAR;
    }
    for (;;) {
        const bool has_next = S.next(ui + 1, nxt);
        const char* nA = has_next ? (const char*)g.A + (size_t)nxt.pm * tstep : cA; const char* nB = has_next ? (const char*)g.Bt + (size_t)nxt.pn * tstep : cB;
        for (int t = 0; t < nt; t += 2) {
            const bool last = (t == nt - 2);
            const char* a1 = cA + (size_t)(t + 1) * kstep;
            const char* a2 = last ? nA : cA + (size_t)(t + 2) * kstep; const char* b2 = last ? nB : cB + (size_t)(t + 2) * kstep;
            const char* a3 = a2 + kstep; const char* b3 = b2 + kstep;
            if (last && has_next) S.a_ready(nxt);
            if constexpr (SP2) {
            PG8_LDB(B0, 0, 0); PG8_LDB(B1, 0, 1); PG8_SCHED; PG8_LDA(At, 0, 0); PG8_STAGE(PG8_SA(1, 1), a1 + hstep, voffA);
            PG8_WAIT_V(8); PG8_WAIT_L(0); PG8_BAR; PG8_MMA(0, 0, At, B0); PG8_MMA(0, 1, At, B1); PG8_BAR; PG8_SCHED;
            PG8_LDA(At, 0, 1); PG8_STAGE(PG8_SB(0, 0), b2, voffB); PG8_STAGE(PG8_SB(0, 1), b2 + hstep, voffB); PG8_STAGE(PG8_SA(0, 0), a2, voffA);
            PG8_WAIT_V(8); PG8_WAIT_L(0); PG8_BAR; PG8_MMA(1, 0, At, B0); PG8_MMA(1, 1, At, B1); PG8_BAR; PG8_SCHED;
            PG8_LDB(B0, 1, 0); PG8_LDB(B1, 1, 1); PG8_SCHED; PG8_LDA(At, 1, 0); PG8_STAGE(PG8_SA(0, 1), a2 + hstep, voffA);
            PG8_WAIT_V(8); PG8_WAIT_L(0); PG8_BAR; PG8_MMA(0, 0, At, B0); PG8_MMA(0, 1, At, B1); PG8_BAR; PG8_SCHED;
            PG8_LDA(At, 1, 1); PG8_STAGE(PG8_SB(1, 0), b3, voffB); PG8_STAGE(PG8_SB(1, 1), b3 + hstep, voffB); PG8_STAGE(PG8_SA(1, 0), a3, voffA);
            PG8_WAIT_V(8); PG8_WAIT_L(0); PG8_BAR; PG8_MMA(1, 0, At, B0); PG8_MMA(1, 1, At, B1); PG8_BAR; PG8_SCHED;
            } else {
            PG8_LDB(B0, 0, 0); PG8_SCHED; PG8_LDA(At, 0, 0); PG8_STAGE(PG8_SA(1, 1), a1 + hstep, voffA);
            PG8_WAIT_L(8); PG8_BAR; PG8_WAIT_L(0); PG8_MMA(0, 0, At, B0); PG8_BAR; PG8_SCHED;
            PG8_LDB(B1, 0, 1); PG8_STAGE(PG8_SB(0, 0), b2, voffB);
            PG8_BAR; PG8_WAIT_L(0); PG8_MMA(0, 1, At, B1); PG8_BAR;
            PG8_LDA(At, 0, 1); PG8_STAGE(PG8_SA(0, 0), a2, voffA);
            PG8_BAR; PG8_WAIT_L(0); PG8_MMA(1, 0, At, B0); PG8_BAR; PG8_SCHED;
            PG8_STAGE(PG8_SB(0, 1), b2 + hstep, voffB);
            PG8_WAIT_V(6); PG8_BAR; PG8_MMA(1, 1, At, B1); PG8_BAR;
            PG8_LDB(B0, 1, 0); PG8_SCHED; PG8_LDA(At, 1, 0); PG8_STAGE(PG8_SA(0, 1), a2 + hstep, voffA);
            PG8_WAIT_L(8); PG8_BAR; PG8_WAIT_L(0); PG8_MMA(0, 0, At, B0); PG8_BAR; PG8_SCHED;
            PG8_LDB(B1, 1, 1); PG8_STAGE(PG8_SB(1, 0), b3, voffB);
            PG8_BAR; PG8_WAIT_L(0); PG8_MMA(0, 1, At, B1); PG8_BAR;
            PG8_LDA(At, 1, 1); PG8_STAGE(PG8_SA(1, 0), a3, voffA);
            PG8_BAR; PG8_WAIT_L(0); PG8_MMA(1, 0, At, B0); PG8_BAR; PG8_SCHED;
            PG8_STAGE(PG8_SB(1, 1), b3 + hstep, voffB);
            PG8_WAIT_V(6); PG8_BAR; PG8_MMA(1, 1, At, B1); PG8_BAR;
            }
        }
        if constexpr (ALIGN_EPI) { if (wr == 0) PG8_BAR; }
        if constexpr (!Epi::AFTER_DRAIN) { E(acc, cur, wr, wc, fr, fq, ui); S.done(cur); }
        if (!has_next) break;
#pragma unroll
        for (int a = 0; a < 2; ++a)
#pragma unroll
            for (int b = 0; b < 2; ++b)
#pragma unroll
                for (int m = 0; m < 4; ++m)
#pragma unroll
                    for (int n = 0; n < 2; ++n) acc[a][b][m][n] = (f32x4){0.f, 0.f, 0.f, 0.f};
        cur = nxt; cA = nA; cB = nB; ++ui;
        if constexpr (ALIGN_EPI) { if (wr == 1) PG8_BAR; }
    }
    PG8_WAIT_V(0);
    if constexpr (!ALIGN_EPI) { if (wr == 0) PG8_BAR; }
    PG8_BAR;
    if constexpr (Epi::AFTER_DRAIN) { E.fused(acc, cur, wr, wc, fr, fq, lds, wid, lane); S.done(cur); }
#undef PG8_SA
#undef PG8_SB
#undef PG8_STAGE
#undef PG8_LDA
#undef PG8_LDB
#undef PG8_MMA
#undef PG8_WAIT_V
#undef PG8_WAIT_L
#undef PG8_BAR
#undef PG8_SCHED
}
}
#define PG8_SP2 true
#define PG8_ALIGN true
namespace attn_body {
using bf16=__hip_bfloat16;
using bf16x8=__attribute__((ext_vector_type(8)))short;
using s16x4=__attribute__((ext_vector_type(4)))short;
using f32x16=__attribute__((ext_vector_type(16)))float;
using u32x4=__attribute__((ext_vector_type(4)))unsigned;
constexpr int BATCH=2,NHEAD=16,SEQ=8192,D=64,DM=NHEAD*D;
constexpr int NW=8,QBLK=32,QB=QBLK*NW,KVBLK=64,NQB=SEQ/QB;
constexpr int ATTN_PITCH=DM, ATTN_UNIT_ROWS=QB;
__device__ __forceinline__ int crow(int r,int hi){return (r&3)+8*(r>>2)+4*hi;}
#define SBAR() __builtin_amdgcn_sched_barrier(0)
__device__ __forceinline__ void cmask(f32x16&p0,f32x16&p1,int jb,int qrel,int hi){
  const float NEG=-INFINITY; int kb=64*jb+4*hi;
  #pragma unroll
  for(int r=0;r<16;++r){int kv=kb+(r&3)+8*(r>>2); if(kv>qrel)p0[r]=NEG; if(kv+32>qrel)p1[r]=NEG;}
}

constexpr int NSLOT=3, SLOTB=8192; constexpr float NEGBIG=-2048.f;
constexpr int LDS_K=0, LDS_V=NSLOT*SLOTB, LDS_WS=2*NSLOT*SLOTB, LDS_OST=LDS_WS+NW*64*4, LDS_BYTES=LDS_OST+NW*4096;
constexpr float C2=0.125f*1.4426950408889634f;
__device__ __forceinline__ void glds16(const void*gsrc,unsigned lds_dst){unsigned keep;
  asm volatile("s_mov_b32 %0, m0\n\ts_mov_b32 m0, %2\n\ts_nop 0\n\tglobal_load_lds_dwordx4 %1, off\n\ts_mov_b32 m0, %0":"=&s"(keep):"v"(gsrc),"s"(lds_dst):"memory");}
__device__ __forceinline__ float max3f(float a,float b,float c){float r;asm("v_max3_f32 %0, %1, %2, %3":"=v"(r):"v"(a),"v"(b),"v"(c));return r;}
__device__ __forceinline__ float max2f(float a,float b){float r;asm("v_max_f32_e32 %0, %1, %2":"=v"(r):"v"(a),"v"(b));return r;}
__device__ __forceinline__ float fadd_s(float a,float b){float r;asm("v_add_f32_e32 %0, %1, %2":"=v"(r):"v"(a),"v"(b));return r;}
__device__ __forceinline__ float fsub_s(float a,float b){float r;asm("v_sub_f32_e32 %0, %1, %2":"=v"(r):"v"(a),"v"(b));return r;}
typedef float f32x2_t __attribute__((ext_vector_type(2))); typedef __bf16 bf16x2_t __attribute__((ext_vector_type(2)));
__device__ __forceinline__ unsigned cvtpk_s(float lo,float hi){f32x2_t v={lo,hi};bf16x2_t b=__builtin_convertvector(v,bf16x2_t);return __builtin_bit_cast(unsigned,b);}
#define WAIT_BAR(N) asm volatile("s_waitcnt vmcnt(" #N ") lgkmcnt(0)\n\ts_barrier":::"memory")

__device__ __forceinline__ void qkt(f32x16&p0,f32x16&p1,const char*Kslot,const bf16x8*qr,const f32x16&negm,int r32,int hi){
  const char*kb=Kslot+hi*1024+r32*16;
  #pragma unroll
  for(int d0=0;d0<4;++d0){
    const bf16x8 b0=*reinterpret_cast<const bf16x8*>(kb+d0*2048);
    const bf16x8 b1=*reinterpret_cast<const bf16x8*>(kb+d0*2048+512);
    if(d0==0){p0=__builtin_amdgcn_mfma_f32_32x32x16_bf16(b0,qr[0],negm,0,0,0);p1=__builtin_amdgcn_mfma_f32_32x32x16_bf16(b1,qr[0],negm,0,0,0);}
    else{p0=__builtin_amdgcn_mfma_f32_32x32x16_bf16(b0,qr[d0],p0,0,0,0);p1=__builtin_amdgcn_mfma_f32_32x32x16_bf16(b1,qr[d0],p1,0,0,0);}}
}
typedef __attribute__((address_space(3))) const char* lds_cptr;
typedef short v4i16_t __attribute__((ext_vector_type(4)));
__device__ __forceinline__ void kload8(bf16x8*kf,lds_cptr kp){
  kf[0]=*(const __attribute__((address_space(3))) bf16x8*)(kp);      kf[1]=*(const __attribute__((address_space(3))) bf16x8*)(kp+512);
  kf[2]=*(const __attribute__((address_space(3))) bf16x8*)(kp+2048); kf[3]=*(const __attribute__((address_space(3))) bf16x8*)(kp+2560);
  kf[4]=*(const __attribute__((address_space(3))) bf16x8*)(kp+4096); kf[5]=*(const __attribute__((address_space(3))) bf16x8*)(kp+4608);
  kf[6]=*(const __attribute__((address_space(3))) bf16x8*)(kp+6144); kf[7]=*(const __attribute__((address_space(3))) bf16x8*)(kp+6656);
}
__device__ __forceinline__ void kload2(bf16x8*kf,lds_cptr kp,int j){ kf[2*j]=*(const __attribute__((address_space(3))) bf16x8*)(kp+j*2048); kf[2*j+1]=*(const __attribute__((address_space(3))) bf16x8*)(kp+j*2048+512); }
__device__ __forceinline__ s16x4 vtr(lds_cptr p){ return __builtin_bit_cast(s16x4,__builtin_amdgcn_ds_read_tr16_b64_v4i16((__attribute__((address_space(3))) v4i16_t*)p)); }
__device__ __forceinline__ float rowmax(const f32x16&p0,const f32x16&p1){
  float a=max3f(p0[0],p0[1],p1[0]),b=max3f(p0[2],p0[3],p1[1]);a=max3f(a,p1[2],p1[3]);
  #pragma unroll
  for(int r=4;r<16;r+=4){a=max3f(a,p0[r],p0[r+1]);b=max3f(b,p0[r+2],p0[r+3]);a=max3f(a,p1[r],p1[r+1]);b=max3f(b,p1[r+2],p1[r+3]);}
  const float m=max2f(a,b);
  auto rr=__builtin_amdgcn_permlane32_swap(__float_as_uint(m),__float_as_uint(m),false,false);
  return max2f(__uint_as_float(rr[0]),__uint_as_float(rr[1]));
}
__device__ __forceinline__ void pv(f32x16*o,int vb,bf16x8 pa0,bf16x8 pa1,bf16x8 pa2,bf16x8 pa3){
  #pragma unroll
  for(int d0=0;d0<2;++d0){s16x4 lo[4],hi[4];
    #pragma unroll
    for(int ks=0;ks<4;++ks){
      asm volatile("ds_read_b64_tr_b16 %0,%1 offset:%c2":"=&v"(lo[ks]):"v"(vb),"i"(d0*4096+ks*1024):"memory");
      asm volatile("ds_read_b64_tr_b16 %0,%1 offset:%c2":"=&v"(hi[ks]):"v"(vb),"i"(d0*4096+ks*1024+512):"memory");}
    asm volatile("s_waitcnt lgkmcnt(0)":::"memory");SBAR();
    #define PK(k) (bf16x8){lo[k][0],lo[k][1],lo[k][2],lo[k][3],hi[k][0],hi[k][1],hi[k][2],hi[k][3]}
    o[d0]=__builtin_amdgcn_mfma_f32_32x32x16_bf16(pa0,PK(0),o[d0],0,0,0);
    o[d0]=__builtin_amdgcn_mfma_f32_32x32x16_bf16(pa1,PK(1),o[d0],0,0,0);
    o[d0]=__builtin_amdgcn_mfma_f32_32x32x16_bf16(pa2,PK(2),o[d0],0,0,0);
    o[d0]=__builtin_amdgcn_mfma_f32_32x32x16_bf16(pa3,PK(3),o[d0],0,0,0);
    #undef PK
  }
}

#ifndef ATTN_STORE16
#define ATTN_STORE16(p,v) (*(u32x4*)(p)=(v))
#endif
template<int THRL> __device__ __forceinline__ void attn_unit(int b,int h,int qb,const bf16*Q,const bf16*__restrict__ K,const bf16*__restrict__ V,bf16*O,const unsigned*__restrict__ SEL,char*shm){
  const int tid=threadIdx.x,lane=tid&63,r32=lane&31,hi=lane>>5; const int wid=__builtin_amdgcn_readfirstlane(tid>>6);
  const long rowbase=(long)b*SEQ; const int q0=qb*QB;
  const bf16*Qw=Q+(rowbase+q0+wid*QBLK)*DM+h*D;
  const bf16*Kh=K+rowbase*DM+h*D,*Vh=V+rowbase*DM+h*D;
  const unsigned lds0=(unsigned)(uintptr_t)shm;
  float*wsf=(float*)(shm+LDS_WS)+wid*64;
  const bf16*ksrc=Kh+(long)lane*DM+wid*8;
  const bf16*vsrc=Vh+(long)(16*(wid&3)+(lane>>2))*DM+(wid>>2)*32+(lane&3)*8;
  const unsigned kdst=lds0+LDS_K+wid*1024, vdst=lds0+LDS_V+wid*1024;
  #define DMA_K(t,slot) glds16(ksrc+(long)(t)*KVBLK*DM,(unsigned)__builtin_amdgcn_readfirstlane(kdst+(slot)))
  #define DMA_V(t,slot) glds16(vsrc+(long)(t)*KVBLK*DM,(unsigned)__builtin_amdgcn_readfirstlane(vdst+(slot)))
  const int vb0=(int)(lds0+LDS_V)+((lane>>4)&1)*32+(lane&3)*8+(4*hi+((lane&15)>>2))*64;
  const char*Kbase=shm+LDS_K; bf16x8 kf[8];
  const lds_cptr shm3=(lds_cptr)shm; const lds_cptr kp0=shm3+LDS_K+hi*1024+r32*16; const lds_cptr vp0=shm3+LDS_V+((lane>>4)&1)*32+(lane&3)*8+(4*hi+((lane&15)>>2))*64;
  const int NT=(q0+QB)/KVBLK;
  DMA_K(0,0);DMA_V(0,0);DMA_K(1,SLOTB);
  bf16x8 qr[4];
  #pragma unroll
  for(int d0=0;d0<4;++d0)qr[d0]=*reinterpret_cast<const bf16x8*>(&Qw[(long)r32*DM+d0*16+hi*8]);
  float mhat=0.f,l_reg=0.f;f32x16 o[2];o[0]=f32x16{};o[1]=f32x16{};const f32x16 negm=f32x16{};
  const int qrel=wid*QBLK+r32; volatile unsigned*sel_l=(volatile unsigned*)(shm+LDS_BYTES)+wid*32; if(hi==0)sel_l[r32]=SEL[(size_t)(b*NHEAD+h)*SEQ+q0+qrel];
  #define CMASK(P0,P1,t) do{int jb_=(t)-(NT-4); if(jb_>=0){cmask(P0,P1,jb_,qrel,hi);} else if(!((sel_l[r32]>>(((t)>>2)&31))&1u)){ _Pragma("unroll") for(int r_=0;r_<16;++r_){P0[r_]=NEGBIG;P1[r_]=NEGBIG;} } }while(0)
  bool resc=false;
  #define START(P0,P1) do{ const float rm=rowmax(P0,P1); resc=false; \
    { const float dl=rm; mhat=fadd_s(mhat,dl); \
      _Pragma("unroll") for(int r=0;r<16;++r){P0[r]=fsub_s(P0[r],dl);P1[r]=fsub_s(P1[r],dl);} \
      } \
    _Pragma("unroll") for(int r=0;r<16;++r)P0[r]=__builtin_amdgcn_exp2f(P0[r]); }while(0)
  #define RESC() do{ if(resc){ asm volatile("s_waitcnt lgkmcnt(0)":::"memory"); \
      _Pragma("unroll") for(int d_=0;d_<2;++d_) _Pragma("unroll") for(int r=0;r<16;++r)o[d_][r]*=wsf[crow(r,hi)]; } }while(0)
  f32x16 pA0,pA1,pB0,pB1;
  int sl_prev=0,sl_cur=0,sl_next=SLOTB;
  #define ROT() do{sl_prev=sl_cur;sl_cur=sl_next;sl_next=(sl_next==(NSLOT-1)*SLOTB)?0:sl_next+SLOTB;}while(0)
  DMA_K(2,2*SLOTB);
  WAIT_BAR(3);
  qkt(pA0,pA1,Kbase,qr,negm,r32,hi);asm volatile("s_nop 15\n\ts_nop 7":"+v"(pA0),"+v"(pA1));CMASK(pA0,pA1,0);
  START(pA0,pA1);
  _Pragma("unroll") for(int r=0;r<16;++r)pA1[r]=__builtin_amdgcn_exp2f(pA1[r]);
  WAIT_BAR(0);
  DMA_K(3,0);DMA_V(1,SLOTB);
  ROT();
  kload8(kf,kp0+sl_cur);
  WAIT_BAR(2);
  s16x4 vlo[8],vhi[8]; u32x4 pw0,pw1,pw2,pw3;
  #define PKW(P,B) cvtpk_s(P[B],P[B+1])
  #define PAF(k) __builtin_bit_cast(bf16x8,pw##k)
  #define VFR(i) (bf16x8){vlo[i][0],vlo[i][1],vlo[i][2],vlo[i][3],vhi[i][0],vhi[i][1],vhi[i][2],vhi[i][3]}
  #define PIN(x) asm volatile("":"+v"(x))
  #define MX3(a,b,c) __builtin_fmaxf(__builtin_fmaxf((a),(b)),(c))
  #define GAPA(MF,A0,A1,A2,A3,W0,W1,PW) do{ MF; sacc+=A0; sacc+=A1; sacc+=A2; sacc+=A3; PIN(sacc); W0; W1; PIN(PW); SBAR(); }while(0)
  #define EX(v) __builtin_amdgcn_exp2f(v)
  #define GAPB(MF,X,B) do{ MF; X[B]=EX(X[B]); X[B+1]=EX(X[B+1]); X[B+2]=EX(X[B+2]); X[B+3]=EX(X[B+3]); PIN(X); SBAR(); }while(0)
  #define VRD(i) do{ vlo[i]=vtr(vp_+(((i)>>2)*4096+((i)&3)*1024)); vhi[i]=vtr(vp_+(((i)>>2)*4096+((i)&3)*1024+512)); }while(0)
  #define KRD(G,j) do{ if(G){ kload2(kf,kp0+sl_next,j); SBAR(); } }while(0)
  #define STEP(C0,C1,P0,P1,t,GK,GV,GL) do{ SBAR(); \
    const lds_cptr vp_=vp0+sl_prev; \
    VRD(0); SBAR(); float sacc=(P0[0]+P0[1]); \
    GAPA(C0=__builtin_amdgcn_mfma_f32_32x32x16_bf16(kf[0],qr[0],negm,0,0,0), P0[2],P0[3],P0[4],P0[5],     pw0[0]=PKW(P0,0), pw0[1]=PKW(P0,2), pw0); \
    VRD(4); SBAR(); GAPA(C1=__builtin_amdgcn_mfma_f32_32x32x16_bf16(kf[1],qr[0],negm,0,0,0), P0[6],P0[7],P0[8],P0[9],     pw0[2]=PKW(P0,4), pw0[3]=PKW(P0,6), pw0); \
    VRD(1); SBAR(); GAPA(C0=__builtin_amdgcn_mfma_f32_32x32x16_bf16(kf[2],qr[1],C0,0,0,0),   P0[10],P0[11],P0[12],P0[13], pw1[0]=PKW(P0,8), pw1[1]=PKW(P0,10), pw1); \
    VRD(5); SBAR(); GAPA(C1=__builtin_amdgcn_mfma_f32_32x32x16_bf16(kf[3],qr[1],C1,0,0,0),   P0[14],P0[15],P1[0],P1[1],   pw1[2]=PKW(P0,12),pw1[3]=PKW(P0,14), pw1); \
    VRD(2); SBAR(); GAPA(C0=__builtin_amdgcn_mfma_f32_32x32x16_bf16(kf[4],qr[2],C0,0,0,0),   P1[2],P1[3],P1[4],P1[5],     pw2[0]=PKW(P1,0), pw2[1]=PKW(P1,2), pw2); \
    VRD(6); SBAR(); GAPA(C1=__builtin_amdgcn_mfma_f32_32x32x16_bf16(kf[5],qr[2],C1,0,0,0),   P1[6],P1[7],P1[8],P1[9],     pw2[2]=PKW(P1,4), pw2[3]=PKW(P1,6), pw2); \
    VRD(3); SBAR(); GAPA(C0=__builtin_amdgcn_mfma_f32_32x32x16_bf16(kf[6],qr[3],C0,0,0,0),   P1[10],P1[11],P1[12],P1[13], pw3[0]=PKW(P1,8), pw3[1]=PKW(P1,10), pw3); \
    VRD(7); SBAR(); GAPA(C1=__builtin_amdgcn_mfma_f32_32x32x16_bf16(kf[7],qr[3],C1,0,0,0),   P1[14],P1[15],0.f,0.f,       pw3[2]=PKW(P1,12),pw3[3]=PKW(P1,14), pw3); \
    l_reg+=sacc; \
    if(GK){DMA_K((t)+3,sl_cur);} if(GV){DMA_V((t)+1,sl_next);} \
    _Pragma("unroll") for(int r=0;r<16;++r){C0[r]-=mhat;C1[r]-=mhat;} \
    CMASK(C0,C1,t); \
    { float a=MX3(C0[0],C0[1],C1[0]),b=MX3(C0[2],C0[3],C1[1]); a=MX3(a,C1[2],C1[3]); \
      _Pragma("unroll") for(int r=4;r<16;r+=4){a=MX3(a,C0[r],C0[r+1]);b=MX3(b,C0[r+2],C0[r+3]);a=MX3(a,C1[r],C1[r+1]);b=MX3(b,C1[r+2],C1[r+3]);} \
      float rm=__builtin_fmaxf(a,b); { auto rr=__builtin_amdgcn_permlane32_swap(__float_as_uint(rm),__float_as_uint(rm),false,false); rm=__builtin_fmaxf(__uint_as_float(rr[0]),__uint_as_float(rr[1])); } \
      resc=false; \
      if(__builtin_expect(__any(rm>(float)THRL),0)){ const float dl=__builtin_fmaxf(rm,0.f); mhat+=dl; \
        _Pragma("unroll") for(int r=0;r<16;++r){C0[r]-=dl;C1[r]-=dl;} \
        const float f=__builtin_amdgcn_exp2f(-dl); l_reg*=f; if(hi==0)wsf[r32]=f; resc=true; } } \
    SBAR(); \
    GAPB(o[0]=__builtin_amdgcn_mfma_f32_32x32x16_bf16(PAF(0),VFR(0),o[0],0,0,0), C0,0); \
    GAPB(o[1]=__builtin_amdgcn_mfma_f32_32x32x16_bf16(PAF(0),VFR(4),o[1],0,0,0), C0,4); \
    KRD(GL,0); GAPB(o[0]=__builtin_amdgcn_mfma_f32_32x32x16_bf16(PAF(1),VFR(1),o[0],0,0,0), C0,8); \
    KRD(GL,1); GAPB(o[1]=__builtin_amdgcn_mfma_f32_32x32x16_bf16(PAF(1),VFR(5),o[1],0,0,0), C0,12); \
    KRD(GL,2); GAPB(o[0]=__builtin_amdgcn_mfma_f32_32x32x16_bf16(PAF(2),VFR(2),o[0],0,0,0), C1,0); \
    KRD(GL,3); GAPB(o[1]=__builtin_amdgcn_mfma_f32_32x32x16_bf16(PAF(2),VFR(6),o[1],0,0,0), C1,4); \
    GAPB(o[0]=__builtin_amdgcn_mfma_f32_32x32x16_bf16(PAF(3),VFR(3),o[0],0,0,0), C1,8); \
    GAPB(o[1]=__builtin_amdgcn_mfma_f32_32x32x16_bf16(PAF(3),VFR(7),o[1],0,0,0), C1,12); \
    }while(0)
  int t=1;
  #undef CMASK
  #define CMASK(P0,P1,t) do{ if(!((sel_l[r32]>>(((t)>>2)&31))&1u)){ _Pragma("unroll") for(int r_=0;r_<16;++r_){P0[r_]=NEGBIG;P1[r_]=NEGBIG;} } }while(0)
  for(;t+5<NT;t+=2){
    STEP(pB0,pB1,pA0,pA1,t,true,true,true);     WAIT_BAR(2); RESC(); ROT();
    STEP(pA0,pA1,pB0,pB1,t+1,true,true,true);   WAIT_BAR(2); RESC(); ROT();
  }
  #undef CMASK
  #define CMASK(P0,P1,t) do{int jb_=(t)-(NT-4); if(jb_>=0){cmask(P0,P1,jb_,qrel,hi);} else if(!((sel_l[r32]>>(((t)>>2)&31))&1u)){ _Pragma("unroll") for(int r_=0;r_<16;++r_){P0[r_]=NEGBIG;P1[r_]=NEGBIG;} } }while(0)
  #define ENDW(tt) do{ if((tt)+3<NT){WAIT_BAR(2);} else if((tt)+2<NT){WAIT_BAR(1);} else {WAIT_BAR(0);} }while(0)
  for(;t+1<NT;t+=2){
    STEP(pB0,pB1,pA0,pA1,t,(t+3<NT),(t+1<NT),(t+1<NT));       ENDW(t);   RESC(); ROT();
    STEP(pA0,pA1,pB0,pB1,t+1,(t+4<NT),(t+2<NT),(t+2<NT));     ENDW(t+1); RESC(); ROT();
  }
  STEP(pB0,pB1,pA0,pA1,NT-1,false,false,false); RESC();
  { float sacc=pB0[0]+pB0[1]; _Pragma("unroll") for(int r=2;r<16;++r)sacc+=pB0[r]; _Pragma("unroll") for(int r=0;r<16;++r)sacc+=pB1[r]; l_reg+=sacc;
    pw0=(u32x4){PKW(pB0,0),PKW(pB0,2),PKW(pB0,4),PKW(pB0,6)};pw1=(u32x4){PKW(pB0,8),PKW(pB0,10),PKW(pB0,12),PKW(pB0,14)};pw2=(u32x4){PKW(pB1,0),PKW(pB1,2),PKW(pB1,4),PKW(pB1,6)};pw3=(u32x4){PKW(pB1,8),PKW(pB1,10),PKW(pB1,12),PKW(pB1,14)};
    SBAR(); pv(o,vb0+sl_cur,PAF(0),PAF(1),PAF(2),PAF(3)); }
  #undef PKW
  #undef PAF
  #undef VFR
  #undef PIN
  #undef MX3
  #undef GAPA
  #undef GAPB
  #undef EX
  #undef VRD
  #undef KRD
  #undef STEP
  #undef ENDW
  {auto rr=__builtin_amdgcn_permlane32_swap(__float_as_uint(l_reg),__float_as_uint(l_reg),false,false);l_reg=__uint_as_float(rr[0])+__uint_as_float(rr[1]);}
  if(hi==0)wsf[32+r32]=l_reg;asm volatile("s_waitcnt lgkmcnt(0)":::"memory");
  float rli[16];
  #pragma unroll
  for(int r=0;r<16;++r)rli[r]=__builtin_amdgcn_rcpf(wsf[32+crow(r,hi)]);
  bf16*Ow=O+(rowbase+q0+wid*QBLK)*DM+h*D;
  { bf16*stg=(bf16*)(shm+LDS_OST)+wid*2048;
    #pragma unroll
    for(int r=0;r<16;++r){const int orow=crow(r,hi);
      #pragma unroll
      for(int d0=0;d0<2;++d0)stg[orow*64+d0*32+r32]=__float2bfloat16(o[d0][r]*rli[r]);}
    asm volatile("s_waitcnt lgkmcnt(0)":::"memory");
    #pragma unroll
    for(int i=0;i<4;++i){const int row=i*8+(lane>>3),ch=lane&7; const u32x4 v=*(const u32x4*)(stg+row*64+ch*8); ATTN_STORE16(Ow+(long)row*DM+ch*8,v);} }
  asm volatile("s_waitcnt lgkmcnt(0)\n\ts_barrier":::"memory");
  #undef DMA_K
  #undef DMA_V
  #undef CMASK
  #undef START
  #undef RESC
  #undef ROT
}
constexpr int ATTN_LDS_BYTES=LDS_BYTES;
struct AttnTensors { const bf16* Q; const bf16* K; const bf16* V; bf16* O; const unsigned* SEL; };
struct AttnUnit { int bh; int qb; };
struct StaticOrder {
  int vcu;
  __device__ __forceinline__ explicit StaticOrder(int grid,int block):vcu((block%8)*(grid/8)+block/8){}
  __device__ __forceinline__ bool next(int i,AttnUnit&u)const{ if(i>=4)return false; const int s=vcu&7; u.bh=vcu>>3; u.qb=(i==0)?s:(i==1)?15-s:(i==2)?16+s:31-s; return true; }
  __device__ __forceinline__ void a_ready(const AttnUnit&)const{}
  __device__ __forceinline__ void done(const AttnUnit&)const{}
};
template<class Sched,int THRL=8> __device__ __forceinline__ void attn_phase(char*lds,const AttnTensors&T,const Sched&S){
  AttnUnit u;
  for(int i=0;S.next(i,u);++i){ S.a_ready(u); attn_unit<THRL>(u.bh/NHEAD,u.bh%NHEAD,u.qb,T.Q,T.K,T.V,T.O,T.SEL,lds); S.done(u); }
}
#undef SBAR
#undef WAIT_BAR
}
#define LAS __attribute__((address_space(3)))
typedef unsigned short bf16;
typedef unsigned v4u __attribute__((ext_vector_type(4)));
typedef unsigned v2u __attribute__((ext_vector_type(2)));
typedef float f32x4 __attribute__((ext_vector_type(4)));
typedef short bf16x8 __attribute__((ext_vector_type(8)));
typedef short s16x4 __attribute__((ext_vector_type(4)));
constexpr int NWAVES = 8, NTHR = 512;
constexpr int SEQ = 8192, DM = 1024, M = 16384, FF = 2816, ABIN = 2560, CIN = 3072;
constexpr float C2 = 0.125f * 1.4426950408889634f;
constexpr size_t MiB = 1u << 20;
__host__ __device__ constexpr size_t ws_wgu(int f) { return (f == 0 ? 2 : f == 1 ? 13 : f == 2 ? 42 : 53) * MiB; }
__host__ __device__ constexpr size_t ws_wd(int f) { return (f == 0 ? 48 : f == 1 ? 59 : f == 2 ? 128 : 139) * (MiB / 2); }
constexpr size_t WS_WABIN = 35 * MiB, WS_WABOUT = 40 * MiB, WS_WCIN = 75 * MiB, WS_WCOUT = 81 * MiB;
constexpr size_t WS_PO2 = 2 * MiB, WS_LSE = 34 * MiB;
constexpr size_t WS_CNT = 131072;
constexpr size_t WS_LIST = 248 * MiB;
constexpr size_t WS_WSB = 83 * MiB;
constexpr size_t WS_PART = 84 * MiB;
constexpr size_t WS_KM = 85 * MiB;
constexpr size_t WS_SEL = 86 * MiB;
constexpr size_t WS_XB = 88 * MiB;
constexpr size_t WS_ACT = 120 * MiB;
constexpr size_t WS_MIX = 216 * MiB;
constexpr size_t WS_END = 256 * MiB;
constexpr int LDS_BYTES = 147456;
constexpr int MISC_OFF = 131072 + 320;
constexpr size_t WS_BAR = 65536;

__device__ __forceinline__ unsigned f2bf(float f) { unsigned u = __builtin_bit_cast(unsigned, f); return (u + 0x7fffu + ((u >> 16) & 1u)) >> 16; }
typedef float f32x2_t __attribute__((ext_vector_type(2))); typedef __bf16 bf16x2_t __attribute__((ext_vector_type(2)));
__device__ __forceinline__ unsigned pk2(float lo, float hi) { f32x2_t v = {lo, hi}; bf16x2_t b = __builtin_convertvector(v, bf16x2_t); return __builtin_bit_cast(unsigned, b); }
__device__ __forceinline__ float bf2f(unsigned short b) { return __builtin_bit_cast(float, (unsigned)b << 16); }
__device__ __forceinline__ float wave_sum(float v) {
#pragma unroll
    for (int o = 1; o < 64; o <<= 1) v += __shfl_xor(v, o);
    return v;
}
__device__ __forceinline__ float gelu_tanh(float x) {
    const float y = 0.7978845608028654f * (x + 0.044715f * x * x * x);
    return x * __builtin_amdgcn_rcpf(1.0f + __builtin_amdgcn_exp2f(-2.0f * 1.4426950408889634f * y));
}
constexpr int TP_STRIDE = 136;
__device__ __forceinline__ void p0_transpose_item(const float* W, int K, int N, bf16* WT, int mode, const float* gain, LAS unsigned char* scr, int item, int lane) {
    const int nblk = N / 64, kb = item / nblk, nb = item % nblk, k0 = 64 * kb, n0 = 64 * nb;
    const int d0 = (mode == 0) ? n0 : ((n0 >> 7) * 256 + (n0 & 127) + (mode == 2 ? 128 : 0));
    const int kr = lane >> 4, nc = (lane & 15) * 4;
    f32x4 v[16];
#pragma unroll
    for (int i = 0; i < 16; ++i) v[i] = __builtin_nontemporal_load((const f32x4*)(W + (size_t)(k0 + 4 * i + kr) * N + n0 + nc));
#pragma unroll
    for (int i = 0; i < 16; ++i) { const float gk = gain ? gain[k0 + 4 * i + kr] : 1.0f; v2u w; w.x = pk2(v[i][0] * gk, v[i][1] * gk); w.y = pk2(v[i][2] * gk, v[i][3] * gk);
        *(LAS v2u*)(scr + (4 * i + kr) * TP_STRIDE + nc * 2) = w; }
    asm volatile("s_waitcnt lgkmcnt(0)" ::: "memory");
    const int g = lane >> 4, li = lane & 15, qq = li >> 2, pp = li & 3;
#pragma unroll
    for (int nb16 = 0; nb16 < 4; ++nb16)
#pragma unroll
        for (int half = 0; half < 2; ++half) { const int kc = g + 4 * half;
            LAS unsigned char* a = scr + (8 * kc + qq) * TP_STRIDE + (16 * nb16 + 4 * pp) * 2;
            const s16x4 lo = __builtin_bit_cast(s16x4, __builtin_amdgcn_ds_read_tr16_b64_v4i16((LAS s16x4*)a));
            const s16x4 hi = __builtin_bit_cast(s16x4, __builtin_amdgcn_ds_read_tr16_b64_v4i16((LAS s16x4*)(a + 4 * TP_STRIDE)));
            const bf16x8 o = (bf16x8){lo[0], lo[1], lo[2], lo[3], hi[0], hi[1], hi[2], hi[3]};
            *(bf16x8*)(WT + (size_t)(d0 + 16 * nb16 + li) * K + k0 + 8 * kc) = o; }
    asm volatile("s_waitcnt lgkmcnt(0)" ::: "memory");
}
#define XB_TMO      128
#define XB_XCNT(j)  (256  + 64 * (j))
#define XB_XSUB(j)  (1280 + 64 * (j))
#define XB_XGEN(j)  (2304 + 64 * (j))
#define XB_TOP      3328
#define XB_TOPGEN   3392
#define XCD_BAR_WORDS 3456
#define XB_SPIN_CAP (1u << 18)

__device__ __forceinline__ unsigned xb_ld(unsigned* p)              { return __hip_atomic_load(p, __ATOMIC_RELAXED, __HIP_MEMORY_SCOPE_AGENT); }
__device__ __forceinline__ unsigned xb_add(unsigned* p, unsigned v) { return __hip_atomic_fetch_add(p, v, __ATOMIC_RELAXED, __HIP_MEMORY_SCOPE_AGENT); }
__device__ __forceinline__ unsigned xb_xcc_id() { return (unsigned)__builtin_amdgcn_s_getreg((3 << 11) | 20) & 0xFu; }
#define XB_SPIN(cond, bar) do { unsigned _sp = 0; while (cond) { __builtin_amdgcn_s_sleep(1); \
    if ((++_sp & 255u) == 0u) { if (xb_ld(&(bar)[XB_TMO])) break; if (_sp > XB_SPIN_CAP) { atomicAdd(&(bar)[XB_TMO], 1u); break; } } } } while (0)

struct XcdBarrier {
    unsigned* bar; unsigned x;
    volatile LAS unsigned* st;
};

__device__ __forceinline__ XcdBarrier xcd_barrier_post(unsigned* bar, volatile LAS unsigned* st) {
    XcdBarrier b; b.bar = bar; b.x = xb_xcc_id(); b.st = st;
    if (threadIdx.x == 0) (void)xb_add(&bar[XB_XCNT(b.x)], 1u);
    return b;
}
__device__ __forceinline__ void xcd_barrier_complete(unsigned* bar, unsigned x, unsigned& nloc, unsigned& nx) {
    const unsigned G = gridDim.x * gridDim.y * gridDim.z;
    unsigned sum, cnt, mine, sp = 0u;
    for (;;) {
        sum = 0u; cnt = 0u; mine = 0u;
#pragma unroll
        for (unsigned j = 0; j < 16; ++j) { const unsigned c = xb_ld(&bar[XB_XCNT(j)]); sum += c; cnt += (c > 0u) ? 1u : 0u; mine = (j == x) ? c : mine; }
        if (sum == G) break;
        __builtin_amdgcn_s_sleep(1);
        if ((++sp & 255u) == 0u) { if (xb_ld(&bar[XB_TMO])) break; if (sp > XB_SPIN_CAP) { atomicAdd(&bar[XB_TMO], 1u); break; } }
    }
    nloc = mine > 0u ? mine : 1u; nx = cnt > 0u ? cnt : 1u;
}

__device__ __forceinline__ void xcd_barrier(const XcdBarrier& b) {
    asm volatile("s_waitcnt vmcnt(0)" ::: "memory");
    __syncthreads();
    if (threadIdx.x == 0) {
        unsigned* bar = b.bar;
        __builtin_amdgcn_s_waitcnt(0);
        unsigned nloc = b.st[0], nx = b.st[1];
        if (nloc == 0u) { xcd_barrier_complete(bar, b.x, nloc, nx); b.st[0] = nloc; b.st[1] = nx; }
        const unsigned old = xb_add(&bar[XB_XSUB(b.x)], 1u);
        const unsigned gen = old / nloc;
        if (old + 1u == (gen + 1u) * nloc) {
            __builtin_amdgcn_fence(__ATOMIC_RELEASE, "agent");
            asm volatile("s_waitcnt vmcnt(0)" ::: "memory");
            const unsigned og = xb_add(&bar[XB_TOP], 1u);
            const unsigned tg = og / nx;
            if (og + 1u == (tg + 1u) * nx) xb_add(&bar[XB_TOPGEN], 1u);
            else XB_SPIN(xb_ld(&bar[XB_TOPGEN]) == tg, bar);
            __builtin_amdgcn_fence(__ATOMIC_ACQUIRE, "agent");
            xb_add(&bar[XB_XGEN(b.x)], 1u);
            asm volatile("s_waitcnt vmcnt(0)" ::: "memory");
        } else {
            XB_SPIN(xb_ld(&bar[XB_XGEN(b.x)]) == gen, bar);
            __builtin_amdgcn_fence(__ATOMIC_ACQUIRE, "agent");
            asm volatile("s_waitcnt vmcnt(0)" ::: "memory");
        }
    }
    __syncthreads();
}

struct EpiResidNorm {
    static constexpr bool PERM = true, AFTER_DRAIN = true;
    const bf16* basexb; float* out; float* part; const float* gfin; float alpha; XcdBarrier xb;
    __device__ __forceinline__ void fused(pg8::f32x4 (&acc)[2][2][4][2], const pg8::Unit& u, int wr, int wc, int fr, int fq, LAS unsigned char* lds, int wid, int lane) const {
        const int row0 = u.pm * pg8::BM + wr * 64 + fr; const int col0 = u.pn * pg8::BM + wc * 32 + 8 * fq;
#pragma unroll
        for (int ai = 0; ai < 2; ++ai)
#pragma unroll
            for (int m = 0; m < 4; ++m) { const int row = row0 + ai * pg8::HALF + m * 16; float ss = 0.f;
#pragma unroll
                for (int bj = 0; bj < 2; ++bj) { const size_t off = (size_t)row * 1024 + col0 + bj * pg8::HALF;
                    const v4u r = *(const v4u*)(basexb + off);
                    const pg8::f32x4 b0 = (pg8::f32x4){__builtin_bit_cast(float, r.x << 16), __builtin_bit_cast(float, r.x & 0xffff0000u), __builtin_bit_cast(float, r.y << 16), __builtin_bit_cast(float, r.y & 0xffff0000u)};
                    const pg8::f32x4 b1 = (pg8::f32x4){__builtin_bit_cast(float, r.z << 16), __builtin_bit_cast(float, r.z & 0xffff0000u), __builtin_bit_cast(float, r.w << 16), __builtin_bit_cast(float, r.w & 0xffff0000u)};
                    const pg8::f32x4 v0 = b0 + acc[ai][bj][m][0] * alpha, v1 = b1 + acc[ai][bj][m][1] * alpha;
                    acc[ai][bj][m][0] = v0; acc[ai][bj][m][1] = v1;
                    ss += ((v0[0] * v0[0] + v0[1] * v0[1]) + (v0[2] * v0[2] + v0[3] * v0[3])) + ((v1[0] * v1[0] + v1[1] * v1[1]) + (v1[2] * v1[2] + v1[3] * v1[3])); }
                ss += __shfl_xor(ss, 16); ss += __shfl_xor(ss, 32);
                if (fq == 0) part[(size_t)row * 16 + u.pn * 4 + wc] = ss; }
        xcd_barrier(xb);
#pragma unroll
        for (int ai = 0; ai < 2; ++ai)
#pragma unroll
            for (int m = 0; m < 4; ++m) { const int row = row0 + ai * pg8::HALF + m * 16; const float rs = pg8::row_rstd(part, row);
#pragma unroll
                for (int bj = 0; bj < 2; ++bj) { const size_t off = (size_t)row * 1024 + col0 + bj * pg8::HALF;
                    const pg8::f32x4 g0 = *(const pg8::f32x4*)(gfin + col0 + bj * pg8::HALF), g1 = *(const pg8::f32x4*)(gfin + col0 + bj * pg8::HALF + 4);
                    *(pg8::f32x4*)(out + off) = acc[ai][bj][m][0] * rs * g0; *(pg8::f32x4*)(out + off + 4) = acc[ai][bj][m][1] * rs * g1; } }
    }
};
constexpr int RSTD_OFF = 131072 + 1024;
__device__ __forceinline__ void rstd_table(const float* part, LAS unsigned char* lds, const pg8::StaticOrder& S) {
    LAS float* T = (LAS float*)(lds + RSTD_OFF);
    const int tid = threadIdx.x;
#pragma unroll
    for (int pass = 0; pass < 3; ++pass) { const int i = 2 * pass + (tid >> 8); pg8::Unit u; if (S.next(i, u)) T[i * 256 + (tid & 255)] = pg8::row_rstd(part, u.pm * 256 + (tid & 255)); }
    __syncthreads();
}
struct Args { const float* in[18]; float* out; unsigned char* ws; int ph_lo, ph_hi; };

constexpr int I_G = (DM / 64) * (FF / 64), I_D = (FF / 64) * (DM / 64), I_ABIN = (DM / 64) * (ABIN / 64), I_SQ = (DM / 64) * (DM / 64), I_CIN = (DM / 64) * (CIN / 64);
__device__ __forceinline__ constexpr int mat_items(int id) { return id < 0 ? 0 : id < 4 ? 2 * I_G : id < 8 ? I_D : id == 8 ? I_ABIN : id == 10 ? I_CIN : I_SQ; }
__device__ __forceinline__ void conv_item(const Args& A, LAS unsigned char* scr, int lane, int id, int r) {
    unsigned char* ws = A.ws;
    if (id < 4) { const int f = id, layer = f >> 1, second = f & 1; const float* gain = A.in[second ? 6 : 1] + layer * DM; bf16* wgu = (bf16*)(ws + ws_wgu(f));
        if (r < I_G) p0_transpose_item(A.in[second ? 7 : 2] + (size_t)layer * DM * FF, DM, FF, wgu, 1, gain, scr, r, lane);
        else p0_transpose_item(A.in[second ? 8 : 3] + (size_t)layer * DM * FF, DM, FF, wgu, 2, gain, scr, r - I_G, lane); }
    else if (id < 8) { const int f = id - 4, layer = f >> 1, second = f & 1; p0_transpose_item(A.in[second ? 9 : 4] + (size_t)layer * FF * DM, FF, DM, (bf16*)(ws + ws_wd(f)), 0, nullptr, scr, r, lane); }
    else if (id == 8) p0_transpose_item(A.in[10], DM, ABIN, (bf16*)(ws + WS_WABIN), 0, A.in[5], scr, r, lane);
    else if (id == 9) p0_transpose_item(A.in[14], DM, DM, (bf16*)(ws + WS_WABOUT), 0, nullptr, scr, r, lane);
    else if (id == 10) p0_transpose_item(A.in[15], DM, CIN, (bf16*)(ws + WS_WCIN), 0, A.in[5] + DM, scr, r, lane);
    else p0_transpose_item(A.in[16], DM, DM, (bf16*)(ws + WS_WCOUT), 0, nullptr, scr, r, lane);
}
__device__ __forceinline__ void conv_set(const Args& A, LAS unsigned char* lds, int wave, int lane, int gw, int NGW, int id0, int id1, int id2) {
    LAS unsigned char* scr = lds + wave * 16384;
    const int n0 = mat_items(id0), n1 = mat_items(id1), n2 = mat_items(id2);
    for (int it = gw; it < n0 + n1 + n2; it += NGW) {
        if (it < n0) conv_item(A, scr, lane, id0, it); else if (it < n0 + n1) conv_item(A, scr, lane, id1, it - n0); else conv_item(A, scr, lane, id2, it - n0 - n1); }
}
__device__ __forceinline__ void conv_idle(const Args& A, LAS unsigned char* lds, int id0, int id1, int id2) {
    if (blockIdx.x >= 128) { const int tid_ = threadIdx.x; conv_set(A, lds, __builtin_amdgcn_readfirstlane(tid_ >> 6), tid_ & 63, ((int)blockIdx.x - 128) * NWAVES + (tid_ >> 6), ((int)gridDim.x - 128) * NWAVES, id0, id1, id2); }
}
__device__ __forceinline__ void phase_prologue(const Args& A, LAS unsigned char* lds, int wave, int lane) {
    const int gw = blockIdx.x * NWAVES + wave, NGW = gridDim.x * NWAVES;
    unsigned char* ws = A.ws;
    conv_set(A, lds, wave, lane, gw, NGW, 0, 4, 3);
    { const float* wsp = A.in[12]; bf16* o = (bf16*)(ws + WS_WSB);
      for (int i = blockIdx.x * NTHR + threadIdx.x; i < 4 * 128 * 128; i += gridDim.x * NTHR) { const int p = (i >> 7) & 127, q = i & 127; o[i] = (bf16)f2bf(q <= p ? wsp[i] : 0.f); } }
    const float* x = A.in[0]; bf16* xb = (bf16*)(ws + WS_XB); float* part = (float*)(ws + WS_PART);
    for (int m = gw; m < M; m += NGW) {
        const f32x4* xr = (const f32x4*)(x + (size_t)m * DM) + lane; f32x4 v[4]; float s = 0.f;
#pragma unroll
        for (int j = 0; j < 4; ++j) { v[j] = __builtin_nontemporal_load(xr + 64 * j); s += (v[j][0] * v[j][0] + v[j][1] * v[j][1]) + (v[j][2] * v[j][2] + v[j][3] * v[j][3]); }
        s = wave_sum(s);
        v2u* o8 = (v2u*)(xb + (size_t)m * DM) + lane;
#pragma unroll
        for (int j = 0; j < 4; ++j) { v2u w; w.x = pk2(v[j][0], v[j][1]); w.y = pk2(v[j][2], v[j][3]); o8[64 * j] = w; }
        if (lane < 16) part[(size_t)m * 16 + lane] = (lane == 0) ? s : 0.f;
    }
}

constexpr int GV_STRIDE = 272;
__device__ __forceinline__ void gate_unit(const Args& A, LAS unsigned char* lds, int unit, int wave, int lane) {
    const int g4 = unit & 3, n = (unit >> 2) & 63, b = unit >> 8;
    const size_t R0 = (size_t)b * SEQ + (size_t)n * 128;
    const bf16* Z = (const bf16*)(A.ws + WS_ACT); bf16* MIX = (bf16*)(A.ws + WS_MIX); const bf16* WsB = (const bf16*)(A.ws + WS_WSB) + (size_t)g4 * 128 * 128;
    const float* vnorm = A.in[11] + g4 * 128; const float* bsp = A.in[13] + g4 * 128;
    const int tid = threadIdx.x;
    { const int row = tid >> 2, qt = tid & 3; const bf16* vp = Z + (R0 + row) * ABIN + 2048 + 128 * g4 + 32 * qt;
      float v[32]; float ss = 0.f;
#pragma unroll
      for (int i = 0; i < 4; ++i) { const bf16x8 raw = *(const bf16x8*)(vp + 8 * i);
#pragma unroll
          for (int e = 0; e < 8; ++e) { const float gl = gelu_tanh(bf2f((unsigned short)raw[e])); v[8 * i + e] = gl; ss += gl * gl; } }
      ss += __shfl_xor(ss, 1); ss += __shfl_xor(ss, 2);
      const float rs = rsqrtf(ss * (1.0f / 128.0f) + 1e-6f);
#pragma unroll
      for (int i = 0; i < 4; ++i) { const f32x4 g0 = *(const f32x4*)(vnorm + 32 * qt + 8 * i), g1 = *(const f32x4*)(vnorm + 32 * qt + 8 * i + 4);
          v4u w; w.x = pk2(v[8 * i] * rs * g0[0], v[8 * i + 1] * rs * g0[1]); w.y = pk2(v[8 * i + 2] * rs * g0[2], v[8 * i + 3] * rs * g0[3]);
          w.z = pk2(v[8 * i + 4] * rs * g1[0], v[8 * i + 5] * rs * g1[1]); w.w = pk2(v[8 * i + 6] * rs * g1[2], v[8 * i + 7] * rs * g1[3]);
          *(LAS v4u*)(lds + row * GV_STRIDE + qt * 64 + i * 16) = w; } }
    __syncthreads();
    const int pl = lane & 15, g = lane >> 4, qq = pl >> 2, pp = pl & 3;
    f32x4 acc[8];
#pragma unroll
    for (int cb = 0; cb < 8; ++cb) acc[cb] = (f32x4){0.f, 0.f, 0.f, 0.f};
    const int nks = (16 * wave + 15) / 32 + 1;
    for (int ks = 0; ks < nks; ++ks) {
        const bf16x8 bfrag = *(const bf16x8*)(WsB + (size_t)(16 * wave + pl) * 128 + 32 * ks + 8 * g);
        LAS unsigned char* base = lds + (32 * ks + 8 * g + qq) * GV_STRIDE + pp * 8;
#pragma unroll
        for (int cb = 0; cb < 8; ++cb) {
            const s16x4 lo = __builtin_bit_cast(s16x4, __builtin_amdgcn_ds_read_tr16_b64_v4i16((LAS s16x4*)(base + cb * 32)));
            const s16x4 hi = __builtin_bit_cast(s16x4, __builtin_amdgcn_ds_read_tr16_b64_v4i16((LAS s16x4*)(base + cb * 32 + 4 * GV_STRIDE)));
            const bf16x8 afrag = (bf16x8){lo[0], lo[1], lo[2], lo[3], hi[0], hi[1], hi[2], hi[3]};
            acc[cb] = __builtin_amdgcn_mfma_f32_16x16x32_bf16(afrag, bfrag, acc[cb], 0, 0, 0);
        }
    }
    { const int p = 16 * wave + pl; const float bias = bsp[p];
      const bf16* up = Z + (R0 + p) * ABIN + 1536 + 128 * g4 + 4 * g; bf16* op = MIX + (R0 + p) * DM + 512 + 128 * g4 + 4 * g;
#pragma unroll
      for (int cb = 0; cb < 8; ++cb) { const s16x4 ur = *(const s16x4*)(up + 16 * cb);
          v2u w; w.x = pk2(gelu_tanh(bf2f((unsigned short)ur[0])) * (acc[cb][0] + bias), gelu_tanh(bf2f((unsigned short)ur[1])) * (acc[cb][1] + bias));
          w.y = pk2(gelu_tanh(bf2f((unsigned short)ur[2])) * (acc[cb][2] + bias), gelu_tanh(bf2f((unsigned short)ur[3])) * (acc[cb][3] + bias));
          *(v2u*)(op + 16 * cb) = w; } }
    __syncthreads();
}

constexpr int DV_STRIDE = 160, DV_BUF = 32 * DV_STRIDE;
__device__ __forceinline__ void dil_unit(const Args& A, LAS unsigned char* vl, int unit, int lane) {
    const int r16 = unit & 15, sp = (unit >> 4) & 31, h = (unit >> 9) & 7, b = unit >> 12;
    const bf16* Z = (const bf16*)(A.ws + WS_ACT); bf16* MIX = (bf16*)(A.ws + WS_MIX);
    const int qi = lane & 15, g = lane >> 4, T0 = sp * 256;
    const size_t rowb = (size_t)b * SEQ;
    const int tq = T0 + r16 + 16 * qi;
    const bf16* qp = Z + (rowb + tq) * ABIN + h * 64 + 8 * g;
    const bf16x8 qf0 = *(const bf16x8*)qp, qf1 = *(const bf16x8*)(qp + 32);
    const bf16* Kb = Z + rowb * ABIN + 512 + h * 64 + 8 * g;
    const bf16* Vb = Z + rowb * ABIN + 1024 + h * 64 + 8 * (lane & 7);
    float mrun = -INFINITY, lrun = 0.f; f32x4 o[4];
#pragma unroll
    for (int d = 0; d < 4; ++d) o[d] = (f32x4){0.f, 0.f, 0.f, 0.f};
    const int tb = T0 + r16;
    constexpr int DIL_D = 3;
    bf16x8 kn[DIL_D][4], vn[DIL_D][4];
#define DIL_PARAMS(it, dsh, j) const int dsh = ((it) < 12) ? 0 : ((it) < 18) ? 2 : 4; const int j = (it) - (((it) < 12) ? 0 : ((it) < 18) ? 12 : 18);
#define DIL_LOAD(it, S) do { DIL_PARAMS(it, dsh_, j_) const int c_ = tb & ((1 << dsh_) - 1), skb_ = (tb >> dsh_) - 128 + 32 * j_; \
        _Pragma("unroll") for (int s_ = 0; s_ < 2; ++s_) { int t_ = c_ + ((skb_ + 16 * s_ + qi) << dsh_); t_ = t_ < 0 ? 0 : (t_ > SEQ - 1 ? SEQ - 1 : t_); \
            kn[S][2 * s_] = *(const bf16x8*)(Kb + (size_t)t_ * ABIN); kn[S][2 * s_ + 1] = *(const bf16x8*)(Kb + (size_t)t_ * ABIN + 32); } \
        _Pragma("unroll") for (int i_ = 0; i_ < 4; ++i_) { int t_ = c_ + ((skb_ + (lane >> 3) + 8 * i_) << dsh_); t_ = t_ < 0 ? 0 : (t_ > SEQ - 1 ? SEQ - 1 : t_); \
            vn[S][i_] = *(const bf16x8*)(Vb + (size_t)t_ * ABIN); } } while (0)
#pragma unroll
    for (int p = 0; p < DIL_D; ++p) DIL_LOAD(p, p);
#pragma nounroll
    for (int it0 = 0; it0 < 24; it0 += DIL_D) {
#pragma unroll
      for (int S = 0; S < DIL_D; ++S) { const int it = it0 + S; if (it < 23) {
        LAS unsigned char* buf = vl + (it & 1) * DV_BUF;
        const bf16x8 k0 = kn[S][0], k1 = kn[S][1], k2 = kn[S][2], k3 = kn[S][3];
#pragma unroll
        for (int i = 0; i < 4; ++i) *(LAS bf16x8*)(buf + ((lane >> 3) + 8 * i) * DV_STRIDE + (lane & 7) * 16) = vn[S][i];
        if (it + DIL_D < 23) DIL_LOAD(it + DIL_D, S);
        DIL_PARAMS(it, dsh, j)
        const int skb = (tb >> dsh) - 128 + 32 * j, sq = (tb >> dsh) + ((16 >> dsh) * qi);
        f32x4 sa = (f32x4){0.f, 0.f, 0.f, 0.f}, sb = (f32x4){0.f, 0.f, 0.f, 0.f};
        sa = __builtin_amdgcn_mfma_f32_16x16x32_bf16(k0, qf0, sa, 0, 0, 0); sa = __builtin_amdgcn_mfma_f32_16x16x32_bf16(k1, qf1, sa, 0, 0, 0);
        sb = __builtin_amdgcn_mfma_f32_16x16x32_bf16(k2, qf0, sb, 0, 0, 0); sb = __builtin_amdgcn_mfma_f32_16x16x32_bf16(k3, qf1, sb, 0, 0, 0);
        float mx = -INFINITY;
#pragma unroll
        for (int e = 0; e < 4; ++e) { const int ska = skb + 4 * g + e, skq = ska + 16;
            const bool va = (ska >= 0) && (ska <= sq) && (sq - ska <= 128), vb = (skq >= 0) && (skq <= sq) && (sq - skq <= 128);
            sa[e] = va ? sa[e] : -INFINITY; sb[e] = vb ? sb[e] : -INFINITY; mx = fmaxf(mx, fmaxf(sa[e], sb[e])); }
        mx = fmaxf(mx, __shfl_xor(mx, 16)); mx = fmaxf(mx, __shfl_xor(mx, 32));
        const float mnew = fmaxf(mrun, mx), muse = (mnew == -INFINITY) ? 0.f : mnew;
        const float alpha = __builtin_amdgcn_exp2f(mrun - muse);
        float ps = 0.f; float pa[4], pb[4];
#pragma unroll
        for (int e = 0; e < 4; ++e) { pa[e] = __builtin_amdgcn_exp2f(sa[e] - muse); pb[e] = __builtin_amdgcn_exp2f(sb[e] - muse); ps += pa[e] + pb[e]; }
        lrun = lrun * alpha + ps; mrun = mnew;
        v4u pw; pw.x = pk2(pa[0], pa[1]); pw.y = pk2(pa[2], pa[3]); pw.z = pk2(pb[0], pb[1]); pw.w = pk2(pb[2], pb[3]);
        const bf16x8 pf = __builtin_bit_cast(bf16x8, pw);
        asm volatile("s_waitcnt lgkmcnt(0)" ::: "memory");
        LAS unsigned char* rb = buf + (4 * g + (qi >> 2)) * DV_STRIDE + (qi & 3) * 8;
#pragma unroll
        for (int db = 0; db < 4; ++db) {
            const s16x4 lo = __builtin_bit_cast(s16x4, __builtin_amdgcn_ds_read_tr16_b64_v4i16((LAS s16x4*)(rb + db * 32)));
            const s16x4 hi = __builtin_bit_cast(s16x4, __builtin_amdgcn_ds_read_tr16_b64_v4i16((LAS s16x4*)(rb + db * 32 + 16 * DV_STRIDE)));
            const bf16x8 vf = (bf16x8){lo[0], lo[1], lo[2], lo[3], hi[0], hi[1], hi[2], hi[3]};
            o[db] = o[db] * alpha;
            o[db] = __builtin_amdgcn_mfma_f32_16x16x32_bf16(vf, pf, o[db], 0, 0, 0);
        }
    } } }
#undef DIL_LOAD
#undef DIL_PARAMS
    lrun += __shfl_xor(lrun, 16); lrun += __shfl_xor(lrun, 32);
    const float inv = 1.0f / lrun;
    bf16* op = MIX + (rowb + tq) * DM + h * 64 + 4 * g;
#pragma unroll
    for (int db = 0; db < 4; ++db) { v2u w; w.x = pk2(o[db][0] * inv, o[db][1] * inv); w.y = pk2(o[db][2] * inv, o[db][3] * inv); *(v2u*)(op + 16 * db) = w; }
}

constexpr int DS_OFF = 16 * DV_BUF, DS_STRIDE = 144;
__device__ __forceinline__ void dil_wg_unit(const Args& A, LAS unsigned char* lds, int unit, int wave, int lane) {
    const int sp = unit & 31, h = (unit >> 5) & 7, b = unit >> 8;
    const bf16* Z = (const bf16*)(A.ws + WS_ACT); bf16* MIX = (bf16*)(A.ws + WS_MIX);
    const int qi = lane & 15, g = lane >> 4, T0 = sp * 256;
    const size_t rowb = (size_t)b * SEQ;
    const bf16* Kb = Z + rowb * ABIN + 512 + h * 64 + 8 * g;
    const bf16* Vb = Z + rowb * ABIN + 1024 + h * 64 + 8 * (lane & 7);
    LAS unsigned char* ST = lds + DS_OFF;
#pragma unroll 1
    for (int stage = 0; stage < 3; ++stage) {
        const int dsh = 4 - 2 * stage;
        int tbg[2]; bf16x8 qf[2][2]; float mrun[2], lrun[2]; f32x4 o[2][4];
#pragma unroll
        for (int k = 0; k < 2; ++k) { const int G = 2 * wave + k; tbg[k] = T0 + (stage == 0 ? G : stage == 1 ? 64 * (G >> 2) + (G & 3) : 16 * G);
            const bf16* qp = Z + (rowb + tbg[k] + (qi << dsh)) * ABIN + h * 64 + 8 * g; qf[k][0] = *(const bf16x8*)qp; qf[k][1] = *(const bf16x8*)(qp + 32); }
        bf16x8 kn[2][4], vn[2][4];
#define DW_LOAD(jt_) do { _Pragma("unroll") for (int k_ = 0; k_ < 2; ++k_) { const int c_ = tbg[k_] & ((1 << dsh) - 1), skb_ = (tbg[k_] >> dsh) - 128 + 32 * (jt_); \
        _Pragma("unroll") for (int i_ = 0; i_ < 4; ++i_) { int t_ = c_ + ((skb_ + (lane >> 3) + 8 * i_) << dsh); t_ = t_ < 0 ? 0 : (t_ > SEQ - 1 ? SEQ - 1 : t_); \
            kn[k_][i_] = *(const bf16x8*)(Vb + (size_t)t_ * ABIN - 512); vn[k_][i_] = *(const bf16x8*)(Vb + (size_t)t_ * ABIN); } } } while (0)
        DW_LOAD(0);
#pragma unroll
        for (int k = 0; k < 2; ++k) { LAS unsigned char* sq_p = ST + (tbg[k] + (qi << dsh) - T0) * DS_STRIDE;
            if (stage == 0) { mrun[k] = -INFINITY; lrun[k] = 0.f;
#pragma unroll
                for (int d = 0; d < 4; ++d) o[k][d] = (f32x4){0.f, 0.f, 0.f, 0.f}; }
            else { mrun[k] = *(LAS float*)(sq_p + 128); lrun[k] = (g == 0) ? *(LAS float*)(sq_p + 132) : 0.f;
#pragma unroll
                for (int d = 0; d < 4; ++d) { const s16x4 r = *(LAS s16x4*)(sq_p + (16 * d + 4 * g) * 2); o[k][d] = (f32x4){bf2f((unsigned short)r[0]), bf2f((unsigned short)r[1]), bf2f((unsigned short)r[2]), bf2f((unsigned short)r[3])}; } } }
#pragma nounroll
        for (int jt = 0; jt < 5; ++jt) {
            bf16x8 kc[2][4], vc[2][4];
#pragma unroll
            for (int k = 0; k < 2; ++k) { LAS unsigned char* vbuf = lds + (wave * 2 + k) * DV_BUF;
#pragma unroll
                for (int i = 0; i < 4; ++i) { vc[k][i] = vn[k][i]; *(LAS bf16x8*)(vbuf + ((lane >> 3) + 8 * i) * DV_STRIDE + (lane & 7) * 16) = kn[k][i]; } }
            if (jt + 1 < 5) DW_LOAD(jt + 1);
            asm volatile("s_waitcnt lgkmcnt(0)" ::: "memory");
#pragma unroll
            for (int k = 0; k < 2; ++k) { LAS unsigned char* kb_ = lds + (wave * 2 + k) * DV_BUF + qi * DV_STRIDE + 16 * g;
                kc[k][0] = *(LAS bf16x8*)(kb_); kc[k][1] = *(LAS bf16x8*)(kb_ + 64); kc[k][2] = *(LAS bf16x8*)(kb_ + 16 * DV_STRIDE); kc[k][3] = *(LAS bf16x8*)(kb_ + 16 * DV_STRIDE + 64); }
            asm volatile("s_waitcnt lgkmcnt(0)" ::: "memory");
#pragma unroll
            for (int k = 0; k < 2; ++k) { LAS unsigned char* vbuf = lds + (wave * 2 + k) * DV_BUF;
#pragma unroll
                for (int i = 0; i < 4; ++i) *(LAS bf16x8*)(vbuf + ((lane >> 3) + 8 * i) * DV_STRIDE + (lane & 7) * 16) = vc[k][i]; }
            f32x4 sa[2], sb[2]; float alpha[2]; bf16x8 pf[2];
#pragma unroll
            for (int k = 0; k < 2; ++k) {
                sa[k] = (f32x4){0.f, 0.f, 0.f, 0.f}; sb[k] = sa[k];
                sa[k] = __builtin_amdgcn_mfma_f32_16x16x32_bf16(kc[k][0], qf[k][0], sa[k], 0, 0, 0); sa[k] = __builtin_amdgcn_mfma_f32_16x16x32_bf16(kc[k][1], qf[k][1], sa[k], 0, 0, 0);
                sb[k] = __builtin_amdgcn_mfma_f32_16x16x32_bf16(kc[k][2], qf[k][0], sb[k], 0, 0, 0); sb[k] = __builtin_amdgcn_mfma_f32_16x16x32_bf16(kc[k][3], qf[k][1], sb[k], 0, 0, 0); }
#pragma unroll
            for (int k = 0; k < 2; ++k) {
                const int skb = (tbg[k] >> dsh) - 128 + 32 * jt, sq = (tbg[k] >> dsh) + qi;
                float mx = -INFINITY;
#pragma unroll
                for (int e = 0; e < 4; ++e) { const int ska = skb + 4 * g + e, skq = ska + 16;
                    const bool va = (ska >= 0) && (ska <= sq) && (sq - ska <= 128), vb = (skq >= 0) && (skq <= sq) && (sq - skq <= 128);
                    sa[k][e] = va ? sa[k][e] : -INFINITY; sb[k][e] = vb ? sb[k][e] : -INFINITY; mx = fmaxf(mx, fmaxf(sa[k][e], sb[k][e])); }
                mx = fmaxf(mx, __shfl_xor(mx, 16)); mx = fmaxf(mx, __shfl_xor(mx, 32));
                const float mnew = fmaxf(mrun[k], mx), muse = (mnew == -INFINITY) ? 0.f : mnew;
                alpha[k] = __builtin_amdgcn_exp2f(mrun[k] - muse);
                float ps = 0.f; float pa[4], pb[4];
#pragma unroll
                for (int e = 0; e < 4; ++e) { pa[e] = __builtin_amdgcn_exp2f(sa[k][e] - muse); pb[e] = __builtin_amdgcn_exp2f(sb[k][e] - muse); ps += pa[e] + pb[e]; }
                lrun[k] = lrun[k] * alpha[k] + ps; mrun[k] = mnew;
                v4u pw; pw.x = pk2(pa[0], pa[1]); pw.y = pk2(pa[2], pa[3]); pw.z = pk2(pb[0], pb[1]); pw.w = pk2(pb[2], pb[3]);
                pf[k] = __builtin_bit_cast(bf16x8, pw); }
            asm volatile("s_waitcnt lgkmcnt(0)" ::: "memory");
#pragma unroll
            for (int k = 0; k < 2; ++k) { LAS unsigned char* rb = lds + (wave * 2 + k) * DV_BUF + (4 * g + (qi >> 2)) * DV_STRIDE + (qi & 3) * 8;
#pragma unroll
                for (int db = 0; db < 4; ++db) {
                    const s16x4 lo = __builtin_bit_cast(s16x4, __builtin_amdgcn_ds_read_tr16_b64_v4i16((LAS s16x4*)(rb + db * 32)));
                    const s16x4 hi = __builtin_bit_cast(s16x4, __builtin_amdgcn_ds_read_tr16_b64_v4i16((LAS s16x4*)(rb + db * 32 + 16 * DV_STRIDE)));
                    const bf16x8 vf = (bf16x8){lo[0], lo[1], lo[2], lo[3], hi[0], hi[1], hi[2], hi[3]};
                    o[k][db] = o[k][db] * alpha[k];
                    o[k][db] = __builtin_amdgcn_mfma_f32_16x16x32_bf16(vf, pf[k], o[k][db], 0, 0, 0);
                } }
            asm volatile("s_waitcnt lgkmcnt(0)" ::: "memory");
        }
#undef DW_LOAD
#pragma unroll
        for (int k = 0; k < 2; ++k) { const int qpos = tbg[k] + (qi << dsh) - T0; LAS unsigned char* sq_p = ST + qpos * DS_STRIDE;
            float lt = lrun[k]; lt += __shfl_xor(lt, 16); lt += __shfl_xor(lt, 32);
            if (stage < 2) {
#pragma unroll
                for (int d = 0; d < 4; ++d) { v2u w; w.x = pk2(o[k][d][0], o[k][d][1]); w.y = pk2(o[k][d][2], o[k][d][3]); *(LAS v2u*)(sq_p + (16 * d + 4 * g) * 2) = w; }
                if (g == 0) { *(LAS float*)(sq_p + 128) = mrun[k]; *(LAS float*)(sq_p + 132) = lt; }
            } else {
                const float inv = 1.0f / lt;
                bf16* op = MIX + (rowb + T0 + qpos) * DM + h * 64 + 4 * g;
#pragma unroll
                for (int db = 0; db < 4; ++db) { v2u w; w.x = pk2(o[k][db][0] * inv, o[k][db][1] * inv); w.y = pk2(o[k][db][2] * inv, o[k][db][3] * inv); *(v2u*)(op + 16 * db) = w; }
            } }
        __syncthreads();
    }
}
__device__ __forceinline__ void select_phase(const Args& A, LAS unsigned char* lds, int wave, int lane) {
    LAS unsigned* lcnt = (LAS unsigned*)lds; LAS unsigned* lbase = lcnt + 32;
    const int tid = threadIdx.x;
    for (int k = 0; k < 2; ++k) {
        const int U = blockIdx.x + 256 * k, bh = (U >> 4) & 31, c16 = k ? 15 - (U & 15) : (U & 15), b = bh >> 4, h = bh & 15;
        const int ch = c16 * 8 + wave, t = ch * 64 + lane, own = ch >> 2;
        if (tid < 32) lcnt[tid] = 0u;
        __syncthreads();
        unsigned mask = 0u; int i1 = -1, i2 = -1, i3 = -1;
        if (own > 0) {
            const bf16* qp = (const bf16*)(A.ws + WS_ACT) + ((size_t)b * SEQ + t) * DM + h * 64;
            float q[64];
#pragma unroll
            for (int i = 0; i < 8; ++i) { const bf16x8 raw = *(const bf16x8*)(qp + 8 * i);
#pragma unroll
                for (int e = 0; e < 8; ++e) q[8 * i + e] = bf2f((unsigned short)raw[e]); }
            const float* km = (const float*)(A.ws + WS_KM) + (size_t)(b * 32) * 2048 + h * 64 + lane;
            float v1 = -INFINITY, v2 = -INFINITY, v3 = -INFINITY;
            for (int j0 = 0; j0 < own; j0 += 4) {
                float kmv[4];
#pragma unroll
                for (int u = 0; u < 4; ++u) { const int jj = (j0 + u < own) ? j0 + u : own - 1; kmv[u] = km[(size_t)jj * 2048] + km[(size_t)jj * 2048 + 1024]; }
#pragma unroll
                for (int u = 0; u < 4; ++u) { const int j = j0 + u;
                    float s = 0.f;
#pragma unroll
                    for (int d = 0; d < 64; ++d) s += q[d] * __builtin_bit_cast(float, __builtin_amdgcn_readlane(__builtin_bit_cast(int, kmv[u]), d));
                    if (j < own) {
                        if (s > v1) { v3 = v2; i3 = i2; v2 = v1; i2 = i1; v1 = s; i1 = j; }
                        else if (s > v2) { v3 = v2; i3 = i2; v2 = s; i2 = j; }
                        else if (s > v3) { v3 = s; i3 = j; } } }
            }
            if (i1 >= 0) mask |= 1u << i1; if (i2 >= 0) mask |= 1u << i2; if (i3 >= 0) mask |= 1u << i3;
        }
        unsigned p1 = 0, p2 = 0, p3 = 0;
        if (i1 >= 0) p1 = atomicAdd((unsigned*)(lcnt + i1), 1u);
        if (i2 >= 0) p2 = atomicAdd((unsigned*)(lcnt + i2), 1u);
        if (i3 >= 0) p3 = atomicAdd((unsigned*)(lcnt + i3), 1u);
        __syncthreads();
        if (tid < 32) { const unsigned n = lcnt[tid]; lbase[tid] = n ? atomicAdd((unsigned*)(A.ws + WS_CNT) + bh * 32 + tid, n) : 0u; }
        __syncthreads();
        unsigned short* list = (unsigned short*)(A.ws + WS_LIST) + (size_t)bh * 126976;
        if (i1 >= 0) list[256 * (31 * i1 - (i1 * (i1 - 1)) / 2) + lbase[i1] + p1] = (unsigned short)(t | (__popc(mask & ((1u << i1) - 1u)) << 13));
        if (i2 >= 0) list[256 * (31 * i2 - (i2 * (i2 - 1)) / 2) + lbase[i2] + p2] = (unsigned short)(t | (__popc(mask & ((1u << i2) - 1u)) << 13));
        if (i3 >= 0) list[256 * (31 * i3 - (i3 * (i3 - 1)) / 2) + lbase[i3] + p3] = (unsigned short)(t | (__popc(mask & ((1u << i3) - 1u)) << 13));
        ((unsigned*)(A.ws + WS_SEL))[(size_t)bh * SEQ + t] = mask;
        __syncthreads();
    }
}
constexpr int MB_VIRT = 0;
constexpr int MK_STRIDE = 144, MV_STRIDE = 160, MK_OFF = 0, MV_OFF = 256 * MK_STRIDE, MB_CTL = 81920;
__device__ __forceinline__ void moba_stage_load(const Args& A, int bh, int j, bf16x8 (&kk)[4], bf16x8 (&vv)[4]) {
    const int b = bh >> 4, h = bh & 15, row = threadIdx.x >> 3, ch = threadIdx.x & 7;
    const bf16* kp = (const bf16*)(A.ws + WS_ACT) + (size_t)M * DM + ((size_t)b * SEQ + 256 * j + row) * DM + h * 64 + 8 * ch;
    const bf16* vp = kp + (size_t)M * DM;
#pragma unroll
    for (int i = 0; i < 4; ++i) { kk[i] = *(const bf16x8*)(kp + (size_t)64 * i * DM); vv[i] = *(const bf16x8*)(vp + (size_t)64 * i * DM); }
}
__device__ __forceinline__ void moba_stage_store(LAS unsigned char* lds, const bf16x8 (&kk)[4], const bf16x8 (&vv)[4]) {
    const int row = threadIdx.x >> 3, ch = threadIdx.x & 7;
#pragma unroll
    for (int i = 0; i < 4; ++i) { *(LAS bf16x8*)(lds + MK_OFF + (64 * i + row) * MK_STRIDE + 16 * ch) = kk[i]; *(LAS bf16x8*)(lds + MV_OFF + (64 * i + row) * MV_STRIDE + 16 * ch) = vv[i]; }
}
__device__ __forceinline__ void moba_stage(const Args& A, LAS unsigned char* lds, int bh, int j) {
    bf16x8 kk[4], vv[4]; moba_stage_load(A, bh, j, kk, vv); moba_stage_store(lds, kk, vv);
}
__device__ __forceinline__ void moba_block(LAS unsigned char* lds, int ntile, const bf16x8 qf0, const bf16x8 qf1, int qpos, int lane, float& m_out, float& l_out, f32x4 (&o)[4]) {
    const int qi = lane & 15, g = lane >> 4;
    LAS unsigned char* kb = lds + MK_OFF + qi * MK_STRIDE + 16 * g;
    f32x4 sa[8], sb[8];
    float mx = -INFINITY;
#pragma unroll
    for (int t = 0; t < 8; ++t) {
        sa[t] = (f32x4){-INFINITY, -INFINITY, -INFINITY, -INFINITY}; sb[t] = sa[t];
        if (t < ntile) {
            LAS unsigned char* kt = kb + t * 32 * MK_STRIDE;
            const bf16x8 k0 = *(LAS bf16x8*)(kt), k1 = *(LAS bf16x8*)(kt + 64), k2 = *(LAS bf16x8*)(kt + 16 * MK_STRIDE), k3 = *(LAS bf16x8*)(kt + 16 * MK_STRIDE + 64);
            f32x4 a = (f32x4){0.f, 0.f, 0.f, 0.f}, bq = (f32x4){0.f, 0.f, 0.f, 0.f};
            a = __builtin_amdgcn_mfma_f32_16x16x32_bf16(k0, qf0, a, 0, 0, 0); a = __builtin_amdgcn_mfma_f32_16x16x32_bf16(k1, qf1, a, 0, 0, 0);
            bq = __builtin_amdgcn_mfma_f32_16x16x32_bf16(k2, qf0, bq, 0, 0, 0); bq = __builtin_amdgcn_mfma_f32_16x16x32_bf16(k3, qf1, bq, 0, 0, 0);
#pragma unroll
            for (int e = 0; e < 4; ++e) { const int ka = 32 * t + 4 * g + e;
                a[e] = (ka <= qpos) ? a[e] : -INFINITY; bq[e] = (ka + 16 <= qpos) ? bq[e] : -INFINITY; mx = fmaxf(mx, fmaxf(a[e], bq[e])); }
            sa[t] = a; sb[t] = bq;
        }
    }
    mx = fmaxf(mx, __shfl_xor(mx, 16)); mx = fmaxf(mx, __shfl_xor(mx, 32));
    float ps = 0.f;
    LAS unsigned char* rb = lds + MV_OFF + (4 * g + (qi >> 2)) * MV_STRIDE + (qi & 3) * 8;
#pragma unroll
    for (int t = 0; t < 8; ++t) {
        if (t < ntile) {
            float pa[4], pb[4];
#pragma unroll
            for (int e = 0; e < 4; ++e) { pa[e] = __builtin_amdgcn_exp2f(sa[t][e] - mx); pb[e] = __builtin_amdgcn_exp2f(sb[t][e] - mx); ps += pa[e] + pb[e]; }
            v4u pw; pw.x = pk2(pa[0], pa[1]); pw.y = pk2(pa[2], pa[3]); pw.z = pk2(pb[0], pb[1]); pw.w = pk2(pb[2], pb[3]);
            const bf16x8 pf = __builtin_bit_cast(bf16x8, pw);
            LAS unsigned char* rt = rb + t * 32 * MV_STRIDE;
#pragma unroll
            for (int db = 0; db < 4; ++db) {
                const s16x4 lo = __builtin_bit_cast(s16x4, __builtin_amdgcn_ds_read_tr16_b64_v4i16((LAS s16x4*)(rt + db * 32)));
                const s16x4 hi = __builtin_bit_cast(s16x4, __builtin_amdgcn_ds_read_tr16_b64_v4i16((LAS s16x4*)(rt + db * 32 + 16 * MV_STRIDE)));
                const bf16x8 vf = (bf16x8){lo[0], lo[1], lo[2], lo[3], hi[0], hi[1], hi[2], hi[3]};
                o[db] = __builtin_amdgcn_mfma_f32_16x16x32_bf16(vf, pf, o[db], 0, 0, 0);
            }
        }
    }
    m_out = mx; l_out = ps;
}
__device__ __forceinline__ bf16* moba_po(const Args& A, int slot) { return slot == 0 ? (bf16*)(A.ws + WS_MIX) : slot == 1 ? (bf16*)A.out : (bf16*)(A.ws + WS_PO2); }
__device__ __forceinline__ void moba_past_phase(const Args& A, LAS unsigned char* lds, int wave, int lane) {
    LAS unsigned* cntl = (LAS unsigned*)(lds + MB_CTL);
    LAS unsigned* pre = cntl + 1024;
    LAS unsigned* tot = pre + 1025;
    const unsigned* cnt = (const unsigned*)(A.ws + WS_CNT);
    const int tid = threadIdx.x;
    for (int i = tid; i < 1024; i += NTHR) cntl[i] = cnt[i];
    __syncthreads();
    if (tid < 32) { unsigned run = 0; for (int j = 0; j < 32; ++j) { pre[tid * 32 + j] = run; const unsigned n = cntl[tid * 32 + j]; run += n ? ((n + 127u) >> 7) + MB_VIRT : 0u; } tot[tid] = run; }
    __syncthreads();
    if (tid == 0) { unsigned run = 0; for (int b = 0; b < 32; ++b) { const unsigned t = tot[b]; tot[b] = run; run += t; } tot[32] = run; pre[1024] = run; }
    __syncthreads();
    for (int i = tid; i < 1024; i += NTHR) pre[i] += tot[i >> 5];
    __syncthreads();
    const unsigned T = tot[32];
    const unsigned i0 = (unsigned)(((unsigned long long)T * blockIdx.x) / gridDim.x), i1 = (unsigned)(((unsigned long long)T * (blockIdx.x + 1)) / gridDim.x);
    const int qi = lane & 15, g = lane >> 4;
    LAS unsigned short* ents = (LAS unsigned short*)(lds + 98304);
    LAS unsigned short* item_e = (LAS unsigned short*)(lds + 98304 + 24576);
    const int n = (int)(i1 - i0) < 96 ? (int)(i1 - i0) : 96;
    for (int x = tid; x < n * 128; x += NTHR) {
        const unsigned it = i0 + (unsigned)(x >> 7);
        int lo = 0, hi = 1024;
        while (lo < hi) { const int mid = (lo + hi) >> 1; if (pre[mid + 1] > it) hi = mid; else lo = mid + 1; }
        const int e = lo, c = (int)(it - pre[e]), li = c * 128 + (x & 127), j = e & 31;
        const unsigned short* list = (const unsigned short*)(A.ws + WS_LIST) + (size_t)(e >> 5) * 126976 + 256 * (31 * j - (j * (j - 1)) / 2);
        ents[x] = (li < (int)cntl[e]) ? list[li] : (unsigned short)0xFFFF;
        if ((x & 127) == 0) item_e[x >> 7] = (unsigned short)e;
    }
    __syncthreads();
    int cur_e = -1;
#define MB_QP(e_, tq_) ((const bf16*)(A.ws + WS_ACT) + ((size_t)((e_) >> 9) * SEQ + (tq_)) * DM + (((e_) >> 5) & 15) * 64 + 8 * g)
    if (n > 0) {
        int eA = (int)item_e[0]; unsigned entA = ents[wave * 16 + qi];
        bf16x8 qA0, qA1; { const int tq = (entA == 0xFFFFu) ? 0 : (int)(entA & 8191u); qA0 = *(const bf16x8*)MB_QP(eA, tq); qA1 = *(const bf16x8*)(MB_QP(eA, tq) + 32); }
        bf16x8 pkk[4], pvv[4]; bool have_pf = false; int pf_e = -1;
#pragma unroll
        for (int i = 0; i < 4; ++i) { pkk[i] = (bf16x8){0, 0, 0, 0, 0, 0, 0, 0}; pvv[i] = pkk[i]; }
        for (int ii = 0; ii < n; ++ii) {
            const int bh = eA >> 5, j = eA & 31;
            const int iin = (ii + 1 < n) ? ii + 1 : ii;
            const int eB = (int)item_e[iin]; const unsigned entB = ents[iin * 128 + wave * 16 + qi];
            if (eA != cur_e) { __syncthreads(); if (have_pf && pf_e == eA) moba_stage_store(lds, pkk, pvv); else moba_stage(A, lds, bh, j); __syncthreads(); cur_e = eA; have_pf = false; }
            const int tqB = (entB == 0xFFFFu) ? 0 : (int)(entB & 8191u);
            const bf16x8 qB0 = *(const bf16x8*)MB_QP(eB, tqB), qB1 = *(const bf16x8*)(MB_QP(eB, tqB) + 32);
            if (eB != eA) { moba_stage_load(A, eB >> 5, eB & 31, pkk, pvv); have_pf = true; pf_e = eB; }
            float mrun, lrun; f32x4 o[4];
#pragma unroll
            for (int d = 0; d < 4; ++d) o[d] = (f32x4){0.f, 0.f, 0.f, 0.f};
            moba_block(lds, 8, qA0, qA1, 1 << 30, lane, mrun, lrun, o);
            lrun += __shfl_xor(lrun, 16); lrun += __shfl_xor(lrun, 32);
            {
                const bool valA = entA != 0xFFFFu; const int tq = (int)(entA & 8191u), slot = (int)(entA >> 13); const size_t idx = (size_t)bh * SEQ + tq;
                const float inv = 1.0f / lrun;
                bf16* junk = (bf16*)(A.ws + 524288) + threadIdx.x * 64;
                bf16* op = valA ? moba_po(A, slot) + idx * 64 + 16 * g : junk;
#pragma unroll
                for (int hh = 0; hh < 2; ++hh) { v4u w; w.x = pk2(o[2 * hh][0] * inv, o[2 * hh][1] * inv); w.y = pk2(o[2 * hh][2] * inv, o[2 * hh][3] * inv);
                    w.z = pk2(o[2 * hh + 1][0] * inv, o[2 * hh + 1][1] * inv); w.w = pk2(o[2 * hh + 1][2] * inv, o[2 * hh + 1][3] * inv); *(v4u*)(op + 8 * hh) = w; }
                float* lp = (valA && g == 0) ? (float*)(A.ws + WS_LSE) + (size_t)slot * (32 * SEQ) + idx : (float*)(junk + 32);
                *lp = mrun + __builtin_amdgcn_logf(lrun);
            }
            eA = eB; entA = entB; qA0 = qB0; qA1 = qB1;
        }
    }
#undef MB_QP
    __syncthreads();
}
__device__ __forceinline__ void moba_own_phase(const Args& A, LAS unsigned char* lds, int wave, int lane) {
    const int qi = lane & 15, g = lane >> 4;
    int cur_e = -1;
    for (int u = blockIdx.x * 8; u < blockIdx.x * 8 + 8; ++u) {
        const int hf = u & 1, e = u >> 1, bh = e >> 5, j = e & 31;
        if (e != cur_e) { __syncthreads(); moba_stage(A, lds, bh, j); __syncthreads(); cur_e = e; }
        const int qloc = 128 * hf + 16 * wave + qi, tq = 256 * j + qloc;
        const size_t qrow = (size_t)(bh >> 4) * SEQ + tq;
        bf16* qp = (bf16*)(A.ws + WS_ACT) + qrow * DM + (bh & 15) * 64;
        const bf16x8 qf0 = *(const bf16x8*)(qp + 8 * g), qf1 = *(const bf16x8*)(qp + 8 * g + 32);
        float mrun, lrun; f32x4 o[4];
#pragma unroll
        for (int d = 0; d < 4; ++d) o[d] = (f32x4){0.f, 0.f, 0.f, 0.f};
        const size_t idx = (size_t)bh * SEQ + tq;
        const unsigned selm = ((const unsigned*)(A.ws + WS_SEL))[idx];
        const float* lsep = (const float*)(A.ws + WS_LSE) + idx;
        float lsr[3]; s16x4 pr[3][4];
#pragma unroll
        for (int s = 0; s < 3; ++s) { lsr[s] = lsep[(size_t)s * (32 * SEQ)]; const bf16* pp = moba_po(A, s) + idx * 64 + 16 * g;
#pragma unroll
            for (int hh = 0; hh < 2; ++hh) { const bf16x8 r8 = *(const bf16x8*)(pp + 8 * hh);
                pr[s][2 * hh] = (s16x4){r8[0], r8[1], r8[2], r8[3]}; pr[s][2 * hh + 1] = (s16x4){r8[4], r8[5], r8[6], r8[7]}; } }
        const int ntile = (128 * hf + 16 * wave + 15) / 32 + 1;
        moba_block(lds, ntile, qf0, qf1, qloc, lane, mrun, lrun, o);
        lrun += __shfl_xor(lrun, 16); lrun += __shfl_xor(lrun, 32);
        const int nsel = __popc(selm);
        float ls[3]; float mx = mrun;
#pragma unroll
        for (int s = 0; s < 3; ++s) { ls[s] = (s < nsel) ? lsr[s] : -INFINITY; mx = fmaxf(mx, ls[s]); }
        const float w0 = __builtin_amdgcn_exp2f(mrun - mx); float den = lrun * w0;
#pragma unroll
        for (int d = 0; d < 4; ++d) o[d] = o[d] * w0;
#pragma unroll
        for (int s = 0; s < 3; ++s) { const bool on = s < nsel; const float ws_ = on ? __builtin_amdgcn_exp2f(ls[s] - mx) : 0.f; den += ws_;
#pragma unroll
            for (int db = 0; db < 4; ++db) { const s16x4 r = pr[s][db];
                o[db][0] += on ? ws_ * bf2f((unsigned short)r[0]) : 0.f; o[db][1] += on ? ws_ * bf2f((unsigned short)r[1]) : 0.f;
                o[db][2] += on ? ws_ * bf2f((unsigned short)r[2]) : 0.f; o[db][3] += on ? ws_ * bf2f((unsigned short)r[3]) : 0.f; } }
        const float inv = 1.0f / den;
#pragma unroll
        for (int db = 0; db < 4; ++db) { v2u w; w.x = pk2(o[db][0] * inv, o[db][1] * inv); w.y = pk2(o[db][2] * inv, o[db][3] * inv); *(v2u*)(qp + 16 * db + 4 * g) = w; }
    }
    __syncthreads();
}
constexpr int N_PHASES = 17;
#ifndef MK_DENSE_MOBA
#define MK_DENSE_MOBA 0
#endif
#ifndef MK_FUSE_FINAL
#define MK_FUSE_FINAL 1
#endif
#ifndef MK_SINGLE
#define MK_SINGLE 1
#endif
__global__ void __launch_bounds__(NTHR, 2) fwd_megakernel(Args args) {
    extern __shared__ __attribute__((aligned(16))) unsigned char lds_raw[];
    __builtin_assume(__builtin_amdgcn_workitem_id_y() == 0); __builtin_assume(__builtin_amdgcn_workitem_id_z() == 0);
    cg::grid_group grid = cg::this_grid();
    LAS unsigned char* lds = (LAS unsigned char*)lds_raw;
    const int tid = threadIdx.x, lane = tid & 63, wave = __builtin_amdgcn_readfirstlane(tid >> 6);
    const int G = gridDim.x;
    unsigned char* ws = args.ws;
    const int lo = args.ph_lo, hi = args.ph_hi;
    bf16* XB = (bf16*)(ws + WS_XB); float* PART = (float*)(ws + WS_PART); bf16* ACT = (bf16*)(ws + WS_ACT); bf16* MIX = (bf16*)(ws + WS_MIX);
    float* X = args.out;
#define IN(k) (lo <= (k) && (k) < hi)
    volatile LAS unsigned* MISC = (volatile LAS unsigned*)(lds + MISC_OFF);
    if (tid < 32) MISC[tid] = 0u;
    unsigned* barw = (unsigned*)(ws + WS_BAR);
    XcdBarrier xbar; xbar.bar = barw; xbar.x = 0; xbar.st = MISC + 8;
    __syncthreads();
    xbar = xcd_barrier_post(barw, MISC + 8);
    if (lo > 1000) grid.sync();
#ifdef PROBE_REP
#define SEAM(k) do { if (IN(k) && IN((k) + 1)) { for (int s_ = 0; s_ < PROBE_SYNC; ++s_) grid.sync(); } } while (0)
#else
#ifdef MK_TS
#define STAMP(i) do { if (blockIdx.x == 0 && tid == 0) ((unsigned long long*)(ws + 262144))[i] = __builtin_amdgcn_s_memrealtime(); } while (0)
#define SEAM(k) do { if (IN(k) && IN((k) + 1)) xcd_barrier(xbar); STAMP((k) + 1); } while (0)
#else
#define STAMP(i) do { } while (0)
#define SEAM(k) do { if (IN(k) && IN((k) + 1)) xcd_barrier(xbar); } while (0)
#endif
#endif
#define GEMM_GU(f) do { pg8::Gemm g{XB, (const bf16*)(ws + ws_wgu(f)), M, 2 * FF, DM}; pg8::StaticOrder S; S.init(M, 2 * FF, G, (int)blockIdx.x); \
        rstd_table(PART, lds, S); pg8::EpiSwiGLU E{ACT, FF, (const LAS float*)(lds + RSTD_OFF)}; pg8::gemm_phase<pg8::EpiSwiGLU, pg8::StaticOrder, true, true>(lds, g, S, E); } while (0)
#define GEMM_DOWN(f, F32B, basep) do { pg8::Gemm g{ACT, (const bf16*)(ws + ws_wd(f)), M, DM, FF}; pg8::StaticOrder S; S.init(M, DM, G, (int)blockIdx.x); \
        pg8::EpiResid<F32B> E{(basep), XB, PART, 0.5f}; pg8::gemm_phase<pg8::EpiResid<F32B>, pg8::StaticOrder, true, true>(lds, g, S, E); } while (0)
#define GEMM_OUT(Ap, Wp) do { pg8::Gemm g{(Ap), (const bf16*)(ws + (Wp)), M, DM, DM}; pg8::StaticOrder S; S.init(M, DM, G, (int)blockIdx.x); \
        pg8::EpiResid<false> E{nullptr, XB, PART, 1.0f}; pg8::gemm_phase<pg8::EpiResid<false>, pg8::StaticOrder, true, true>(lds, g, S, E); } while (0)

#ifdef PROBE_REP
    for (int rep_ = 0; rep_ < PROBE_REP0; ++rep_) { phase_prologue(args, lds, wave, lane); __syncthreads(); }
#endif
    STAMP(0);
    if (IN(0)) { phase_prologue(args, lds, wave, lane); } SEAM(0);
    if (IN(1)) { GEMM_GU(0); conv_idle(args, lds, 8, 9, 5); } SEAM(1);
    if (IN(2)) { GEMM_DOWN(0, false, nullptr); } SEAM(2);
    if (IN(3)) { pg8::Gemm g{XB, (const bf16*)(ws + WS_WABIN), M, ABIN, DM}; pg8::StaticOrder S; S.init(M, ABIN, G, (int)blockIdx.x);
        rstd_table(PART, lds, S); pg8::EpiProj E{ACT, ABIN, (const LAS float*)(lds + RSTD_OFF), 0, 0, 512, C2, nullptr}; pg8::gemm_phase<pg8::EpiProj, pg8::StaticOrder, true, true>(lds, g, S, E); conv_idle(args, lds, 1, -1, -1); } SEAM(3);
#ifndef NO_MIX
#ifdef PROBE_REP
    for (int rep_ = 0; rep_ < PROBE_REP4; ++rep_)
#endif
    if (IN(4)) {
        for (int u = blockIdx.x; u < 512; u += G) gate_unit(args, lds, u, wave, lane);
        if (G == 256) { for (int r = 0; r < 2; ++r) dil_wg_unit(args, lds, (r << 8) | ((blockIdx.x & 7) << 5) | (blockIdx.x >> 3), wave, lane); }
        else { for (int u = blockIdx.x; u < 512; u += G) dil_wg_unit(args, lds, u, wave, lane); }
    }
#endif
    SEAM(4);
    if (IN(5)) { GEMM_OUT(MIX, WS_WABOUT); } SEAM(5);
    if (IN(6)) { GEMM_GU(1); conv_idle(args, lds, 2, -1, -1); } SEAM(6);
    if (IN(7)) { GEMM_DOWN(1, false, nullptr); } SEAM(7);
    if (IN(8)) { GEMM_GU(2); conv_idle(args, lds, 6, 10, 11); } SEAM(8);
    if (IN(9)) { GEMM_DOWN(2, false, nullptr); } SEAM(9);
    if (IN(10)) { pg8::Gemm g{XB, (const bf16*)(ws + WS_WCIN), M, CIN, DM}; pg8::StaticOrder S; S.init(M, CIN, G, (int)blockIdx.x);
        rstd_table(PART, lds, S); pg8::EpiProj E{ACT, DM, (const LAS float*)(lds + RSTD_OFF), DM, (size_t)M * DM, DM, C2, (float*)(ws + WS_KM)}; pg8::gemm_phase<pg8::EpiProj, pg8::StaticOrder, true, true>(lds, g, S, E); } SEAM(10);
    if (IN(11)) { select_phase(args, lds, wave, lane); }
    SEAM(11);
#if MK_DENSE_MOBA
#ifndef NO_ATTN
    if (IN(12)) {
        const attn_body::AttnTensors AT{(const attn_body::bf16*)ACT, (const attn_body::bf16*)(ACT + (size_t)M * DM), (const attn_body::bf16*)(ACT + (size_t)2 * M * DM), (attn_body::bf16*)ACT, (const unsigned*)(ws + WS_SEL)};
        const attn_body::StaticOrder S(G, (int)blockIdx.x);
        attn_body::attn_phase<attn_body::StaticOrder>((char*)lds_raw, AT, S);
    }
#endif
#else
    if (IN(12)) { moba_past_phase(args, lds, wave, lane); xcd_barrier(xbar); STAMP(20); moba_own_phase(args, lds, wave, lane); }
#endif
    SEAM(12);
    if (IN(13)) { GEMM_OUT(ACT, WS_WCOUT); } SEAM(13);
    if (IN(14)) { GEMM_GU(3); conv_idle(args, lds, 7, -1, -1); } SEAM(14);
#if MK_FUSE_FINAL
    if (IN(15)) { pg8::Gemm g{ACT, (const bf16*)(ws + ws_wd(3)), M, DM, FF}; pg8::StaticOrder S; S.init(M, DM, G, (int)blockIdx.x);
        EpiResidNorm E{XB, X, PART, args.in[17], 0.5f, xbar}; pg8::gemm_phase<EpiResidNorm, pg8::StaticOrder, false, true>(lds, g, S, E); }
#ifdef MK_TS
    xcd_barrier(xbar); STAMP(16);
    if (blockIdx.x == 0 && tid == 0) { const unsigned long long* ts = (const unsigned long long*)(ws + 262144);
        auto dur = [&](int p) -> float { if (p == 100) return (float)(ts[20] - ts[12]) * 0.01f; if (p == 101) return (float)(ts[13] - ts[20]) * 0.01f; if (p == 102) return (float)(ts[16] - ts[0]) * 0.01f; return (float)(ts[p + 1] - ts[p]) * 0.01f; };
        X[0] += dur(MK_TS_A); X[1024 * 1000] += dur(MK_TS_B); }
#endif
#else
    if (IN(15)) { GEMM_DOWN(3, false, nullptr); } SEAM(15);
    if (IN(16)) {
        const float* gn = args.in[17];
        int tid16 = threadIdx.x; asm volatile("" : "+v"(tid16)); const int lane = tid16 & 63, wave = __builtin_amdgcn_readfirstlane(tid16 >> 6);
        for (int m = blockIdx.x * NWAVES + wave; m < M; m += G * NWAVES) {
            f32x4* xr = (f32x4*)(X + (size_t)m * DM) + lane; f32x4 v[4]; float s = 0.f;
#pragma unroll
            for (int j = 0; j < 4; ++j) { v[j] = xr[64 * j]; s += (v[j][0] * v[j][0] + v[j][1] * v[j][1]) + (v[j][2] * v[j][2] + v[j][3] * v[j][3]); }
            const float rs = rsqrtf(wave_sum(s) * (1.0f / DM) + 1e-6f);
#pragma unroll
            for (int j = 0; j < 4; ++j) { const f32x4 gg = ((const f32x4*)gn)[64 * j + lane]; xr[64 * j] = v[j] * rs * gg; }
        }
    }
#endif
#undef IN
#undef SEAM
}

extern "C" void kernel_launch(void* const* d_in, const int* in_sizes, int n_in, void* d_out, int out_size, void* d_ws, size_t ws_size, hipStream_t stream) {
    static int grid = 0;
    if (grid == 0) {
        if (n_in != 18 || out_size != M * DM || ws_size < WS_END) { fprintf(stderr, "kernel_launch: unexpected shapes (n_in %d out %d ws %zu)\n", n_in, out_size, ws_size); grid = -1; return; }
        int dev = 0, cus = 0, per_cu = 0;
        hipGetDevice(&dev); hipDeviceGetAttribute(&cus, hipDeviceAttributeMultiprocessorCount, dev);
        hipFuncSetAttribute((const void*)fwd_megakernel, hipFuncAttributeMaxDynamicSharedMemorySize, LDS_BYTES);
        hipOccupancyMaxActiveBlocksPerMultiprocessor(&per_cu, (const void*)fwd_megakernel, NTHR, LDS_BYTES);
        (void)hipGetLastError();
        if (per_cu < 1) { fprintf(stderr, "kernel_launch: occupancy query reports %d blocks per CU\n", per_cu); per_cu = 1; }
        grid = cus;
        if (grid != 256) fprintf(stderr, "kernel_launch: note: %d CUs (the attention order assumes 256)\n", grid);
    }
    if (grid < 0) return;
    if (hipMemsetAsync((char*)d_ws + WS_BAR, 0, (WS_CNT + 4096) - WS_BAR, stream) != hipSuccess) { fprintf(stderr, "kernel_launch: memset failed\n"); return; }
    Args a{};
    for (int i = 0; i < 18; ++i) a.in[i] = (const float*)d_in[i];
    a.out = (float*)d_out; a.ws = (unsigned char*)d_ws;
#if MK_SINGLE
    a.ph_lo = 0; a.ph_hi = N_PHASES;
    { void* kargs[] = {&a}; hipError_t e = hipLaunchCooperativeKernel((const void*)fwd_megakernel, dim3(grid), dim3(NTHR), kargs, LDS_BYTES, stream);
      if (e != hipSuccess) fprintf(stderr, "cooperative launch failed: %s\n", hipGetErrorString(e)); }
#else
    for (int p = 0; p < N_PHASES; ++p) { a.ph_lo = p; a.ph_hi = p + 1; void* kargs[] = {&a};
        hipError_t e = hipLaunchCooperativeKernel((const void*)fwd_megakernel, dim3(grid), dim3(NTHR), kargs, LDS_BYTES, stream);
        if (e != hipSuccess) { fprintf(stderr, "cooperative launch %d failed: %s\n", p, hipGetErrorString(e)); break; } }
#endif
}
```
